# Optimizing an MI355X kernel written in HIP

```python
import jax, jax.numpy as jnp
from jax import lax
import numpy as np

D_MODEL = 1024
BATCH = 2
SEQ = 8192
DEPTH = 4

CONV_WIDTH = 3
CONV_DIM = D_MODEL // 2
CONV_GROUPS = 8
MLSTM_HEADS = 4
MLSTM_HEAD_DIM = (D_MODEL // 2) // MLSTM_HEADS
MLSTM_DIM = MLSTM_HEADS * MLSTM_HEAD_DIM
MLSTM_CHUNK = 128
SGU_CHUNK = 128
SGU_DIM = D_MODEL
SGU_GROUPS = 8
SGU_GROUP_DIM = SGU_DIM // SGU_GROUPS
D_FF = ((8 * D_MODEL // 3 + 255) // 256) * 256
RMS_EPS = 1e-6
EVEN_IN = 3 * CONV_DIM + 4 * MLSTM_DIM + 2 * MLSTM_HEADS
N_EVEN = (DEPTH + 1) // 2
N_ODD = DEPTH // 2

kernel_name = "hybrid_shortconv_mlstm_sgu_trunk"


def rmsnorm(x, g):
    xf = x.astype(jnp.float32)
    y = xf * lax.rsqrt(jnp.mean(xf * xf, axis=-1, keepdims=True) + RMS_EPS)
    return (y * g.astype(jnp.float32)).astype(x.dtype)


def causal_short_conv(z, w):
    S = z.shape[1]
    zp = jnp.pad(z, ((0, 0), (CONV_WIDTH - 1, 0), (0, 0)))
    out = zp[:, 0:S] * w[0]
    for j in range(1, CONV_WIDTH):
        out = out + zp[:, j:j + S] * w[j]
    return out


def mlstm_chunkwise(q, k, v, i_raw, f_raw):
    Bsz, S, H, Dh = q.shape
    L = MLSTM_CHUNK
    nc = S // L
    f32 = jnp.float32

    def chunks4(a):
        return a.astype(f32).reshape(Bsz, nc, L, H, Dh).transpose(1, 0, 3, 2, 4)

    def chunks3(a):
        return a.astype(f32).reshape(Bsz, nc, L, H).transpose(1, 0, 3, 2)

    qc = chunks4(q)
    kc = chunks4(k) * (Dh ** -0.5)
    vc = chunks4(v)
    ic = chunks3(i_raw)
    lfc = chunks3(jax.nn.log_sigmoid(f_raw.astype(f32)))
    causal = jnp.tril(jnp.ones((L, L), dtype=bool))

    def step(carry, xs):
        C, n, m = carry
        qb, kb, vb, ib, lfb = xs
        b = jnp.cumsum(lfb, axis=-1)
        dmat = jnp.where(causal, b[..., :, None] - b[..., None, :] + ib[..., None, :], -jnp.inf)
        m_inter = b + m[..., None]
        m_t = jnp.maximum(m_inter, jnp.max(dmat, axis=-1))
        scores = jnp.einsum('bhtd,bhsd->bhts', qb, kb) * jnp.exp(dmat - m_t[..., None])
        inter = jnp.exp(m_inter - m_t)
        num = (jnp.einsum('bhts,bhsd->bhtd', scores, vb)
               + inter[..., None] * jnp.einsum('bhtd,bhde->bhte', qb, C))
        den = jnp.sum(scores, axis=-1) + inter * jnp.einsum('bhtd,bhd->bht', qb, n)
        h = num / jnp.maximum(jnp.abs(den), jnp.exp(-m_t))[..., None]
        bL = b[..., -1]
        w_end = bL[..., None] - b + ib
        m_new = jnp.maximum(bL + m, jnp.max(w_end, axis=-1))
        decay = jnp.exp(bL + m - m_new)
        wk = jnp.exp(w_end - m_new[..., None])[..., None] * kb
        C_new = decay[..., None, None] * C + jnp.einsum('bhsd,bhse->bhde', wk, vb)
        n_new = decay[..., None] * n + jnp.sum(wk, axis=-2)
        return (C_new, n_new, m_new), h

    init = (jnp.zeros((Bsz, H, Dh, Dh), f32), jnp.zeros((Bsz, H, Dh), f32),
            jnp.zeros((Bsz, H), f32))
    _, hs = lax.scan(step, init, (qc, kc, vc, ic, lfc))
    return hs.transpose(1, 0, 3, 2, 4).reshape(Bsz, S, H, Dh)


def even_mixer(xn, w_in, w_conv, b_gate, g_head, w_out):
    Bsz, S, _ = xn.shape
    proj = xn @ w_in
    c1 = CONV_DIM
    c3 = 3 * CONV_DIM
    bg, cg, xa, q, k, v, o, gates = jnp.split(
        proj, [c1, 2 * c1, c3, c3 + MLSTM_DIM, c3 + 2 * MLSTM_DIM,
               c3 + 3 * MLSTM_DIM, c3 + 4 * MLSTM_DIM], axis=-1)
    ya = bg * causal_short_conv(cg * xa, w_conv)
    gates = gates + b_gate
    i_raw, f_raw = gates[..., :MLSTM_HEADS], gates[..., MLSTM_HEADS:]
    shp = (Bsz, S, MLSTM_HEADS, MLSTM_HEAD_DIM)
    h = mlstm_chunkwise(q.reshape(shp), k.reshape(shp), v.reshape(shp), i_raw, f_raw)
    h = h * lax.rsqrt(jnp.mean(h * h, axis=-1, keepdims=True) + RMS_EPS)
    h = h * g_head.astype(jnp.float32).reshape(MLSTM_HEADS, MLSTM_HEAD_DIM)
    yb = jax.nn.sigmoid(o) * h.reshape(Bsz, S, MLSTM_DIM).astype(xn.dtype)
    return jnp.concatenate([ya, yb], axis=-1) @ w_out


def odd_mixer(xn, w_in, g_v, w_s, b_s, w_out):
    Bsz, S, _ = xn.shape
    nc = S // SGU_CHUNK
    z = jax.nn.gelu(xn @ w_in)
    u, v = z[..., :SGU_DIM], z[..., SGU_DIM:]
    v = rmsnorm(v, g_v).reshape(Bsz, nc, SGU_CHUNK, SGU_GROUPS, SGU_GROUP_DIM)
    ws = w_s * jnp.tril(jnp.ones((SGU_CHUNK, SGU_CHUNK), dtype=w_s.dtype))
    v = jnp.einsum('gts,bcsgd->bctgd', ws, v) + b_s.T[None, None, :, :, None]
    return (u * v.reshape(Bsz, S, SGU_DIM)) @ w_out


def swiglu(xn, w_in, w_out):
    h = xn @ w_in
    g, up = h[..., :D_FF], h[..., D_FF:]
    return (jax.nn.silu(g) * up) @ w_out


def setup_inputs(seed: int = 0) -> dict:
    key = jax.random.key(seed)
    ks = jax.random.split(key, 16)
    nrm = jax.random.normal
    f32 = jnp.float32
    x = nrm(ks[0], (BATCH, SEQ, D_MODEL), f32)
    norm_mix = 1.0 + 0.02 * nrm(ks[1], (DEPTH, D_MODEL), f32)
    norm_ffn = 1.0 + 0.02 * nrm(ks[2], (DEPTH, D_MODEL), f32)
    even_w_in = nrm(ks[3], (N_EVEN, D_MODEL, EVEN_IN), f32) * D_MODEL ** -0.5
    even_w_conv = nrm(ks[4], (N_EVEN, CONV_WIDTH, CONV_DIM), f32) * CONV_WIDTH ** -0.5
    b_i = 0.1 * nrm(ks[5], (N_EVEN, MLSTM_HEADS), f32)
    b_f = 3.0 + 0.5 * nrm(jax.random.fold_in(ks[5], 1), (N_EVEN, MLSTM_HEADS), f32)
    even_b_gate = jnp.concatenate([b_i, b_f], axis=-1)
    even_g_head = 1.0 + 0.02 * nrm(ks[6], (N_EVEN, MLSTM_DIM), f32)
    even_w_out = nrm(ks[7], (N_EVEN, CONV_DIM + MLSTM_DIM, D_MODEL), f32) * (CONV_DIM + MLSTM_DIM) ** -0.5
    odd_w_in = nrm(ks[8], (N_ODD, D_MODEL, 2 * SGU_DIM), f32) * D_MODEL ** -0.5
    odd_g_v = 1.0 + 0.02 * nrm(ks[9], (N_ODD, SGU_DIM), f32)
    odd_w_s = nrm(ks[10], (N_ODD, SGU_GROUPS, SGU_CHUNK, SGU_CHUNK), f32) * SGU_CHUNK ** -0.5
    odd_b_s = 1.0 + 0.02 * nrm(ks[11], (N_ODD, SGU_GROUPS, SGU_CHUNK), f32)
    odd_w_out = nrm(ks[12], (N_ODD, SGU_DIM, D_MODEL), f32) * SGU_DIM ** -0.5
    ffn_w_in = nrm(ks[13], (DEPTH, D_MODEL, 2 * D_FF), f32) * D_MODEL ** -0.5
    ffn_w_out = nrm(ks[14], (DEPTH, D_FF, D_MODEL), f32) * D_FF ** -0.5
    norm_final = 1.0 + 0.02 * nrm(ks[15], (D_MODEL,), f32)
    return {"x": x, "norm_mix": norm_mix, "norm_ffn": norm_ffn,
            "even_w_in": even_w_in, "even_w_conv": even_w_conv, "even_b_gate": even_b_gate,
            "even_g_head": even_g_head, "even_w_out": even_w_out,
            "odd_w_in": odd_w_in, "odd_g_v": odd_g_v, "odd_w_s": odd_w_s,
            "odd_b_s": odd_b_s, "odd_w_out": odd_w_out,
            "ffn_w_in": ffn_w_in, "ffn_w_out": ffn_w_out, "norm_final": norm_final}


def reference(x, norm_mix, norm_ffn, even_w_in, even_w_conv, even_b_gate, even_g_head,
              even_w_out, odd_w_in, odd_g_v, odd_w_s, odd_b_s, odd_w_out,
              ffn_w_in, ffn_w_out, norm_final):
    for layer in range(DEPTH):
        j = layer // 2
        xn = rmsnorm(x, norm_mix[layer])
        if layer % 2 == 0:
            x = x + even_mixer(xn, even_w_in[j], even_w_conv[j], even_b_gate[j],
                               even_g_head[j], even_w_out[j])
        else:
            x = x + odd_mixer(xn, odd_w_in[j], odd_g_v[j], odd_w_s[j], odd_b_s[j], odd_w_out[j])
        x = x + swiglu(rmsnorm(x, norm_ffn[layer]), ffn_w_in[layer], ffn_w_out[layer])
    return rmsnorm(x, norm_final)
```

```cpp
#include <hip/hip_runtime.h>
#include <cstdio>
#include <cstdint>

namespace nv {
constexpr int DM = 1024, NB = 2, SEQ = 8192, M = NB * SEQ, DEPTH = 4;
constexpr int CD = 512, HEADS = 4, HD = 128, MD = 512, EVEN_IN = 3592, DFF = 2816, SGU_L = 128;
constexpr float EPS = 1e-6f;

__device__ __forceinline__ float block_sum(float v, float* red) {
#pragma unroll
    for (int o = 32; o > 0; o >>= 1) v += __shfl_xor(v, o);
    const int w = threadIdx.x >> 6, nw = (blockDim.x + 63) >> 6;
    __syncthreads();
    if ((threadIdx.x & 63) == 0) red[w] = v;
    __syncthreads();
    float s = 0.f;
    for (int i = 0; i < nw; ++i) s += red[i];
    return s;
}

__global__ void __launch_bounds__(256) rmsnorm_k(const float* x, const float* g, float* y, int ldx, int ldy) {
    __shared__ float red[32];
    const size_t r = blockIdx.x;
    const float* xr = x + r * ldx; float* yr = y + r * ldy;
    float v[4]; float s = 0.f;
#pragma unroll
    for (int j = 0; j < 4; ++j) { v[j] = xr[threadIdx.x + 256 * j]; s += v[j] * v[j]; }
    s = block_sum(s, red);
    const float rstd = rsqrtf(s * (1.0f / 1024.0f) + EPS);
#pragma unroll
    for (int j = 0; j < 4; ++j) yr[threadIdx.x + 256 * j] = v[j] * rstd * g[threadIdx.x + 256 * j];
}

template <int EPI>
__global__ void __launch_bounds__(256) gemm_k(const float* A, const float* W, float* C, const float* R, int N, int K, int lda, int ldw, int ldc) {
    __shared__ float As[16][68];
    __shared__ float Ws[16][68];
    const int tx = threadIdx.x & 15, ty = threadIdx.x >> 4;
    const int m0 = blockIdx.y * 64, n0 = blockIdx.x * 64;
    float acc00 = 0, acc01 = 0, acc02 = 0, acc03 = 0, acc10 = 0, acc11 = 0, acc12 = 0, acc13 = 0;
    float acc20 = 0, acc21 = 0, acc22 = 0, acc23 = 0, acc30 = 0, acc31 = 0, acc32 = 0, acc33 = 0;
    for (int k0 = 0; k0 < K; k0 += 16) {
#pragma unroll
        for (int i = 0; i < 4; ++i) { const int id = threadIdx.x + 256 * i; const int mm = id >> 4, kk = id & 15; As[kk][mm] = A[(size_t)(m0 + mm) * lda + k0 + kk]; }
#pragma unroll
        for (int i = 0; i < 4; ++i) { const int id = threadIdx.x + 256 * i; const int kk = id >> 6, nn = id & 63; const int n = n0 + nn; Ws[kk][nn] = (n < N) ? W[(size_t)(k0 + kk) * ldw + n] : 0.f; }
        __syncthreads();
#pragma unroll
        for (int kk = 0; kk < 16; ++kk) {
            const float a0 = As[kk][ty * 4 + 0], a1 = As[kk][ty * 4 + 1], a2 = As[kk][ty * 4 + 2], a3 = As[kk][ty * 4 + 3];
            const float b0 = Ws[kk][tx * 4 + 0], b1 = Ws[kk][tx * 4 + 1], b2 = Ws[kk][tx * 4 + 2], b3 = Ws[kk][tx * 4 + 3];
            acc00 += a0 * b0; acc01 += a0 * b1; acc02 += a0 * b2; acc03 += a0 * b3;
            acc10 += a1 * b0; acc11 += a1 * b1; acc12 += a1 * b2; acc13 += a1 * b3;
            acc20 += a2 * b0; acc21 += a2 * b1; acc22 += a2 * b2; acc23 += a2 * b3;
            acc30 += a3 * b0; acc31 += a3 * b1; acc32 += a3 * b2; acc33 += a3 * b3;
        }
        __syncthreads();
    }
#define ST(i, j, v) do { const int m = m0 + ty * 4 + (i), n = n0 + tx * 4 + (j); if (n < N) { float o = (v); if (EPI) o += R[(size_t)m * ldc + n]; C[(size_t)m * ldc + n] = o; } } while (0)
    ST(0, 0, acc00); ST(0, 1, acc01); ST(0, 2, acc02); ST(0, 3, acc03);
    ST(1, 0, acc10); ST(1, 1, acc11); ST(1, 2, acc12); ST(1, 3, acc13);
    ST(2, 0, acc20); ST(2, 1, acc21); ST(2, 2, acc22); ST(2, 3, acc23);
    ST(3, 0, acc30); ST(3, 1, acc31); ST(3, 2, acc32); ST(3, 3, acc33);
#undef ST
}

__global__ void __launch_bounds__(256) conv_k(const float* proj, const float* wconv, float* Y) {
    const int idx = blockIdx.x * 256 + threadIdx.x;
    const int t = idx >> 9, c = idx & 511;
    float acc = 0.f;
#pragma unroll
    for (int j = 0; j < 3; ++j) { const int tt = t - 2 + j; if (tt >= 0) { const float* p = proj + (size_t)tt * EVEN_IN; acc += wconv[j * CD + c] * (p[CD + c] * p[2 * CD + c]); } }
    Y[(size_t)t * DM + c] = proj[(size_t)t * EVEN_IN + c] * acc;
}

__device__ __forceinline__ float logsig(float x) { return fminf(x, 0.f) - log1pf(expf(-fabsf(x))); }

__global__ void __launch_bounds__(1024) mlstm_rec_k(const float* proj, const float* bgate, float* hbuf) {
    __shared__ float pn[2][8][128];
    __shared__ float pd[2][128];
    const int h = blockIdx.x, tid = threadIdx.x, e = tid & 127, dg = tid >> 7;
    float C0 = 0, C1 = 0, C2 = 0, C3 = 0, C4 = 0, C5 = 0, C6 = 0, C7 = 0, C8 = 0, C9 = 0, C10 = 0, C11 = 0, C12 = 0, C13 = 0, C14 = 0, C15 = 0;
    float nval = 0.f, m = 0.f;
    const float bi = bgate[h], bf = bgate[4 + h];
    const float ksc = 0.08838834764831845f;
    for (int t = 0; t < SEQ; ++t) {
        const float* p = proj + (size_t)t * EVEN_IN;
        const float ig_raw = p[3584 + h] + bi, fg_raw = p[3588 + h] + bf;
        const float lf = logsig(fg_raw);
        const float m_new = fmaxf(lf + m, ig_raw);
        const float fd = expf(lf + m - m_new), ig = expf(ig_raw - m_new);
        m = m_new;
        const float* qp = p + 1536 + h * HD + dg * 16;
        const float* kp = p + 2048 + h * HD + dg * 16;
        const float ve = p[2560 + h * HD + e] * ig;
        float part = 0.f;
#define UPD(j, Cj) do { Cj = fd * Cj + (kp[j] * ksc) * ve; part += qp[j] * Cj; } while (0)
        UPD(0, C0); UPD(1, C1); UPD(2, C2); UPD(3, C3); UPD(4, C4); UPD(5, C5); UPD(6, C6); UPD(7, C7);
        UPD(8, C8); UPD(9, C9); UPD(10, C10); UPD(11, C11); UPD(12, C12); UPD(13, C13); UPD(14, C14); UPD(15, C15);
#undef UPD
        const int par = t & 1;
        pn[par][dg][e] = part;
        if (e < 16) { nval = fd * nval + ig * (kp[e] * ksc); pd[par][dg * 16 + e] = qp[e] * nval; }
        __syncthreads();
        if (tid < 128) {
            float num = 0.f, den = 0.f;
#pragma unroll
            for (int g = 0; g < 8; ++g) num += pn[par][g][tid];
            for (int i = 0; i < 128; ++i) den += pd[par][i];
            hbuf[(size_t)t * MD + h * HD + tid] = num / fmaxf(fabsf(den), expf(-m_new));
        }
    }
}

__global__ void __launch_bounds__(512) headgate_k(const float* proj, const float* hbuf, const float* ghead, float* Y) {
    __shared__ float red[8];
    const int t = blockIdx.x, tid = threadIdx.x;
    const float hv = hbuf[(size_t)t * MD + tid];
    float s = hv * hv;
#pragma unroll
    for (int o = 32; o > 0; o >>= 1) s += __shfl_xor(s, o);
    if ((tid & 63) == 0) red[tid >> 6] = s;
    __syncthreads();
    const int hd = tid >> 7;
    const float ss = red[2 * hd] + red[2 * hd + 1];
    const float rstd = rsqrtf(ss * (1.0f / 128.0f) + EPS);
    const float o = proj[(size_t)t * EVEN_IN + 3072 + tid];
    Y[(size_t)t * DM + 512 + tid] = (1.0f / (1.0f + expf(-o))) * hv * rstd * ghead[tid];
}

__global__ void __launch_bounds__(256) gelu_k(float* z, size_t n) {
    const size_t i = (size_t)blockIdx.x * 256 + threadIdx.x;
    if (i < n) { const float x = z[i]; const float u = 0.7978845608028654f * (x + 0.044715f * x * x * x); z[i] = 0.5f * x * (1.0f + tanhf(u)); }
}

__global__ void __launch_bounds__(256) sgu_k(const float* z, const float* vn, const float* ws, const float* bs, float* a) {
    const int idx = blockIdx.x * 256 + threadIdx.x;
    const int t = idx >> 10, col = idx & 1023, g = col >> 7, c = t >> 7, tt = t & 127;
    const float* w = ws + ((size_t)g * SGU_L + tt) * SGU_L;
    float acc = 0.f;
    for (int ss = 0; ss <= tt; ++ss) acc += w[ss] * vn[(size_t)(c * SGU_L + ss) * DM + col];
    a[(size_t)t * DM + col] = z[(size_t)t * 2048 + col] * (acc + bs[g * SGU_L + tt]);
}

__global__ void __launch_bounds__(256) swiglu_k(const float* h, float* act, int rows) {
    const size_t i = (size_t)blockIdx.x * 256 + threadIdx.x;
    if (i < (size_t)rows * DFF) { const size_t r = i / DFF, c = i % DFF; const float g = h[r * (2 * DFF) + c], u = h[r * (2 * DFF) + DFF + c]; act[i] = g / (1.0f + expf(-g)) * u; }
}
}

extern "C" void kernel_launch(void* const* d_in, const int* in_sizes, int n_in, void* d_out, int out_size, void* d_ws, size_t ws_size, hipStream_t stream) {
    using namespace nv;
    const float* x = (const float*)d_in[0];
    const float* norm_mix = (const float*)d_in[1];
    const float* norm_ffn = (const float*)d_in[2];
    const float* even_w_in = (const float*)d_in[3];
    const float* even_w_conv = (const float*)d_in[4];
    const float* even_b_gate = (const float*)d_in[5];
    const float* even_g_head = (const float*)d_in[6];
    const float* even_w_out = (const float*)d_in[7];
    const float* odd_w_in = (const float*)d_in[8];
    const float* odd_g_v = (const float*)d_in[9];
    const float* odd_w_s = (const float*)d_in[10];
    const float* odd_b_s = (const float*)d_in[11];
    const float* odd_w_out = (const float*)d_in[12];
    const float* ffn_w_in = (const float*)d_in[13];
    const float* ffn_w_out = (const float*)d_in[14];
    const float* norm_final = (const float*)d_in[15];
    float* out = (float*)d_out;
    const size_t MiB = 1u << 20;
    if (ws_size < 300 * MiB) { fprintf(stderr, "kernel_launch: workspace too small: %zu\n", ws_size); return; }
    float* xcur = (float*)((char*)d_ws);
    float* xn = (float*)((char*)d_ws + 64 * MiB);
    char* scr = (char*)d_ws + 128 * MiB;
    hipMemcpyAsync(xcur, x, (size_t)M * DM * 4, hipMemcpyDeviceToDevice, stream);
    for (int layer = 0; layer < DEPTH; ++layer) {
        const int j = layer / 2;
        rmsnorm_k<<<M, 256, 0, stream>>>(xcur, norm_mix + (size_t)layer * DM, xn, DM, DM);
        for (int b = 0; b < NB; ++b) {
            const float* xnb = xn + (size_t)b * SEQ * DM; float* xb = xcur + (size_t)b * SEQ * DM;
            if ((layer & 1) == 0) {
                float* proj = (float*)scr;
                float* Y = (float*)(scr + 113 * MiB);
                float* hbuf = (float*)(scr + 145 * MiB);
                gemm_k<0><<<dim3((EVEN_IN + 63) / 64, SEQ / 64), 256, 0, stream>>>(xnb, even_w_in + (size_t)j * DM * EVEN_IN, proj, nullptr, EVEN_IN, DM, DM, EVEN_IN, EVEN_IN);
                conv_k<<<SEQ * 512 / 256, 256, 0, stream>>>(proj, even_w_conv + (size_t)j * 3 * CD, Y);
                mlstm_rec_k<<<HEADS, 1024, 0, stream>>>(proj, even_b_gate + (size_t)j * 8, hbuf);
                headgate_k<<<SEQ, 512, 0, stream>>>(proj, hbuf, even_g_head + (size_t)j * MD, Y);
                gemm_k<1><<<dim3(DM / 64, SEQ / 64), 256, 0, stream>>>(Y, even_w_out + (size_t)j * DM * DM, xb, xb, DM, DM, DM, DM, DM);
            } else {
                float* z = (float*)scr;
                float* vn = (float*)(scr + 64 * MiB);
                float* a = (float*)(scr + 96 * MiB);
                gemm_k<0><<<dim3(2048 / 64, SEQ / 64), 256, 0, stream>>>(xnb, odd_w_in + (size_t)j * DM * 2048, z, nullptr, 2048, DM, DM, 2048, 2048);
                gelu_k<<<(unsigned)(((size_t)SEQ * 2048 + 255) / 256), 256, 0, stream>>>(z, (size_t)SEQ * 2048);
                rmsnorm_k<<<SEQ, 256, 0, stream>>>(z + 1024, odd_g_v + (size_t)j * DM, vn, 2048, DM);
                sgu_k<<<SEQ * 1024 / 256, 256, 0, stream>>>(z, vn, odd_w_s + (size_t)j * 8 * SGU_L * SGU_L, odd_b_s + (size_t)j * 8 * SGU_L, a);
                gemm_k<1><<<dim3(DM / 64, SEQ / 64), 256, 0, stream>>>(a, odd_w_out + (size_t)j * DM * DM, xb, xb, DM, DM, DM, DM, DM);
            }
        }
        rmsnorm_k<<<M, 256, 0, stream>>>(xcur, norm_ffn + (size_t)layer * DM, xn, DM, DM);
        for (int c = 0; c < 4; ++c) {
            const int rows = M / 4;
            const float* xnc = xn + (size_t)c * rows * DM; float* xc = xcur + (size_t)c * rows * DM;
            float* h = (float*)scr;
            float* act = (float*)(scr + 96 * MiB);
            gemm_k<0><<<dim3(2 * DFF / 64, rows / 64), 256, 0, stream>>>(xnc, ffn_w_in + (size_t)layer * DM * 2 * DFF, h, nullptr, 2 * DFF, DM, DM, 2 * DFF, 2 * DFF);
            swiglu_k<<<(unsigned)(((size_t)rows * DFF + 255) / 256), 256, 0, stream>>>(h, act, rows);
            gemm_k<1><<<dim3(DM / 64, rows / 64), 256, 0, stream>>>(act, ffn_w_out + (size_t)layer * DFF * DM, xc, xc, DM, DFF, DFF, DM, DM);
        }
    }
    rmsnorm_k<<<M, 256, 0, stream>>>(xcur, norm_final, out, DM, DM);
}
```

```cpp
#include <hip/hip_runtime.h>
#include <cstdio>
#include <cstdint>
#define MK_PER_PHASE 1
namespace pg8 {
#define PG8_LAS __attribute__((address_space(3)))
typedef unsigned short bf16_t;
typedef short bf16x8 __attribute__((ext_vector_type(8)));
typedef float f32x4 __attribute__((ext_vector_type(4)));
typedef unsigned u32x4 __attribute__((ext_vector_type(4)));
constexpr int BM = 256, BK = 64, HALF = 128, HTB = HALF * BK * 2  , STAGE_BYTES = 8 * HTB, NXCD = 8, WGM = 8;

__host__ __device__ __forceinline__ int lds_byte(int r, int c) { const int st = (r >> 4) * 2 + (c >> 5), rr = r & 15, cc = c & 31, ob = rr * 64 + cc * 2; return st * 1024 + (ob ^ (((ob >> 9) & 1) << 5)); }
__host__ __device__ __forceinline__ void stage_rc(int b, int& R, int& C) { const int st = b / 1024, sb = b % 1024, swz = sb ^ (((sb >> 9) & 1) << 5); R = (st >> 1) * 16 + swz / 64; C = (st & 1) * 32 + (swz % 64) / 2; }
__host__ __device__ __forceinline__ int perm32(int rho) { const int n = rho >> 4, i = rho & 15; return 8 * (i >> 2) + 4 * n + (i & 3); }

struct Unit { int pm, pn; };
struct Gemm { const bf16_t* A; const bf16_t* Bt; int M, N, K; };

struct StaticOrder {
    int nM, nN, nwg, G, c;
    __host__ __device__ void init(int M, int N, int G_, int c_) { nM = M / BM; nN = N / BM; nwg = nM * nN; G = G_; c = c_; }
    __host__ __device__ bool next(int i, Unit& u) const {
        const long L = (long)i * G + c; if (L >= nwg) return false;
        int wgid = (int)L; { const int q = nwg / NXCD, r = nwg % NXCD, xcd = wgid % NXCD, off = wgid / NXCD; wgid = (xcd < r ? xcd * (q + 1) : r * (q + 1) + (xcd - r) * q) + off; }
        const int nig = WGM * nN, gid = wgid / nig, fm = gid * WGM, gsz = (nM - fm) < WGM ? (nM - fm) : WGM;
        u.pm = fm + ((wgid % nig) % gsz); u.pn = (wgid % nig) / gsz; return true;
    }
    __device__ __forceinline__ void a_ready(const Unit&) const {}
    __device__ __forceinline__ void done(const Unit&) const {}
};

__device__ __forceinline__ unsigned cvt_pk_bf16(float lo, float hi) { unsigned r; asm volatile("v_cvt_pk_bf16_f32 %0, %1, %2" : "=v"(r) : "v"(lo), "v"(hi)); return r; }
typedef float f32x2 __attribute__((ext_vector_type(2)));
constexpr float RMS_EPS_F = 1e-6f;
typedef unsigned u32x2 __attribute__((ext_vector_type(2)));
__device__ __forceinline__ float row_rstd16(const float* sq16, int row) {
    const f32x4* p = (const f32x4*)(sq16 + (size_t)row * 16);
    const f32x4 a = p[0], b = p[1], c = p[2], d = p[3];
    const float s = ((a[0] + a[1]) + (a[2] + a[3])) + ((b[0] + b[1]) + (b[2] + b[3])) + ((c[0] + c[1]) + (c[2] + c[3])) + ((d[0] + d[1]) + (d[2] + d[3]));
    return __builtin_amdgcn_rsqf(s * (1.0f / 1024.0f) + RMS_EPS_F);
}
__device__ __forceinline__ float fast_sigmoid(float x) { return __builtin_amdgcn_rcpf(1.0f + __expf(-x)); }
struct EpiEvenIn {
    static constexpr bool PERM = true, AFTER_DRAIN = false;
    bf16_t* O; const float* sq16; float* gates; const float* bgate;
    __device__ __forceinline__ void operator()(const f32x4 (&acc)[2][2][4][2], const Unit& u, int wr, int wc, int fr, int fq) const {
        const int row0 = u.pm * BM + wr * 64 + fr;
        if (u.pn < 14) {
            const int col0 = u.pn * BM + wc * 32 + 8 * fq;
#pragma unroll
            for (int ai = 0; ai < 2; ++ai)
#pragma unroll
                for (int m = 0; m < 4; ++m) { const int row = row0 + ai * HALF + m * 16; const float r = row_rstd16(sq16, row); bf16_t* rowp = O + (size_t)row * 3584 + col0;
#pragma unroll
                    for (int bj = 0; bj < 2; ++bj) { const f32x4 v0 = acc[ai][bj][m][0] * r, v1 = acc[ai][bj][m][1] * r;
                        u32x4 w; w.x = cvt_pk_bf16(v0[0], v0[1]); w.y = cvt_pk_bf16(v0[2], v0[3]); w.z = cvt_pk_bf16(v1[0], v1[1]); w.w = cvt_pk_bf16(v1[2], v1[3]);
                        *(u32x4*)(rowp + bj * HALF) = w; } }
        } else if (wc == 0 && fq == 0) {
            const f32x4 b0 = *(const f32x4*)(bgate), b1 = *(const f32x4*)(bgate + 4);
#pragma unroll
            for (int ai = 0; ai < 2; ++ai)
#pragma unroll
                for (int m = 0; m < 4; ++m) { const int row = row0 + ai * HALF + m * 16; const float r = row_rstd16(sq16, row);
                    *(f32x4*)(gates + (size_t)row * 8) = acc[ai][0][m][0] * r + b0; *(f32x4*)(gates + (size_t)row * 8 + 4) = acc[ai][0][m][1] * r + b1; }
        }
    }
};
struct EpiResid {
    static constexpr bool PERM = false, AFTER_DRAIN = false;
    float* x; bf16_t* xb; float* sq16;
    __device__ __forceinline__ void operator()(const f32x4 (&acc)[2][2][4][2], const Unit& u, int wr, int wc, int fr, int fq) const {
        const int row0 = u.pm * BM + wr * 64 + fr, col0 = u.pn * BM + wc * 32 + 4 * fq;
#pragma unroll
        for (int ai = 0; ai < 2; ++ai)
#pragma unroll
            for (int m = 0; m < 4; ++m) { const int row = row0 + ai * HALF + m * 16; const size_t off = (size_t)row * 1024 + col0; float ss = 0.f;
#pragma unroll
                for (int bj = 0; bj < 2; ++bj)
#pragma unroll
                    for (int n = 0; n < 2; ++n) { const size_t o = off + bj * HALF + n * 16; const f32x4 v = *(const f32x4*)(x + o) + acc[ai][bj][m][n];
                        *(f32x4*)(x + o) = v; u32x2 w; w.x = cvt_pk_bf16(v[0], v[1]); w.y = cvt_pk_bf16(v[2], v[3]); *(u32x2*)(xb + o) = w;
                        ss += (v[0] * v[0] + v[1] * v[1]) + (v[2] * v[2] + v[3] * v[3]); }
                ss += __shfl_xor(ss, 16); ss += __shfl_xor(ss, 32);
                if (fq == 0) sq16[(size_t)row * 16 + u.pn * 4 + wc] = ss;
                asm volatile("" ::: "memory"); }
    }
};
struct EpiSwiGLU {
    static constexpr bool PERM = true, AFTER_DRAIN = false;
    bf16_t* O; const float* sq16;
    __device__ __forceinline__ void operator()(const f32x4 (&acc)[2][2][4][2], const Unit& u, int wr, int wc, int fr, int fq) const {
        const int row0 = u.pm * BM + wr * 64 + fr, col0 = u.pn * HALF + wc * 32 + 8 * fq;
#pragma unroll
        for (int ai = 0; ai < 2; ++ai)
#pragma unroll
            for (int m = 0; m < 4; ++m) { const int row = row0 + ai * HALF + m * 16; const float r = row_rstd16(sq16, row);
                float h[8];
#pragma unroll
                for (int n = 0; n < 2; ++n)
#pragma unroll
                    for (int j = 0; j < 4; ++j) { const float g = acc[ai][0][m][n][j] * r, up = acc[ai][1][m][n][j] * r; h[4 * n + j] = g * fast_sigmoid(g) * up; }
                u32x4 w; w.x = cvt_pk_bf16(h[0], h[1]); w.y = cvt_pk_bf16(h[2], h[3]); w.z = cvt_pk_bf16(h[4], h[5]); w.w = cvt_pk_bf16(h[6], h[7]);
                *(u32x4*)(O + (size_t)row * 2816 + col0) = w; }
    }
};
struct EpiGeluZ {
    static constexpr bool PERM = true, AFTER_DRAIN = false;
    bf16_t* O; const float* sq16; float* vsq16;
    __device__ __forceinline__ void operator()(const f32x4 (&acc)[2][2][4][2], const Unit& u, int wr, int wc, int fr, int fq) const {
        const int row0 = u.pm * BM + wr * 64 + fr, col0 = u.pn * BM + wc * 32 + 8 * fq;
#pragma unroll
        for (int ai = 0; ai < 2; ++ai)
#pragma unroll
            for (int m = 0; m < 4; ++m) { const int row = row0 + ai * HALF + m * 16; const float r = row_rstd16(sq16, row); float ss = 0.f;
#pragma unroll
                for (int bj = 0; bj < 2; ++bj) { float z[8];
#pragma unroll
                    for (int n = 0; n < 2; ++n)
#pragma unroll
                        for (int j = 0; j < 4; ++j) { const float v = acc[ai][bj][m][n][j] * r; const float t = 1.5957691216057308f * (v + 0.044715f * v * v * v); const float zz = v * fast_sigmoid(t); z[4 * n + j] = zz; ss += zz * zz; }
                    u32x4 w; w.x = cvt_pk_bf16(z[0], z[1]); w.y = cvt_pk_bf16(z[2], z[3]); w.z = cvt_pk_bf16(z[4], z[5]); w.w = cvt_pk_bf16(z[6], z[7]);
                    *(u32x4*)(O + (size_t)row * 2048 + col0 + bj * HALF) = w; }
                if (u.pn >= 4) { ss += __shfl_xor(ss, 16); ss += __shfl_xor(ss, 32); if (fq == 0) vsq16[(size_t)row * 16 + (u.pn - 4) * 4 + wc] = ss; } }
    }
};
template <class Epi, class Sched, bool ALIGN_EPI = false, bool SP2 = false>
__device__ __forceinline__ void gemm_phase(PG8_LAS unsigned char* lds, const Gemm g, const Sched& S, const Epi& E) {
    int tid_ = threadIdx.x; asm volatile("" : "+v"(tid_)); const int tid = tid_, wid = __builtin_amdgcn_readfirstlane(tid >> 6), lane = tid & 63, wr = wid >> 2, wc = wid & 3, fr = lane & 15, fq = lane >> 4;
    const int K = g.K, nt = K / BK;
    unsigned voffA[2], voffB[2];
#pragma unroll
    for (int i = 0; i < 2; ++i) { int R, C; stage_rc(tid * 16 + i * 8192, R, C); const int Rb = Epi::PERM ? ((R & ~31) + perm32(R & 31)) : R;
        voffA[i] = (unsigned)(R * K + C) * 2u; voffB[i] = (unsigned)(Rb * K + C) * 2u; }
    const size_t kstep = (size_t)(BK * 2);
    const size_t hstep = (size_t)HALF * K * 2;
    const size_t tstep = 2 * hstep;
    const unsigned ldsw = (unsigned)wid * 1024u;
    const int aoff = lds_byte(wr * 64 + fr, fq * 8), boff = lds_byte(wc * 32 + fr, fq * 8);
#define PG8_SA(b, h) (((b) * 2 + (h)) * HTB)
#define PG8_SB(b, h) ((4 + (b) * 2 + (h)) * HTB)
#define PG8_STAGE(bufoff, gbase, voff) do { _Pragma("unroll") for (int _i = 0; _i < 2; ++_i) \
        __builtin_amdgcn_global_load_lds((const unsigned*)((const char*)(gbase) + (voff)[_i]), (PG8_LAS unsigned*)(lds + (bufoff) + ldsw + _i * 8192), 16, 0, 0); } while (0)
#define PG8_LDA(dst, b, h) do { _Pragma("unroll") for (int m = 0; m < 4; ++m) _Pragma("unroll") for (int k = 0; k < 2; ++k) dst[m][k] = *(const PG8_LAS bf16x8*)(lds + PG8_SA(b, h) + aoff + m * 2048 + k * 1024); } while (0)
#define PG8_LDB(dst, b, h) do { _Pragma("unroll") for (int n = 0; n < 2; ++n) _Pragma("unroll") for (int k = 0; k < 2; ++k) dst[n][k] = *(const PG8_LAS bf16x8*)(lds + PG8_SB(b, h) + boff + n * 2048 + k * 1024); } while (0)
#define PG8_MMA(ai, bj, At, Bt) do { __builtin_amdgcn_s_setprio(1); _Pragma("unroll") for (int m = 0; m < 4; ++m) _Pragma("unroll") for (int n = 0; n < 2; ++n) _Pragma("unroll") for (int k = 0; k < 2; ++k) \
        acc[ai][bj][m][n] = __builtin_amdgcn_mfma_f32_16x16x32_bf16(Bt[n][k], At[m][k], acc[ai][bj][m][n], 0, 0, 0); __builtin_amdgcn_s_setprio(0); } while (0)
#define PG8_WAIT_V(n) asm volatile("s_waitcnt vmcnt(" #n ")" ::: "memory")
#define PG8_WAIT_L(n) asm volatile("s_waitcnt lgkmcnt(" #n ")" ::: "memory")
#define PG8_BAR __builtin_amdgcn_s_barrier()
#define PG8_SCHED __builtin_amdgcn_sched_barrier(0)
    Unit cur, nxt; int ui = 0;
    if (!S.next(0, cur)) return;
    f32x4 acc[2][2][4][2];
#pragma unroll
    for (int a = 0; a < 2; ++a)
#pragma unroll
        for (int b = 0; b < 2; ++b)
#pragma unroll
            for (int m = 0; m < 4; ++m)
#pragma unroll
                for (int n = 0; n < 2; ++n) acc[a][b][m][n] = (f32x4){0.f, 0.f, 0.f, 0.f};
    bf16x8 At[4][2], B0[2][2], B1[2][2];
    const char* cA = (const char*)g.A + (size_t)cur.pm * tstep; const char* cB = (const char*)g.Bt + (size_t)cur.pn * tstep;
    S.a_ready(cur);
    if constexpr (SP2) {
        PG8_STAGE(PG8_SB(0, 0), cB, voffB); PG8_STAGE(PG8_SB(0, 1), cB + hstep, voffB); PG8_STAGE(PG8_SA(0, 0), cA, voffA); PG8_STAGE(PG8_SA(0, 1), cA + hstep, voffA);
        if (wr == 1) PG8_BAR;
        PG8_WAIT_V(2); PG8_BAR;
        PG8_STAGE(PG8_SB(1, 0), cB + kstep, voffB); PG8_STAGE(PG8_SA(1, 0), cA + kstep, voffA); PG8_STAGE(PG8_SB(1, 1), cB + hstep + kstep, voffB);
        PG8_WAIT_V(6); PG8_BAR;
    } else {
        PG8_STAGE(PG8_SB(0, 0), cB, voffB); PG8_STAGE(PG8_SA(0, 0), cA, voffA); PG8_STAGE(PG8_SB(0, 1), cB + hstep, voffB); PG8_STAGE(PG8_SA(0, 1), cA + hstep, voffA);
        if (wr == 1) PG8_BAR;
        PG8_WAIT_V(4); PG8_BAR;
        PG8_STAGE(PG8_SB(1, 0), cB + kstep, voffB); PG8_STAGE(PG8_SA(1, 0), cA + kstep, voffA); PG8_STAGE(PG8_SB(1, 1), cB + hstep + kstep, voffB);
        PG8_WAIT_V(6); PG8_BAR;
    }
    for (;;) {
        const bool has_next = S.next(ui + 1, nxt);
        const char* nA = has_next ? (const char*)g.A + (size_t)nxt.pm * tstep : cA; const char* nB = has_next ? (const char*)g.Bt + (size_t)nxt.pn * tstep : cB;
        for (int t = 0; t < nt; t += 2) {
            const bool last = (t == nt - 2);
            const char* a1 = cA + (size_t)(t + 1) * kstep;
            const char* a2 = last ? nA : cA + (size_t)(t + 2) * kstep; const char* b2 = last ? nB : cB + (size_t)(t + 2) * kstep;
            const char* a3 = a2 + kstep; const char* b3 = b2 + kstep;
            if (last && has_next) S.a_ready(nxt);
            if constexpr (SP2) {
            PG8_LDB(B0, 0, 0); PG8_LDB(B1, 0, 1); PG8_SCHED; PG8_LDA(At, 0, 0); PG8_STAGE(PG8_SA(1, 1), a1 + hstep, voffA);
            PG8_WAIT_V(8); PG8_WAIT_L(0); PG8_BAR; PG8_MMA(0, 0, At, B0); PG8_MMA(0, 1, At, B1); PG8_BAR; PG8_SCHED;
            PG8_LDA(At, 0, 1); PG8_STAGE(PG8_SB(0, 0), b2, voffB); PG8_STAGE(PG8_SB(0, 1), b2 + hstep, voffB); PG8_STAGE(PG8_SA(0, 0), a2, voffA);
            PG8_WAIT_V(8); PG8_WAIT_L(0); PG8_BAR; PG8_MMA(1, 0, At, B0); PG8_MMA(1, 1, At, B1); PG8_BAR; PG8_SCHED;
            PG8_LDB(B0, 1, 0); PG8_LDB(B1, 1, 1); PG8_SCHED; PG8_LDA(At, 1, 0); PG8_STAGE(PG8_SA(0, 1), a2 + hstep, voffA);
            PG8_WAIT_V(8); PG8_WAIT_L(0); PG8_BAR; PG8_MMA(0, 0, At, B0); PG8_MMA(0, 1, At, B1); PG8_BAR; PG8_SCHED;
            PG8_LDA(At, 1, 1); PG8_STAGE(PG8_SB(1, 0), b3, voffB); PG8_STAGE(PG8_SB(1, 1), b3 + hstep, voffB); PG8_STAGE(PG8_SA(1, 0), a3, voffA);
            PG8_WAIT_V(8); PG8_WAIT_L(0); PG8_BAR; PG8_MMA(1, 0, At, B0); PG8_MMA(1, 1, At, B1); PG8_BAR; PG8_SCHED;
            } else {
            PG8_LDB(B0, 0, 0); PG8_SCHED; PG8_LDA(At, 0, 0); PG8_STAGE(PG8_SA(1, 1), a1 + hstep, voffA);
            PG8_WAIT_L(8); PG8_BAR; PG8_WAIT_L(0); PG8_MMA(0, 0, At, B0); PG8_BAR; PG8_SCHED;
            PG8_LDB(B1, 0, 1); PG8_STAGE(PG8_SB(0, 0), b2, voffB);
            PG8_BAR; PG8_WAIT_L(0); PG8_MMA(0, 1, At, B1); PG8_BAR;
            PG8_LDA(At, 0, 1); PG8_STAGE(PG8_SA(0, 0), a2, voffA);
            PG8_BAR; PG8_WAIT_L(0); PG8_MMA(1, 0, At, B0); PG8_BAR; PG8_SCHED;
            PG8_STAGE(PG8_SB(0, 1), b2 + hstep, voffB);
            PG8_WAIT_V(6); PG8_BAR; PG8_MMA(1, 1, At, B1); PG8_BAR;
            PG8_LDB(B0, 1, 0); PG8_SCHED; PG8_LDA(At, 1, 0); PG8_STAGE(PG8_SA(0, 1), a2 + hstep, voffA);
            PG8_WAIT_L(8); PG8_BAR; PG8_WAIT_L(0); PG8_MMA(0, 0, At, B0); PG8_BAR; PG8_SCHED;
            PG8_LDB(B1, 1, 1); PG8_STAGE(PG8_SB(1, 0), b3, voffB);
            PG8_BAR; PG8_WAIT_L(0); PG8_MMA(0, 1, At, B1); PG8_BAR;
            PG8_LDA(At, 1, 1); PG8_STAGE(PG8_SA(1, 0), a3, voffA);
            PG8_BAR; PG8_WAIT_L(0); PG8_MMA(1, 0, At, B0); PG8_BAR; PG8_SCHED;
            PG8_STAGE(PG8_SB(1, 1), b3 + hstep, voffB);
            PG8_WAIT_V(6); PG8_BAR; PG8_MMA(1, 1, At, B1); PG8_BAR;
            }
        }
        if constexpr (ALIGN_EPI) { if (wr == 0) PG8_BAR; }
        if constexpr (!Epi::AFTER_DRAIN) { E(acc, cur, wr, wc, fr, fq); S.done(cur); }
        if (!has_next) break;
#pragma unroll
        for (int a = 0; a < 2; ++a)
#pragma unroll
            for (int b = 0; b < 2; ++b)
#pragma unroll
                for (int m = 0; m < 4; ++m)
#pragma unroll
                    for (int n = 0; n < 2; ++n) acc[a][b][m][n] = (f32x4){0.f, 0.f, 0.f, 0.f};
        cur = nxt; cA = nA; cB = nB; ++ui;
        if constexpr (ALIGN_EPI) { if (wr == 1) PG8_BAR; }
    }
    PG8_WAIT_V(0);
    if constexpr (!ALIGN_EPI) { if (wr == 0) PG8_BAR; }
    PG8_BAR;
    if constexpr (Epi::AFTER_DRAIN) { E.fused(acc, cur, wr, wc, fr, fq, lds, wid, lane); S.done(cur); }
#undef PG8_SA
#undef PG8_SB
#undef PG8_STAGE
#undef PG8_LDA
#undef PG8_LDB
#undef PG8_MMA
#undef PG8_WAIT_V
#undef PG8_WAIT_L
#undef PG8_BAR
#undef PG8_SCHED
}
}
constexpr int NWAVES = 8;
#ifndef MK_PER_PHASE
#define MK_PER_PHASE 0
#endif
constexpr int DM = 1024, NB = 2, SEQ = 8192, M = NB * SEQ, DEPTH = 4;
constexpr int CD = 512, HEADS = 4, HD = 128, MD = 512, EVEN_IN = 3592, EVEN_NP = 3840, EVEN_W = 3584, DFF = 2816, CHUNK = 128, NCH = SEQ / CHUNK, NUNIT = NB * HEADS * NCH;
constexpr float RMS_EPS = 1e-6f;
constexpr size_t MiB = 1u << 20;
constexpr size_t WS_CTL = 0, CTL_ZERO_BYTES = 1 * MiB;
constexpr size_t WS_SQ = 1 * MiB;
constexpr size_t WS_VSQ = 2 * MiB;
constexpr size_t WS_GATES = 3 * MiB;
constexpr size_t WS_NLOC = 4 * MiB;
constexpr size_t WS_NIN = 4 * MiB + 256 * 1024;
constexpr size_t WS_MLOC = 4 * MiB + 512 * 1024;
constexpr size_t WS_BL = WS_MLOC + 4096;
constexpr size_t WS_MIN = WS_BL + 4096;
constexpr size_t WS_WEI = 5 * MiB;
constexpr size_t WS_WEO = 20 * MiB;
constexpr size_t WS_WOI = 24 * MiB;
constexpr size_t WS_WOO = 32 * MiB;
constexpr size_t WS_WFI = 36 * MiB;
constexpr size_t WS_WFO = 80 * MiB;
constexpr size_t WS_XB = 102 * MiB;
constexpr size_t WS_Y = 134 * MiB;
constexpr size_t WS_BIG = 166 * MiB;
constexpr size_t WS_CLOC = 278 * MiB;
constexpr size_t WS_CIN = 310 * MiB;
constexpr size_t WS_END = 326 * MiB;
constexpr int CW_BAR = 4096;
constexpr int RING_BYTES = 131072;
constexpr int LDS_BYTES = 163840;
constexpr int LDSCTL_OFF = LDS_BYTES - 512, MISC_OFF = LDSCTL_OFF + 320;
constexpr int TSTR = 272;
constexpr int TILE_B = 128 * TSTR;
#define GAS __attribute__((address_space(1)))
#define LAS __attribute__((address_space(3)))
typedef unsigned short bf16;
typedef unsigned v4u __attribute__((ext_vector_type(4)));
typedef float f32x4 __attribute__((ext_vector_type(4)));
typedef short bf16x8 __attribute__((ext_vector_type(8)));
typedef GAS unsigned gu32;
typedef GAS unsigned long long gu64;
#define RLX_AGENT __ATOMIC_RELAXED, __HIP_MEMORY_SCOPE_AGENT
#define LDS_WAIT() asm volatile("s_waitcnt lgkmcnt(0)" ::: "memory")
#define VM_WAIT() asm volatile("s_waitcnt vmcnt(0)" ::: "memory")
__device__ __forceinline__ unsigned long long rt() { return __builtin_amdgcn_s_memrealtime(); }
__device__ __forceinline__ unsigned f2bf(float f) { unsigned u = __builtin_bit_cast(unsigned, f); return (u + 0x7fffu + ((u >> 16) & 1u)) >> 16; }
__device__ __forceinline__ unsigned pk2(float lo, float hi) { return f2bf(lo) | (f2bf(hi) << 16); }

#define XB_TMO      128
#define XB_XCNT(j)  (256  + 64 * (j))
#define XB_XSUB(j)  (1280 + 64 * (j))
#define XB_XGEN(j)  (2304 + 64 * (j))
#define XB_TOP      3328
#define XB_TOPGEN   3392
#define XCD_BAR_WORDS 3456
#define XB_SPIN_CAP (1u << 18)

__device__ __forceinline__ unsigned xb_ld(unsigned* p)              { return __hip_atomic_load(p, __ATOMIC_RELAXED, __HIP_MEMORY_SCOPE_AGENT); }
__device__ __forceinline__ unsigned xb_add(unsigned* p, unsigned v) { return __hip_atomic_fetch_add(p, v, __ATOMIC_RELAXED, __HIP_MEMORY_SCOPE_AGENT); }
__device__ __forceinline__ unsigned xb_xcc_id() { return (unsigned)__builtin_amdgcn_s_getreg((3 << 11) | 20) & 0xFu; }
#define XB_SPIN(cond, bar) do { unsigned _sp = 0; while (cond) { __builtin_amdgcn_s_sleep(1); \
    if ((++_sp & 255u) == 0u) { if (xb_ld(&(bar)[XB_TMO])) break; if (_sp > XB_SPIN_CAP) { atomicAdd(&(bar)[XB_TMO], 1u); break; } } } } while (0)

struct XcdBarrier {
    unsigned* bar; unsigned x;
    volatile LAS unsigned* st;
};

__device__ __forceinline__ XcdBarrier xcd_barrier_post(unsigned* bar, volatile LAS unsigned* st) {
    XcdBarrier b; b.bar = bar; b.x = xb_xcc_id(); b.st = st;
    if (threadIdx.x == 0) (void)xb_add(&bar[XB_XCNT(b.x)], 1u);
    return b;
}
__device__ __forceinline__ void xcd_barrier_complete(unsigned* bar, unsigned x, unsigned& nloc, unsigned& nx) {
    const unsigned G = gridDim.x * gridDim.y * gridDim.z;
    unsigned sum, cnt, mine, sp = 0u;
    for (;;) {
        sum = 0u; cnt = 0u; mine = 0u;
#pragma unroll
        for (unsigned j = 0; j < 16; ++j) { const unsigned c = xb_ld(&bar[XB_XCNT(j)]); sum += c; cnt += (c > 0u) ? 1u : 0u; mine = (j == x) ? c : mine; }
        if (sum == G) break;
        __builtin_amdgcn_s_sleep(1);
        if ((++sp & 255u) == 0u) { if (xb_ld(&bar[XB_TMO])) break; if (sp > XB_SPIN_CAP) { atomicAdd(&bar[XB_TMO], 1u); break; } }
    }
    nloc = mine > 0u ? mine : 1u; nx = cnt > 0u ? cnt : 1u;
}

__device__ __forceinline__ void xcd_barrier(const XcdBarrier& b) {
    asm volatile("s_waitcnt vmcnt(0)" ::: "memory");
    __syncthreads();
    if (threadIdx.x == 0) {
        unsigned* bar = b.bar;
        __builtin_amdgcn_s_waitcnt(0);
        unsigned nloc = b.st[0], nx = b.st[1];
        if (nloc == 0u) { xcd_barrier_complete(bar, b.x, nloc, nx); b.st[0] = nloc; b.st[1] = nx; }
        const unsigned old = xb_add(&bar[XB_XSUB(b.x)], 1u);
        const unsigned gen = old / nloc;
        if (old + 1u == (gen + 1u) * nloc) {
            __builtin_amdgcn_fence(__ATOMIC_RELEASE, "agent");
            asm volatile("s_waitcnt vmcnt(0)" ::: "memory");
            const unsigned og = xb_add(&bar[XB_TOP], 1u);
            const unsigned tg = og / nx;
            if (og + 1u == (tg + 1u) * nx) xb_add(&bar[XB_TOPGEN], 1u);
            else XB_SPIN(xb_ld(&bar[XB_TOPGEN]) == tg, bar);
            __builtin_amdgcn_fence(__ATOMIC_ACQUIRE, "agent");
            xb_add(&bar[XB_XGEN(b.x)], 1u);
            asm volatile("s_waitcnt vmcnt(0)" ::: "memory");
        } else {
            XB_SPIN(xb_ld(&bar[XB_XGEN(b.x)]) == gen, bar);
            __builtin_amdgcn_fence(__ATOMIC_ACQUIRE, "agent");
            asm volatile("s_waitcnt vmcnt(0)" ::: "memory");
        }
    }
    __syncthreads();
}
typedef unsigned u32x2 __attribute__((ext_vector_type(2)));
struct Frame {
    LAS unsigned char* lds;
    volatile LAS unsigned* MISC;
    gu32* ctl;
    int vcu, G;
    unsigned char* ws;
    const float* in[16];
    float* x;
};
#define OPQ_TID() int tid = threadIdx.x; asm volatile("" : "+v"(tid)); const int lane = tid & 63, w = __builtin_amdgcn_readfirstlane(tid >> 6), fr = lane & 15, fq = lane >> 4; (void)w; (void)fr; (void)fq
__device__ __forceinline__ float wave_sum(float v) {
#pragma unroll
    for (int o = 1; o < 64; o <<= 1) v += __shfl_xor(v, o);
    return v;
}
__device__ __forceinline__ float wave_max(float v) {
#pragma unroll
    for (int o = 1; o < 64; o <<= 1) v = fmaxf(v, __shfl_xor(v, o));
    return v;
}
__device__ __forceinline__ float bf2f(unsigned short h) { return __builtin_bit_cast(float, (unsigned)h << 16); }
__device__ __forceinline__ float logsig(float x) { return fminf(x, 0.f) - log1pf(expf(-fabsf(x))); }

__device__ __forceinline__ void p0_item(const float* W, int ldw, int K, int sc0, bf16* Bt, int dr0, int k0, const float* gain, float cs, LAS float* scr, int lane) {
#pragma unroll 8
    for (int i = 0; i < 32; ++i) { const int kk = 2 * i + (lane >> 5); const float gk = gain ? gain[k0 + kk] : 1.0f; scr[kk * 33 + (lane & 31)] = W[(size_t)(k0 + kk) * ldw + sc0 + (lane & 31)] * gk; }
    LDS_WAIT(); asm volatile("" ::: "memory");
    const int c = lane & 7;
#pragma unroll
    for (int j = 0; j < 4; ++j) { const int n = (lane >> 3) + 8 * j; const LAS float* s = scr + (8 * c) * 33 + n;
        v4u o; o.x = pk2(s[0 * 33] * cs, s[1 * 33] * cs); o.y = pk2(s[2 * 33] * cs, s[3 * 33] * cs); o.z = pk2(s[4 * 33] * cs, s[5 * 33] * cs); o.w = pk2(s[6 * 33] * cs, s[7 * 33] * cs);
        *(GAS v4u*)(Bt + (size_t)(dr0 + n) * K + k0 + 8 * c) = o; }
    LDS_WAIT(); asm volatile("" ::: "memory");
}
__device__ __forceinline__ void p0_prologue(Frame& F, const float* xin) {
    OPQ_TID();
    LAS float* scr = (LAS float*)(F.lds + w * 16384);
    const int gw = F.vcu * NWAVES + w, NGW = F.G * NWAVES;
    const float* norm_mix = F.in[1]; const float* norm_ffn = F.in[2];
    constexpr int I_EI = 112 * 16, I_EO = 32 * 16, I_OI = 64 * 16, I_OO = 32 * 16, I_FI = 176 * 16, I_FO = 32 * 44;
    constexpr int N0 = 2 * I_EI, N1 = N0 + 2 * I_EO, N2 = N1 + 2 * I_OI, N3 = N2 + 2 * I_OO, N4 = N3 + 4 * I_FI, N5 = N4 + 4 * I_FO, NG = N5 + 32;
    for (int it = gw; it < NG; it += NGW) {
        if (it < N0) { const int j = it / I_EI, r = it % I_EI, kb = r / 112, nb = r % 112, c0 = 32 * nb;
            p0_item(F.in[3] + (size_t)j * DM * EVEN_IN, EVEN_IN, DM, c0, (bf16*)(F.ws + WS_WEI) + (size_t)j * EVEN_NP * DM, c0, 64 * kb, norm_mix + (size_t)(2 * j) * DM, (c0 >= 2048 && c0 < 2560) ? 0.08838834764831845f : 1.0f, scr, lane);
        } else if (it < N1) { const int q = it - N0, j = q / I_EO, r = q % I_EO, kb = r / 32, nb = r % 32;
            p0_item(F.in[7] + (size_t)j * DM * DM, DM, DM, 32 * nb, (bf16*)(F.ws + WS_WEO) + (size_t)j * DM * DM, 32 * nb, 64 * kb, nullptr, 1.0f, scr, lane);
        } else if (it < N2) { const int q = it - N1, j = q / I_OI, r = q % I_OI, kb = r / 64, nb = r % 64;
            p0_item(F.in[8] + (size_t)j * DM * 2048, 2048, DM, 32 * nb, (bf16*)(F.ws + WS_WOI) + (size_t)j * 2048 * DM, 32 * nb, 64 * kb, norm_mix + (size_t)(2 * j + 1) * DM, 1.0f, scr, lane);
        } else if (it < N3) { const int q = it - N2, j = q / I_OO, r = q % I_OO, kb = r / 32, nb = r % 32;
            p0_item(F.in[12] + (size_t)j * DM * DM, DM, DM, 32 * nb, (bf16*)(F.ws + WS_WOO) + (size_t)j * DM * DM, 32 * nb, 64 * kb, nullptr, 1.0f, scr, lane);
        } else if (it < N4) { const int q = it - N3, l = q / I_FI, r = q % I_FI, kb = r / 176, nb = r % 176, c0 = 32 * nb;
            const int up = c0 >= DFF, cc = up ? c0 - DFF : c0, dr = 256 * (cc >> 7) + (up ? 128 : 0) + (cc & 127);
            p0_item(F.in[13] + (size_t)l * DM * 2 * DFF, 2 * DFF, DM, c0, (bf16*)(F.ws + WS_WFI) + (size_t)l * 2 * DFF * DM, dr, 64 * kb, norm_ffn + (size_t)l * DM, 1.0f, scr, lane);
        } else if (it < N5) { const int q = it - N4, l = q / I_FO, r = q % I_FO, kb = r / 32, nb = r % 32;
            p0_item(F.in[14] + (size_t)l * DFF * DM, DM, DFF, 32 * nb, (bf16*)(F.ws + WS_WFO) + (size_t)l * DM * DFF, 32 * nb, 64 * kb, nullptr, 1.0f, scr, lane);
        } else { const int q = it - N5, j = q >> 4, k0 = 64 * (q & 15);
            const float* W = F.in[3] + (size_t)j * DM * EVEN_IN; bf16* Bt = (bf16*)(F.ws + WS_WEI) + (size_t)j * EVEN_NP * DM; const float* gain = norm_mix + (size_t)(2 * j) * DM;
#pragma unroll
            for (int e = 0; e < 8; ++e) { const int id = lane + 64 * e, col = id & 7, kk = k0 + (id >> 3);
                Bt[(size_t)(EVEN_W + col) * DM + kk] = (bf16)f2bf(W[(size_t)kk * EVEN_IN + EVEN_W + col] * gain[kk]); }
        }
    }
    float* sq16 = (float*)(F.ws + WS_SQ); bf16* xb = (bf16*)(F.ws + WS_XB);
    for (int m = gw; m < M; m += NGW) {
        const GAS f32x4* xr = (const GAS f32x4*)(xin + (size_t)m * DM) + lane; GAS f32x4* xo = (GAS f32x4*)(F.x + (size_t)m * DM) + lane;
        GAS u32x2* bo = (GAS u32x2*)(xb + (size_t)m * DM) + lane; float s = 0.f;
#pragma unroll
        for (int j = 0; j < 4; ++j) { const f32x4 v = xr[64 * j]; xo[64 * j] = v; u32x2 w; w.x = pk2(v.x, v.y); w.y = pk2(v.z, v.w); bo[64 * j] = w; s += (v.x * v.x + v.y * v.y) + (v.z * v.z + v.w * v.w); }
        s = wave_sum(s);
        if (lane < 16) sq16[(size_t)m * 16 + lane] = (lane == 0) ? s : 0.f;
    }
}
__device__ __forceinline__ void final_norm(Frame& F) {
    OPQ_TID();
    const int gw = F.vcu * NWAVES + w, NGW = F.G * NWAVES;
    const float* sq16 = (const float*)(F.ws + WS_SQ); const float* gf = F.in[15];
    f32x4 g[4];
#pragma unroll
    for (int j = 0; j < 4; ++j) g[j] = ((const f32x4*)gf)[lane + 64 * j];
    for (int m = gw; m < M; m += NGW) {
        const float r = pg8::row_rstd16(sq16, m);
        GAS f32x4* xo = (GAS f32x4*)(F.x + (size_t)m * DM) + lane;
#pragma unroll
        for (int j = 0; j < 4; ++j) { f32x4 v = xo[64 * j]; v = v * r * g[j]; xo[64 * j] = v; }
    }
}
__device__ __forceinline__ void scan128_add(float& v0, float& v1, int lane) {
#pragma unroll
    for (int o = 1; o < 64; o <<= 1) { const float a = __shfl_up(v0, o), b = __shfl_up(v1, o); if (lane >= o) { v0 += a; v1 += b; } }
    v1 += __shfl(v0, 63);
}
__device__ __forceinline__ void scan128_max(float& v0, float& v1, int lane) {
#pragma unroll
    for (int o = 1; o < 64; o <<= 1) { const float a = __shfl_up(v0, o), b = __shfl_up(v1, o); if (lane >= o) { v0 = fmaxf(v0, a); v1 = fmaxf(v1, b); } }
    v1 = fmaxf(v1, __shfl(v0, 63));
}
__device__ __forceinline__ void stage_tr(LAS unsigned char* tile, const bf16* src, int ld, const LAS float* sc, int tid) {
#pragma unroll
    for (int i = 0; i < 4; ++i) { const int id = tid + 512 * i, s = id & 127, dc = id >> 7;
        const v4u v = *(const GAS v4u*)(src + (size_t)s * ld + 8 * dc); const float f = sc ? sc[s] : 1.0f;
        const unsigned w[4] = {v.x, v.y, v.z, v.w};
#pragma unroll
        for (int j = 0; j < 4; ++j) { unsigned lo = w[j] & 0xffffu, hi = w[j] >> 16;
            if (sc) { lo = f2bf(bf2f((unsigned short)lo) * f); hi = f2bf(bf2f((unsigned short)hi) * f); }
            *(LAS unsigned short*)(tile + (8 * dc + 2 * j) * TSTR + 2 * s) = (unsigned short)lo; *(LAS unsigned short*)(tile + (8 * dc + 2 * j + 1) * TSTR + 2 * s) = (unsigned short)hi; } }
}
__device__ __forceinline__ void stage_rows(LAS unsigned char* tile, const bf16* src, int ld, int tid) {
#pragma unroll
    for (int i = 0; i < 4; ++i) { const int id = tid + 512 * i, r = id >> 4, dc = id & 15;
        *(LAS v4u*)(tile + r * TSTR + 16 * dc) = *(const GAS v4u*)(src + (size_t)r * ld + 8 * dc); }
}
#define FRAG(tile, row, kk, fq) (*(const LAS bf16x8*)((tile) + (row) * TSTR + (32 * (kk) + 8 * (fq)) * 2))

__device__ __forceinline__ void mlstm_phase_a(Frame& F) {
    LAS unsigned char* TK = F.lds; LAS unsigned char* TV = F.lds + TILE_B; LAS float* aS = (LAS float*)(F.lds + 2 * TILE_B);
    const bf16* proj = (const bf16*)(F.ws + WS_BIG); const float* gates = (const float*)(F.ws + WS_GATES);
    float* Cloc = (float*)(F.ws + WS_CLOC); float* nloc = (float*)(F.ws + WS_NLOC); float* mloc = (float*)(F.ws + WS_MLOC); float* bLv = (float*)(F.ws + WS_BL);
    for (int u = F.vcu; u < NUNIT; u += F.G) {
        OPQ_TID();
        const int bh = u >> 6, c = u & 63, b = bh >> 2, h = bh & 3, row0 = b * SEQ + c * CHUNK;
        if (w == 0) {
            const float i0 = gates[(size_t)(row0 + lane) * 8 + h], i1 = gates[(size_t)(row0 + lane + 64) * 8 + h];
            float b0 = logsig(gates[(size_t)(row0 + lane) * 8 + 4 + h]), b1 = logsig(gates[(size_t)(row0 + lane + 64) * 8 + 4 + h]);
            scan128_add(b0, b1, lane);
            const float bL = __shfl(b1, 63);
            const float w0 = bL - b0 + i0, w1 = bL - b1 + i1;
            const float ml = wave_max(fmaxf(w0, w1));
            aS[lane] = __expf(w0 - ml); aS[lane + 64] = __expf(w1 - ml);
            if (lane == 0) { mloc[u] = ml; bLv[u] = bL; }
        }
        __syncthreads();
        stage_tr(TK, proj + (size_t)row0 * EVEN_W + 2048 + h * HD, EVEN_W, aS, tid);
        stage_tr(TV, proj + (size_t)row0 * EVEN_W + 2560 + h * HD, EVEN_W, nullptr, tid);
        __syncthreads();
        {
            const int d = tid >> 2, q = tid & 3; float s = 0.f;
#pragma unroll
            for (int i = 0; i < 4; ++i) { const bf16x8 v = *(const LAS bf16x8*)(TK + d * TSTR + (32 * q + 8 * i) * 2);
#pragma unroll
                for (int j = 0; j < 8; ++j) s += bf2f((unsigned short)v[j]); }
            s += __shfl_xor(s, 1); s += __shfl_xor(s, 2);
            if (q == 0) nloc[(size_t)u * HD + d] = s;
        }
        bf16x8 vf[4];
#pragma unroll
        for (int kk = 0; kk < 4; ++kk) vf[kk] = FRAG(TV, 16 * w + fr, kk, fq);
#pragma unroll
        for (int db = 0; db < 8; ++db) { f32x4 acc = {0.f, 0.f, 0.f, 0.f};
#pragma unroll
            for (int kk = 0; kk < 4; ++kk) acc = __builtin_amdgcn_mfma_f32_16x16x32_bf16(FRAG(TK, 16 * db + fr, kk, fq), vf[kk], acc, 0, 0, 0);
            *(GAS f32x4*)(Cloc + (size_t)u * (HD * HD) + (size_t)(16 * w + fr) * HD + 16 * db + 4 * fq) = acc; }
        __syncthreads();
    }
}
__device__ __forceinline__ void mlstm_scan_and_conv(Frame& F, const float* wconv) {
    const float* Cloc = (const float*)(F.ws + WS_CLOC); const float* nloc = (const float*)(F.ws + WS_NLOC); const float* mloc = (const float*)(F.ws + WS_MLOC); const float* bLv = (const float*)(F.ws + WS_BL);
    bf16* Cin = (bf16*)(F.ws + WS_CIN); float* nin = (float*)(F.ws + WS_NIN); float* minv = (float*)(F.ws + WS_MIN);
    OPQ_TID();
    const int NT = F.G * 512;
    for (int g = F.vcu * 512 + tid; g < NB * HEADS * (HD * HD + HD); g += NT) {
        const bool isn = g >= NB * HEADS * HD * HD; const int q = isn ? g - NB * HEADS * HD * HD : g;
        const int bh = isn ? (q >> 7) : (q >> 14), idx = isn ? (q & 127) : (q & 16383);
        float C = 0.f, m = 0.f;
        for (int c0 = 0; c0 < NCH; c0 += 8) {
            float cl[8], ml[8], bl[8];
#pragma unroll
            for (int i = 0; i < 8; ++i) { const int u = bh * NCH + c0 + i; cl[i] = isn ? nloc[(size_t)u * HD + idx] : Cloc[(size_t)u * (HD * HD) + idx]; ml[i] = mloc[u]; bl[i] = bLv[u]; }
#pragma unroll
            for (int i = 0; i < 8; ++i) { const int u = bh * NCH + c0 + i;
                if (isn) { nin[(size_t)u * HD + idx] = C; if (idx == 0) minv[u] = m; } else Cin[(size_t)u * (HD * HD) + idx] = (bf16)f2bf(C);
                const float mn = fmaxf(bl[i] + m, ml[i]);
                C = __expf(bl[i] + m - mn) * C + __expf(ml[i] - mn) * cl[i]; m = mn; }
        }
    }
    const bf16* proj = (const bf16*)(F.ws + WS_BIG); bf16* Y = (bf16*)(F.ws + WS_Y);
    for (int g = F.vcu * 512 + tid; g < M * (CD / 8); g += NT) {
        const int t = g >> 6, c8 = (g & 63) * 8, ts = t & (SEQ - 1);
        float acc[8];
#pragma unroll
        for (int j = 0; j < 8; ++j) acc[j] = 0.f;
#pragma unroll
        for (int jj = 0; jj < 3; ++jj) { if (ts - 2 + jj >= 0) { const bf16* p = proj + (size_t)(t - 2 + jj) * EVEN_W;
                const v4u cg = *(const GAS v4u*)(p + CD + c8), xa = *(const GAS v4u*)(p + 2 * CD + c8);
                const unsigned cw[4] = {cg.x, cg.y, cg.z, cg.w}, xw[4] = {xa.x, xa.y, xa.z, xa.w};
#pragma unroll
                for (int j = 0; j < 4; ++j) { acc[2 * j] += wconv[jj * CD + c8 + 2 * j] * (bf2f((unsigned short)(cw[j] & 0xffffu)) * bf2f((unsigned short)(xw[j] & 0xffffu)));
                    acc[2 * j + 1] += wconv[jj * CD + c8 + 2 * j + 1] * (bf2f((unsigned short)(cw[j] >> 16)) * bf2f((unsigned short)(xw[j] >> 16))); } } }
        const v4u bg = *(const GAS v4u*)(proj + (size_t)t * EVEN_W + c8); const unsigned bw[4] = {bg.x, bg.y, bg.z, bg.w}; v4u o; unsigned ow[4];
#pragma unroll
        for (int j = 0; j < 4; ++j) ow[j] = pk2(bf2f((unsigned short)(bw[j] & 0xffffu)) * acc[2 * j], bf2f((unsigned short)(bw[j] >> 16)) * acc[2 * j + 1]);
        o.x = ow[0]; o.y = ow[1]; o.z = ow[2]; o.w = ow[3];
        *(GAS v4u*)(Y + (size_t)t * DM + c8) = o;
    }
}
__device__ __forceinline__ void mlstm_phase_c(Frame& F, const float* ghead) {
    LAS unsigned char* TK = F.lds; LAS unsigned char* TV = F.lds + TILE_B; LAS unsigned char* TC = F.lds + 2 * TILE_B; LAS unsigned char* TS = F.lds + 3 * TILE_B;
    LAS float* gS = (LAS float*)(F.lds + 4 * TILE_B); LAS float* mxS = gS + 128; LAS float* bS = gS + 256; LAS float* nS = gS + 384;
    const bf16* proj = (const bf16*)(F.ws + WS_BIG); const float* gates = (const float*)(F.ws + WS_GATES);
    const bf16* Cin = (const bf16*)(F.ws + WS_CIN); const float* nin = (const float*)(F.ws + WS_NIN); const float* minv = (const float*)(F.ws + WS_MIN);
    bf16* Y = (bf16*)(F.ws + WS_Y);
    for (int u = F.vcu; u < NUNIT; u += F.G) {
        OPQ_TID();
        const int bh = u >> 6, c = u & 63, b = bh >> 2, h = bh & 3, row0 = b * SEQ + c * CHUNK;
        const float m_in = minv[u];
        if (w == 0) {
            const float i0 = gates[(size_t)(row0 + lane) * 8 + h], i1 = gates[(size_t)(row0 + lane + 64) * 8 + h];
            float b0 = logsig(gates[(size_t)(row0 + lane) * 8 + 4 + h]), b1 = logsig(gates[(size_t)(row0 + lane + 64) * 8 + 4 + h]);
            scan128_add(b0, b1, lane);
            const float g0 = i0 - b0, g1 = i1 - b1; float p0 = g0, p1 = g1;
            scan128_max(p0, p1, lane);
            gS[lane] = g0; gS[lane + 64] = g1; mxS[lane] = fmaxf(m_in, p0); mxS[lane + 64] = fmaxf(m_in, p1); bS[lane] = b0; bS[lane + 64] = b1;
        } else if (w == 1) { nS[lane] = nin[(size_t)u * HD + lane]; nS[lane + 64] = nin[(size_t)u * HD + lane + 64]; }
        const int t = 16 * w + fr;
        bf16x8 qf[4];
#pragma unroll
        for (int kk = 0; kk < 4; ++kk) qf[kk] = *(const GAS bf16x8*)(proj + (size_t)(row0 + t) * EVEN_W + 1536 + h * HD + 32 * kk + 8 * fq);
        stage_rows(TK, proj + (size_t)row0 * EVEN_W + 2048 + h * HD, EVEN_W, tid);
        stage_rows(TC, Cin + (size_t)u * (HD * HD), HD, tid);
        stage_tr(TV, proj + (size_t)row0 * EVEN_W + 2560 + h * HD, EVEN_W, nullptr, tid);
        __syncthreads();
        const float mx_t = mxS[t], b_t = bS[t], inter = __expf(m_in - mx_t);
        float den1 = 0.f;
#pragma unroll
        for (int sb = 0; sb < 8; ++sb) {
            u32x2 pk = {0u, 0u};
            if (sb <= w) { f32x4 acc = {0.f, 0.f, 0.f, 0.f};
#pragma unroll
                for (int kk = 0; kk < 4; ++kk) acc = __builtin_amdgcn_mfma_f32_16x16x32_bf16(FRAG(TK, 16 * sb + fr, kk, fq), qf[kk], acc, 0, 0, 0);
                float sv[4];
#pragma unroll
                for (int r = 0; r < 4; ++r) { const int s = 16 * sb + 4 * fq + r; const float e = __expf(gS[s] - mx_t); sv[r] = (s <= t) ? acc[r] * e : 0.f; den1 += sv[r]; }
                pk.x = pk2(sv[0], sv[1]); pk.y = pk2(sv[2], sv[3]); }
            *(LAS u32x2*)(TS + t * TSTR + (16 * sb + 4 * fq) * 2) = pk;
        }
        den1 += __shfl_xor(den1, 16); den1 += __shfl_xor(den1, 32);
        float qn = 0.f;
#pragma unroll
        for (int kk = 0; kk < 4; ++kk)
#pragma unroll
            for (int j = 0; j < 8; ++j) qn += bf2f((unsigned short)qf[kk][j]) * nS[32 * kk + 8 * fq + j];
        qn += __shfl_xor(qn, 16); qn += __shfl_xor(qn, 32);
        const float den = den1 + inter * qn, m_t = b_t + mx_t;
        const float rden = 1.0f / fmaxf(fabsf(den), __expf(-m_t));
        bf16x8 sf[4];
#pragma unroll
        for (int kk = 0; kk < 4; ++kk) sf[kk] = FRAG(TS, t, kk, fq);
        float hh[32]; float ssq = 0.f;
#pragma unroll
        for (int eb = 0; eb < 8; ++eb) { f32x4 a1 = {0.f, 0.f, 0.f, 0.f}, a2 = {0.f, 0.f, 0.f, 0.f};
#pragma unroll
            for (int kk = 0; kk < 4; ++kk) { if (2 * kk <= w) a1 = __builtin_amdgcn_mfma_f32_16x16x32_bf16(FRAG(TV, 16 * eb + fr, kk, fq), sf[kk], a1, 0, 0, 0);
                a2 = __builtin_amdgcn_mfma_f32_16x16x32_bf16(FRAG(TC, 16 * eb + fr, kk, fq), qf[kk], a2, 0, 0, 0); }
#pragma unroll
            for (int r = 0; r < 4; ++r) { const float v = (a1[r] + inter * a2[r]) * rden; hh[4 * eb + r] = v; ssq += v * v; } }
        ssq += __shfl_xor(ssq, 16); ssq += __shfl_xor(ssq, 32);
        const float rs = __builtin_amdgcn_rsqf(ssq * (1.0f / 128.0f) + RMS_EPS);
#pragma unroll
        for (int eb = 0; eb < 8; ++eb) { const int e = 16 * eb + 4 * fq;
            const u32x2 ov = *(const GAS u32x2*)(proj + (size_t)(row0 + t) * EVEN_W + 3072 + h * HD + e); const f32x4 gh = *(const f32x4*)(ghead + h * HD + e);
            const float o0 = bf2f((unsigned short)(ov.x & 0xffffu)), o1 = bf2f((unsigned short)(ov.x >> 16)), o2 = bf2f((unsigned short)(ov.y & 0xffffu)), o3 = bf2f((unsigned short)(ov.y >> 16));
            u32x2 y; y.x = pk2(pg8::fast_sigmoid(o0) * hh[4 * eb] * rs * gh[0], pg8::fast_sigmoid(o1) * hh[4 * eb + 1] * rs * gh[1]);
            y.y = pk2(pg8::fast_sigmoid(o2) * hh[4 * eb + 2] * rs * gh[2], pg8::fast_sigmoid(o3) * hh[4 * eb + 3] * rs * gh[3]);
            *(GAS u32x2*)(Y + (size_t)(row0 + t) * DM + MD + h * HD + e) = y; }
        __syncthreads();
    }
}
__device__ __forceinline__ void sgu_phase(Frame& F, const float* gv, const float* wsp, const float* bsp) {
    LAS unsigned char* TW = F.lds; LAS unsigned char* TV = F.lds + TILE_B; LAS float* rS = (LAS float*)(F.lds + 2 * TILE_B);
    const bf16* Z = (const bf16*)(F.ws + WS_BIG); const float* vsq16 = (const float*)(F.ws + WS_VSQ); bf16* Y = (bf16*)(F.ws + WS_Y);
    for (int u = F.vcu; u < (M / CHUNK) * 8; u += F.G) {
        OPQ_TID();
        const int cb = u >> 3, g = u & 7, row0 = cb * CHUNK;
        if (tid < 128) rS[tid] = pg8::row_rstd16(vsq16, row0 + tid);
        __syncthreads();
#pragma unroll
        for (int i = 0; i < 8; ++i) { const int id = tid + 512 * i, t = id >> 5, s4 = (id & 31) * 4;
            const f32x4 wv = *(const f32x4*)(wsp + ((size_t)g * CHUNK + t) * CHUNK + s4); float v[4];
#pragma unroll
            for (int j = 0; j < 4; ++j) v[j] = (s4 + j <= t) ? wv[j] * rS[s4 + j] : 0.f;
            u32x2 pk; pk.x = pk2(v[0], v[1]); pk.y = pk2(v[2], v[3]);
            *(LAS u32x2*)(TW + t * TSTR + s4 * 2) = pk; }
        stage_tr(TV, Z + (size_t)row0 * 2048 + 1024 + g * 128, 2048, nullptr, tid);
        __syncthreads();
        const int t = 16 * w + fr;
        bf16x8 wf[4];
#pragma unroll
        for (int kk = 0; kk < 4; ++kk) wf[kk] = FRAG(TW, t, kk, fq);
        const float bst = bsp[g * CHUNK + t];
#pragma unroll
        for (int db = 0; db < 8; ++db) { f32x4 acc = {0.f, 0.f, 0.f, 0.f};
#pragma unroll
            for (int kk = 0; kk < 4; ++kk) if (2 * kk <= w) acc = __builtin_amdgcn_mfma_f32_16x16x32_bf16(FRAG(TV, 16 * db + fr, kk, fq), wf[kk], acc, 0, 0, 0);
            const int col = g * 128 + 16 * db + 4 * fq;
            const f32x4 gvv = *(const f32x4*)(gv + col); const u32x2 uv = *(const GAS u32x2*)(Z + (size_t)(row0 + t) * 2048 + col);
            const float u0 = bf2f((unsigned short)(uv.x & 0xffffu)), u1 = bf2f((unsigned short)(uv.x >> 16)), u2 = bf2f((unsigned short)(uv.y & 0xffffu)), u3 = bf2f((unsigned short)(uv.y >> 16));
            u32x2 y; y.x = pk2(u0 * (acc[0] * gvv[0] + bst), u1 * (acc[1] * gvv[1] + bst)); y.y = pk2(u2 * (acc[2] * gvv[2] + bst), u3 * (acc[3] * gvv[3] + bst));
            *(GAS u32x2*)(Y + (size_t)(row0 + t) * DM + col) = y; }
        __syncthreads();
    }
}
struct Args { const float* in[16]; float* out; unsigned char* ws; int ph_lo, ph_hi; };
constexpr int N_PHASES = 26;
enum Kind { K_P0, K_E1, K_E2, K_E3, K_E4, K_RESMIX, K_F1, K_RESFFN, K_O1, K_O2, K_FINAL };
__device__ __forceinline__ void decode_phase(int p, int& kind, int& layer) {
    if (p == 0) { kind = K_P0; layer = 0; return; }
    if (p == 25) { kind = K_FINAL; layer = 0; return; }
    int q = p - 1; const int pair = q / 12; q -= pair * 12;
    if (q < 7) { layer = 2 * pair; kind = q == 0 ? K_E1 : q == 1 ? K_E2 : q == 2 ? K_E3 : q == 3 ? K_E4 : q == 4 ? K_RESMIX : q == 5 ? K_F1 : K_RESFFN; }
    else { layer = 2 * pair + 1; q -= 7; kind = q == 0 ? K_O1 : q == 1 ? K_O2 : q == 2 ? K_RESMIX : q == 3 ? K_F1 : K_RESFFN; }
}
__global__ void __launch_bounds__(NWAVES * 64, 2) trunk_fwd(Args args) {
    extern __shared__ __attribute__((aligned(16))) unsigned char lds[];
    Frame F;
    F.lds = (LAS unsigned char*)lds;
    F.MISC = (volatile LAS unsigned*)(F.lds + MISC_OFF);
    F.G = gridDim.x; { const int bx = blockIdx.x; F.vcu = (F.G % 8 == 0) ? (bx % 8) * (F.G / 8) + bx / 8 : bx; }
    F.ws = args.ws; F.ctl = (gu32*)(args.ws + WS_CTL); F.x = args.out;
#pragma unroll
    for (int i = 0; i < 16; ++i) F.in[i] = args.in[i];
    for (int u = threadIdx.x; u < (LDS_BYTES - LDSCTL_OFF) / 4; u += NWAVES * 64) ((LAS unsigned*)(F.lds + LDSCTL_OFF))[u] = 0u;
    __syncthreads();
    XcdBarrier bar; bar.bar = (unsigned*)(F.ctl + CW_BAR); bar.x = 0; bar.st = nullptr;
    if (!MK_PER_PHASE) bar = xcd_barrier_post((unsigned*)(F.ctl + CW_BAR), F.MISC + 8);
    bf16* xb = (bf16*)(F.ws + WS_XB); bf16* Yb = (bf16*)(F.ws + WS_Y); bf16* big = (bf16*)(F.ws + WS_BIG);
    float* sq16 = (float*)(F.ws + WS_SQ);
    for (int p = args.ph_lo; p < args.ph_hi; ++p) {
        int kind, layer; decode_phase(p, kind, layer);
        const int j = layer >> 1;
        if (kind == K_P0) { p0_prologue(F, F.in[0]); }
        else if (kind == K_E1) {
            pg8::Gemm g{xb, (const bf16*)(F.ws + WS_WEI) + (size_t)j * EVEN_NP * DM, M, EVEN_NP, DM}; pg8::StaticOrder S; S.init(M, EVEN_NP, F.G, (int)blockIdx.x);
            pg8::EpiEvenIn E{big, sq16, (float*)(F.ws + WS_GATES), F.in[5] + (size_t)j * 8};
            pg8::gemm_phase<pg8::EpiEvenIn, pg8::StaticOrder, true, true>(F.lds, g, S, E);
        }
        else if (kind == K_E2) { mlstm_phase_a(F); }
        else if (kind == K_E3) { mlstm_scan_and_conv(F, F.in[4] + (size_t)j * 3 * CD); }
        else if (kind == K_E4) { mlstm_phase_c(F, F.in[6] + (size_t)j * MD); }
        else if (kind == K_RESMIX || kind == K_RESFFN) {
            const bool ffn = kind == K_RESFFN, odd = layer & 1;
            const bf16* A = ffn ? big : Yb;
            const bf16* Bt = ffn ? (const bf16*)(F.ws + WS_WFO) + (size_t)layer * DM * DFF : odd ? (const bf16*)(F.ws + WS_WOO) + (size_t)j * DM * DM : (const bf16*)(F.ws + WS_WEO) + (size_t)j * DM * DM;
            pg8::Gemm g{A, Bt, M, DM, ffn ? DFF : DM}; pg8::StaticOrder S; S.init(M, DM, F.G, (int)blockIdx.x);
            pg8::EpiResid E{F.x, xb, sq16};
            pg8::gemm_phase<pg8::EpiResid, pg8::StaticOrder, false, true>(F.lds, g, S, E);
        }
        else if (kind == K_F1) {
            pg8::Gemm g{xb, (const bf16*)(F.ws + WS_WFI) + (size_t)layer * 2 * DFF * DM, M, 2 * DFF, DM}; pg8::StaticOrder S; S.init(M, 2 * DFF, F.G, (int)blockIdx.x);
            pg8::EpiSwiGLU E{big, sq16};
            pg8::gemm_phase<pg8::EpiSwiGLU, pg8::StaticOrder, true, true>(F.lds, g, S, E);
        }
        else if (kind == K_O1) {
            pg8::Gemm g{xb, (const bf16*)(F.ws + WS_WOI) + (size_t)j * 2048 * DM, M, 2048, DM}; pg8::StaticOrder S; S.init(M, 2048, F.G, (int)blockIdx.x);
            pg8::EpiGeluZ E{big, sq16, (float*)(F.ws + WS_VSQ)};
            pg8::gemm_phase<pg8::EpiGeluZ, pg8::StaticOrder, true, true>(F.lds, g, S, E);
        }
        else if (kind == K_O2) { sgu_phase(F, F.in[9] + (size_t)j * DM, F.in[10] + (size_t)j * 8 * CHUNK * CHUNK, F.in[11] + (size_t)j * 8 * CHUNK); }
        else { final_norm(F); }
        if (p + 1 < args.ph_hi) xcd_barrier(bar);
    }
}

extern "C" void kernel_launch(void* const* d_in, const int* in_sizes, int n_in, void* d_out, int out_size, void* d_ws, size_t ws_size, hipStream_t stream) {
    static int grid = 0;
    if (grid == 0) {
        if (n_in != 16 || in_sizes[0] != M * DM || out_size != M * DM || ws_size < WS_END) { fprintf(stderr, "kernel_launch: unexpected shapes / workspace (n_in %d, ws %zu < %zu); nothing launched\n", n_in, ws_size, (size_t)WS_END); grid = -1; return; }
        int dev = 0, cus = 0, per_cu = 0;
        if (hipGetDevice(&dev) != hipSuccess || hipDeviceGetAttribute(&cus, hipDeviceAttributeMultiprocessorCount, dev) != hipSuccess) { grid = -1; return; }
        if (hipFuncSetAttribute((const void*)trunk_fwd, hipFuncAttributeMaxDynamicSharedMemorySize, LDS_BYTES) != hipSuccess) { fprintf(stderr, "kernel_launch: hipFuncSetAttribute failed\n"); grid = -1; return; }
        if (hipOccupancyMaxActiveBlocksPerMultiprocessor(&per_cu, (const void*)trunk_fwd, NWAVES * 64, LDS_BYTES) != hipSuccess || per_cu < 1) fprintf(stderr, "kernel_launch: note: occupancy query says %d\n", per_cu);
        (void)hipGetLastError();
        grid = cus;
    }
    if (grid < 0) return;
    if (hipMemsetAsync((char*)d_ws + WS_CTL, 0, CTL_ZERO_BYTES, stream) != hipSuccess) return;
    Args a{};
    for (int i = 0; i < 16; ++i) a.in[i] = (const float*)d_in[i];
    a.out = (float*)d_out; a.ws = (unsigned char*)d_ws;
#if MK_PER_PHASE
    for (int p = 0; p < N_PHASES; ++p) { a.ph_lo = p; a.ph_hi = p + 1; hipLaunchKernelGGL(trunk_fwd, dim3(grid), dim3(NWAVES * 64), LDS_BYTES, stream, a); }
#else
    a.ph_lo = 0; a.ph_hi = N_PHASES; hipLaunchKernelGGL(trunk_fwd, dim3(grid), dim3(NWAVES * 64), LDS_BYTES, stream, a);
#endif
}
```

```cpp
#include <hip/hip_runtime.h>
#include <cstdio>
#include <cstdint>
#define MK_PER_PHASE 0
namespace pg8 {
#define PG8_LAS __attribute__((address_space(3)))
typedef unsigned short bf16_t;
typedef short bf16x8 __attribute__((ext_vector_type(8)));
typedef float f32x4 __attribute__((ext_vector_type(4)));
typedef unsigned u32x4 __attribute__((ext_vector_type(4)));
constexpr int BM = 256, BK = 64, HALF = 128, HTB = HALF * BK * 2  , STAGE_BYTES = 8 * HTB, NXCD = 8, WGM = 8;

__host__ __device__ __forceinline__ int lds_byte(int r, int c) { const int st = (r >> 4) * 2 + (c >> 5), rr = r & 15, cc = c & 31, ob = rr * 64 + cc * 2; return st * 1024 + (ob ^ (((ob >> 9) & 1) << 5)); }
__host__ __device__ __forceinline__ void stage_rc(int b, int& R, int& C) { const int st = b / 1024, sb = b % 1024, swz = sb ^ (((sb >> 9) & 1) << 5); R = (st >> 1) * 16 + swz / 64; C = (st & 1) * 32 + (swz % 64) / 2; }
__host__ __device__ __forceinline__ int perm32(int rho) { const int n = rho >> 4, i = rho & 15; return 8 * (i >> 2) + 4 * n + (i & 3); }

struct Unit { int pm, pn; };
struct Gemm { const bf16_t* A; const bf16_t* Bt; int M, N, K; };

struct StaticOrder {
    int nM, nN, nwg, G, c;
    __host__ __device__ void init(int M, int N, int G_, int c_) { nM = M / BM; nN = N / BM; nwg = nM * nN; G = G_; c = c_; }
    __host__ __device__ bool next(int i, Unit& u) const {
        const long L = (long)i * G + c; if (L >= nwg) return false;
        int wgid = (int)L; { const int q = nwg / NXCD, r = nwg % NXCD, xcd = wgid % NXCD, off = wgid / NXCD; wgid = (xcd < r ? xcd * (q + 1) : r * (q + 1) + (xcd - r) * q) + off; }
        const int nig = WGM * nN, gid = wgid / nig, fm = gid * WGM, gsz = (nM - fm) < WGM ? (nM - fm) : WGM;
        u.pm = fm + ((wgid % nig) % gsz); u.pn = (wgid % nig) / gsz; return true;
    }
    __device__ __forceinline__ void a_ready(const Unit&) const {}
    __device__ __forceinline__ void done(const Unit&) const {}
};

__device__ __forceinline__ unsigned cvt_pk_bf16(float lo, float hi) { unsigned r; asm volatile("v_cvt_pk_bf16_f32 %0, %1, %2" : "=v"(r) : "v"(lo), "v"(hi)); return r; }
typedef float f32x2 __attribute__((ext_vector_type(2)));
constexpr float RMS_EPS_F = 1e-6f;
typedef unsigned u32x2 __attribute__((ext_vector_type(2)));
__device__ __forceinline__ float row_rstd16(const float* sq16, int row) {
    const f32x4* p = (const f32x4*)(sq16 + (size_t)row * 16);
    const f32x4 a = p[0], b = p[1], c = p[2], d = p[3];
    const float s = ((a[0] + a[1]) + (a[2] + a[3])) + ((b[0] + b[1]) + (b[2] + b[3])) + ((c[0] + c[1]) + (c[2] + c[3])) + ((d[0] + d[1]) + (d[2] + d[3]));
    return __builtin_amdgcn_rsqf(s * (1.0f / 1024.0f) + RMS_EPS_F);
}
__device__ __forceinline__ float fast_sigmoid(float x) { return __builtin_amdgcn_rcpf(1.0f + __expf(-x)); }
struct EpiEvenIn {
    static constexpr bool PERM = true, AFTER_DRAIN = false;
    bf16_t* O; const float* sq16; float* gates; const float* bgate;
    __device__ __forceinline__ void operator()(const f32x4 (&acc)[2][2][4][2], const Unit& u, int wr, int wc, int fr, int fq) const {
        const int row0 = u.pm * BM + wr * 64 + fr;
        if (u.pn < 14) {
            const int col0 = u.pn * BM + wc * 32 + 8 * fq;
#pragma unroll
            for (int ai = 0; ai < 2; ++ai)
#pragma unroll
                for (int m = 0; m < 4; ++m) { const int row = row0 + ai * HALF + m * 16; const float r = row_rstd16(sq16, row); bf16_t* rowp = O + (size_t)row * 3584 + col0;
#pragma unroll
                    for (int bj = 0; bj < 2; ++bj) { const f32x4 v0 = acc[ai][bj][m][0] * r, v1 = acc[ai][bj][m][1] * r;
                        u32x4 w; w.x = cvt_pk_bf16(v0[0], v0[1]); w.y = cvt_pk_bf16(v0[2], v0[3]); w.z = cvt_pk_bf16(v1[0], v1[1]); w.w = cvt_pk_bf16(v1[2], v1[3]);
                        *(u32x4*)(rowp + bj * HALF) = w; } }
        } else if (wc == 0 && fq == 0) {
            const f32x4 b0 = *(const f32x4*)(bgate), b1 = *(const f32x4*)(bgate + 4);
#pragma unroll
            for (int ai = 0; ai < 2; ++ai)
#pragma unroll
                for (int m = 0; m < 4; ++m) { const int row = row0 + ai * HALF + m * 16; const float r = row_rstd16(sq16, row);
                    *(f32x4*)(gates + (size_t)row * 8) = acc[ai][0][m][0] * r + b0; *(f32x4*)(gates + (size_t)row * 8 + 4) = acc[ai][0][m][1] * r + b1; }
        }
    }
};
struct EpiResid {
    static constexpr bool PERM = false, AFTER_DRAIN = false;
    float* x; bf16_t* xb; float* sq16;
    __device__ __forceinline__ void operator()(const f32x4 (&acc)[2][2][4][2], const Unit& u, int wr, int wc, int fr, int fq) const {
        const int row0 = u.pm * BM + wr * 64 + fr, col0 = u.pn * BM + wc * 32 + 4 * fq;
#pragma unroll
        for (int ai = 0; ai < 2; ++ai)
#pragma unroll
            for (int m = 0; m < 4; ++m) { const int row = row0 + ai * HALF + m * 16; const size_t off = (size_t)row * 1024 + col0; float ss = 0.f;
#pragma unroll
                for (int bj = 0; bj < 2; ++bj)
#pragma unroll
                    for (int n = 0; n < 2; ++n) { const size_t o = off + bj * HALF + n * 16; const f32x4 v = *(const f32x4*)(x + o) + acc[ai][bj][m][n];
                        *(f32x4*)(x + o) = v; u32x2 w; w.x = cvt_pk_bf16(v[0], v[1]); w.y = cvt_pk_bf16(v[2], v[3]); *(u32x2*)(xb + o) = w;
                        ss += (v[0] * v[0] + v[1] * v[1]) + (v[2] * v[2] + v[3] * v[3]); }
                ss += __shfl_xor(ss, 16); ss += __shfl_xor(ss, 32);
                if (fq == 0) sq16[(size_t)row * 16 + u.pn * 4 + wc] = ss;
                asm volatile("" ::: "memory"); }
    }
};
struct EpiSwiGLU {
    static constexpr bool PERM = true, AFTER_DRAIN = false;
    bf16_t* O; const float* sq16;
    __device__ __forceinline__ void operator()(const f32x4 (&acc)[2][2][4][2], const Unit& u, int wr, int wc, int fr, int fq) const {
        const int row0 = u.pm * BM + wr * 64 + fr, col0 = u.pn * HALF + wc * 32 + 8 * fq;
#pragma unroll
        for (int ai = 0; ai < 2; ++ai)
#pragma unroll
            for (int m = 0; m < 4; ++m) { const int row = row0 + ai * HALF + m * 16; const float r = row_rstd16(sq16, row);
                float h[8];
#pragma unroll
                for (int n = 0; n < 2; ++n)
#pragma unroll
                    for (int j = 0; j < 4; ++j) { const float g = acc[ai][0][m][n][j] * r, up = acc[ai][1][m][n][j] * r; h[4 * n + j] = g * fast_sigmoid(g) * up; }
                u32x4 w; w.x = cvt_pk_bf16(h[0], h[1]); w.y = cvt_pk_bf16(h[2], h[3]); w.z = cvt_pk_bf16(h[4], h[5]); w.w = cvt_pk_bf16(h[6], h[7]);
                *(u32x4*)(O + (size_t)row * 2816 + col0) = w; }
    }
};
struct EpiGeluZ {
    static constexpr bool PERM = true, AFTER_DRAIN = false;
    bf16_t* O; const float* sq16; float* vsq16;
    __device__ __forceinline__ void operator()(const f32x4 (&acc)[2][2][4][2], const Unit& u, int wr, int wc, int fr, int fq) const {
        const int row0 = u.pm * BM + wr * 64 + fr, col0 = u.pn * BM + wc * 32 + 8 * fq;
#pragma unroll
        for (int ai = 0; ai < 2; ++ai)
#pragma unroll
            for (int m = 0; m < 4; ++m) { const int row = row0 + ai * HALF + m * 16; const float r = row_rstd16(sq16, row); float ss = 0.f;
#pragma unroll
                for (int bj = 0; bj < 2; ++bj) { float z[8];
#pragma unroll
                    for (int n = 0; n < 2; ++n)
#pragma unroll
                        for (int j = 0; j < 4; ++j) { const float v = acc[ai][bj][m][n][j] * r; const float t = 1.5957691216057308f * (v + 0.044715f * v * v * v); const float zz = v * fast_sigmoid(t); z[4 * n + j] = zz; ss += zz * zz; }
                    u32x4 w; w.x = cvt_pk_bf16(z[0], z[1]); w.y = cvt_pk_bf16(z[2], z[3]); w.z = cvt_pk_bf16(z[4], z[5]); w.w = cvt_pk_bf16(z[6], z[7]);
                    *(u32x4*)(O + (size_t)row * 2048 + col0 + bj * HALF) = w; }
                if (u.pn >= 4) { ss += __shfl_xor(ss, 16); ss += __shfl_xor(ss, 32); if (fq == 0) vsq16[(size_t)row * 16 + (u.pn - 4) * 4 + wc] = ss; } }
    }
};
template <class Epi, class Sched, bool ALIGN_EPI = false, bool SP2 = false>
__device__ __forceinline__ void gemm_phase(PG8_LAS unsigned char* lds, const Gemm g, const Sched& S, const Epi& E) {
    int tid_ = threadIdx.x; asm volatile("" : "+v"(tid_)); const int tid = tid_, wid = __builtin_amdgcn_readfirstlane(tid >> 6), lane = tid & 63, wr = wid >> 2, wc = wid & 3, fr = lane & 15, fq = lane >> 4;
    const int K = g.K, nt = K / BK;
    unsigned voffA[2], voffB[2];
#pragma unroll
    for (int i = 0; i < 2; ++i) { int R, C; stage_rc(tid * 16 + i * 8192, R, C); const int Rb = Epi::PERM ? ((R & ~31) + perm32(R & 31)) : R;
        voffA[i] = (unsigned)(R * K + C) * 2u; voffB[i] = (unsigned)(Rb * K + C) * 2u; }
    const size_t kstep = (size_t)(BK * 2);
    const size_t hstep = (size_t)HALF * K * 2;
    const size_t tstep = 2 * hstep;
    const unsigned ldsw = (unsigned)wid * 1024u;
    const int aoff = lds_byte(wr * 64 + fr, fq * 8), boff = lds_byte(wc * 32 + fr, fq * 8);
#define PG8_SA(b, h) (((b) * 2 + (h)) * HTB)
#define PG8_SB(b, h) ((4 + (b) * 2 + (h)) * HTB)
#define PG8_STAGE(bufoff, gbase, voff) do { _Pragma("unroll") for (int _i = 0; _i < 2; ++_i) \
        __builtin_amdgcn_global_load_lds((const unsigned*)((const char*)(gbase) + (voff)[_i]), (PG8_LAS unsigned*)(lds + (bufoff) + ldsw + _i * 8192), 16, 0, 0); } while (0)
#define PG8_LDA(dst, b, h) do { _Pragma("unroll") for (int m = 0; m < 4; ++m) _Pragma("unroll") for (int k = 0; k < 2; ++k) dst[m][k] = *(const PG8_LAS bf16x8*)(lds + PG8_SA(b, h) + aoff + m * 2048 + k * 1024); } while (0)
#define PG8_LDB(dst, b, h) do { _Pragma("unroll") for (int n = 0; n < 2; ++n) _Pragma("unroll") for (int k = 0; k < 2; ++k) dst[n][k] = *(const PG8_LAS bf16x8*)(lds + PG8_SB(b, h) + boff + n * 2048 + k * 1024); } while (0)
#define PG8_MMA(ai, bj, At, Bt) do { __builtin_amdgcn_s_setprio(1); _Pragma("unroll") for (int m = 0; m < 4; ++m) _Pragma("unroll") for (int n = 0; n < 2; ++n) _Pragma("unroll") for (int k = 0; k < 2; ++k) \
        acc[ai][bj][m][n] = __builtin_amdgcn_mfma_f32_16x16x32_bf16(Bt[n][k], At[m][k], acc[ai][bj][m][n], 0, 0, 0); __builtin_amdgcn_s_setprio(0); } while (0)
#define PG8_WAIT_V(n) asm volatile("s_waitcnt vmcnt(" #n ")" ::: "memory")
#define PG8_WAIT_L(n) asm volatile("s_waitcnt lgkmcnt(" #n ")" ::: "memory")
#define PG8_BAR __builtin_amdgcn_s_barrier()
#define PG8_SCHED __builtin_amdgcn_sched_barrier(0)
    Unit cur, nxt; int ui = 0;
    if (!S.next(0, cur)) return;
    f32x4 acc[2][2][4][2];
#pragma unroll
    for (int a = 0; a < 2; ++a)
#pragma unroll
        for (int b = 0; b < 2; ++b)
#pragma unroll
            for (int m = 0; m < 4; ++m)
#pragma unroll
                for (int n = 0; n < 2; ++n) acc[a][b][m][n] = (f32x4){0.f, 0.f, 0.f, 0.f};
    bf16x8 At[4][2], B0[2][2], B1[2][2];
    const char* cA = (const char*)g.A + (size_t)cur.pm * tstep; const char* cB = (const char*)g.Bt + (size_t)cur.pn * tstep;
    S.a_ready(cur);
    if constexpr (SP2) {
        PG8_STAGE(PG8_SB(0, 0), cB, voffB); PG8_STAGE(PG8_SB(0, 1), cB + hstep, voffB); PG8_STAGE(PG8_SA(0, 0), cA, voffA); PG8_STAGE(PG8_SA(0, 1), cA + hstep, voffA);
        if (wr == 1) PG8_BAR;
        PG8_WAIT_V(2); PG8_BAR;
        PG8_STAGE(PG8_SB(1, 0), cB + kstep, voffB); PG8_STAGE(PG8_SA(1, 0), cA + kstep, voffA); PG8_STAGE(PG8_SB(1, 1), cB + hstep + kstep, voffB);
        PG8_WAIT_V(6); PG8_BAR;
    } else {
        PG8_STAGE(PG8_SB(0, 0), cB, voffB); PG8_STAGE(PG8_SA(0, 0), cA, voffA); PG8_STAGE(PG8_SB(0, 1), cB + hstep, voffB); PG8_STAGE(PG8_SA(0, 1), cA + hstep, voffA);
        if (wr == 1) PG8_BAR;
        PG8_WAIT_V(4); PG8_BAR;
        PG8_STAGE(PG8_SB(1, 0), cB + kstep, voffB); PG8_STAGE(PG8_SA(1, 0), cA + kstep, voffA); PG8_STAGE(PG8_SB(1, 1), cB + hstep + kstep, voffB);
        PG8_WAIT_V(6); PG8_BAR;
    }
    for (;;) {
        const bool has_next = S.next(ui + 1, nxt);
        const char* nA = has_next ? (const char*)g.A + (size_t)nxt.pm * tstep : cA; const char* nB = has_next ? (const char*)g.Bt + (size_t)nxt.pn * tstep : cB;
        for (int t = 0; t < nt; t += 2) {
            const bool last = (t == nt - 2);
            const char* a1 = cA + (size_t)(t + 1) * kstep;
            const char* a2 = last ? nA : cA + (size_t)(t + 2) * kstep; const char* b2 = last ? nB : cB + (size_t)(t + 2) * kstep;
            const char* a3 = a2 + kstep; const char* b3 = b2 + kstep;
            if (last && has_next) S.a_ready(nxt);
            if constexpr (SP2) {
            PG8_LDB(B0, 0, 0); PG8_LDB(B1, 0, 1); PG8_SCHED; PG8_LDA(At, 0, 0); PG8_STAGE(PG8_SA(1, 1), a1 + hstep, voffA);
            PG8_WAIT_V(8); PG8_WAIT_L(0); PG8_BAR; PG8_MMA(0, 0, At, B0); PG8_MMA(0, 1, At, B1); PG8_BAR; PG8_SCHED;
            PG8_LDA(At, 0, 1); PG8_STAGE(PG8_SB(0, 0), b2, voffB); PG8_STAGE(PG8_SB(0, 1), b2 + hstep, voffB); PG8_STAGE(PG8_SA(0, 0), a2, voffA);
            PG8_WAIT_V(8); PG8_WAIT_L(0); PG8_BAR; PG8_MMA(1, 0, At, B0); PG8_MMA(1, 1, At, B1); PG8_BAR; PG8_SCHED;
            PG8_LDB(B0, 1, 0); PG8_LDB(B1, 1, 1); PG8_SCHED; PG8_LDA(At, 1, 0); PG8_STAGE(PG8_SA(0, 1), a2 + hstep, voffA);
            PG8_WAIT_V(8); PG8_WAIT_L(0); PG8_BAR; PG8_MMA(0, 0, At, B0); PG8_MMA(0, 1, At, B1); PG8_BAR; PG8_SCHED;
            PG8_LDA(At, 1, 1); PG8_STAGE(PG8_SB(1, 0), b3, voffB); PG8_STAGE(PG8_SB(1, 1), b3 + hstep, voffB); PG8_STAGE(PG8_SA(1, 0), a3, voffA);
            PG8_WAIT_V(8); PG8_WAIT_L(0); PG8_BAR; PG8_MMA(1, 0, At, B0); PG8_MMA(1, 1, At, B1); PG8_BAR; PG8_SCHED;
            } else {
            PG8_LDB(B0, 0, 0); PG8_SCHED; PG8_LDA(At, 0, 0); PG8_STAGE(PG8_SA(1, 1), a1 + hstep, voffA);
            PG8_WAIT_L(8); PG8_BAR; PG8_WAIT_L(0); PG8_MMA(0, 0, At, B0); PG8_BAR; PG8_SCHED;
            PG8_LDB(B1, 0, 1); PG8_STAGE(PG8_SB(0, 0), b2, voffB);
            PG8_BAR; PG8_WAIT_L(0); PG8_MMA(0, 1, At, B1); PG8_BAR;
            PG8_LDA(At, 0, 1); PG8_STAGE(PG8_SA(0, 0), a2, voffA);
            PG8_BAR; PG8_WAIT_L(0); PG8_MMA(1, 0, At, B0); PG8_BAR; PG8_SCHED;
            PG8_STAGE(PG8_SB(0, 1), b2 + hstep, voffB);
            PG8_WAIT_V(6); PG8_BAR; PG8_MMA(1, 1, At, B1); PG8_BAR;
            PG8_LDB(B0, 1, 0); PG8_SCHED; PG8_LDA(At, 1, 0); PG8_STAGE(PG8_SA(0, 1), a2 + hstep, voffA);
            PG8_WAIT_L(8); PG8_BAR; PG8_WAIT_L(0); PG8_MMA(0, 0, At, B0); PG8_BAR; PG8_SCHED;
            PG8_LDB(B1, 1, 1); PG8_STAGE(PG8_SB(1, 0), b3, voffB);
            PG8_BAR; PG8_WAIT_L(0); PG8_MMA(0, 1, At, B1); PG8_BAR;
            PG8_LDA(At, 1, 1); PG8_STAGE(PG8_SA(1, 0), a3, voffA);
            PG8_BAR; PG8_WAIT_L(0); PG8_MMA(1, 0, At, B0); PG8_BAR; PG8_SCHED;
            PG8_STAGE(PG8_SB(1, 1), b3 + hstep, voffB);
            PG8_WAIT_V(6); PG8_BAR; PG8_MMA(1, 1, At, B1); PG8_BAR;
            }
        }
        if constexpr (ALIGN_EPI) { if (wr == 0) PG8_BAR; }
        if constexpr (!Epi::AFTER_DRAIN) { E(acc, cur, wr, wc, fr, fq); S.done(cur); }
        if (!has_next) break;
#pragma unroll
        for (int a = 0; a < 2; ++a)
#pragma unroll
            for (int b = 0; b < 2; ++b)
#pragma unroll
                for (int m = 0; m < 4; ++m)
#pragma unroll
                    for (int n = 0; n < 2; ++n) acc[a][b][m][n] = (f32x4){0.f, 0.f, 0.f, 0.f};
        cur = nxt; cA = nA; cB = nB; ++ui;
        if constexpr (ALIGN_EPI) { if (wr == 1) PG8_BAR; }
    }
    PG8_WAIT_V(0);
    if constexpr (!ALIGN_EPI) { if (wr == 0) PG8_BAR; }
    PG8_BAR;
    if constexpr (Epi::AFTER_DRAIN) { E.fused(acc, cur, wr, wc, fr, fq, lds, wid, lane); S.done(cur); }
#undef PG8_SA
#undef PG8_SB
#undef PG8_STAGE
#undef PG8_LDA
#undef PG8_LDB
#undef PG8_MMA
#undef PG8_WAIT_V
#undef PG8_WAIT_L
#undef PG8_BAR
#undef PG8_SCHED
}
}
constexpr int NWAVES = 8;
#ifndef MK_PER_PHASE
#define MK_PER_PHASE 0
#endif
constexpr int DM = 1024, NB = 2, SEQ = 8192, M = NB * SEQ, DEPTH = 4;
constexpr int CD = 512, HEADS = 4, HD = 128, MD = 512, EVEN_IN = 3592, EVEN_NP = 3840, EVEN_W = 3584, DFF = 2816, CHUNK = 128, NCH = SEQ / CHUNK, NUNIT = NB * HEADS * NCH;
constexpr float RMS_EPS = 1e-6f;
constexpr size_t MiB = 1u << 20;
constexpr size_t WS_CTL = 0, CTL_ZERO_BYTES = 1 * MiB;
constexpr size_t WS_SQ = 1 * MiB;
constexpr size_t WS_VSQ = 2 * MiB;
constexpr size_t WS_GATES = 3 * MiB;
constexpr size_t WS_NLOC = 4 * MiB;
constexpr size_t WS_NIN = 4 * MiB + 256 * 1024;
constexpr size_t WS_MLOC = 4 * MiB + 512 * 1024;
constexpr size_t WS_BL = WS_MLOC + 4096;
constexpr size_t WS_MIN = WS_BL + 4096;
constexpr size_t WS_WEI = 5 * MiB;
constexpr size_t WS_WEO = 20 * MiB;
constexpr size_t WS_WOI = 24 * MiB;
constexpr size_t WS_WOO = 32 * MiB;
constexpr size_t WS_WFI = 36 * MiB;
constexpr size_t WS_WFO = 80 * MiB;
constexpr size_t WS_XB = 102 * MiB;
constexpr size_t WS_Y = 134 * MiB;
constexpr size_t WS_BIG = 166 * MiB;
constexpr size_t WS_CLOC = 278 * MiB;
constexpr size_t WS_CIN = 310 * MiB;
constexpr size_t WS_END = 326 * MiB;
constexpr int CW_BAR = 4096;
constexpr int RING_BYTES = 131072;
constexpr int LDS_BYTES = 163840;
constexpr int LDSCTL_OFF = LDS_BYTES - 512, MISC_OFF = LDSCTL_OFF + 320;
constexpr int TSTR = 272;
constexpr int TILE_B = 128 * TSTR;
#define GAS __attribute__((address_space(1)))
#define LAS __attribute__((address_space(3)))
typedef unsigned short bf16;
typedef unsigned v4u __attribute__((ext_vector_type(4)));
typedef float f32x4 __attribute__((ext_vector_type(4)));
typedef short bf16x8 __attribute__((ext_vector_type(8)));
typedef GAS unsigned gu32;
typedef GAS unsigned long long gu64;
#define RLX_AGENT __ATOMIC_RELAXED, __HIP_MEMORY_SCOPE_AGENT
#define LDS_WAIT() asm volatile("s_waitcnt lgkmcnt(0)" ::: "memory")
#define VM_WAIT() asm volatile("s_waitcnt vmcnt(0)" ::: "memory")
__device__ __forceinline__ unsigned long long rt() { return __builtin_amdgcn_s_memrealtime(); }
__device__ __forceinline__ unsigned f2bf(float f) { unsigned u = __builtin_bit_cast(unsigned, f); return (u + 0x7fffu + ((u >> 16) & 1u)) >> 16; }
__device__ __forceinline__ unsigned pk2(float lo, float hi) { return f2bf(lo) | (f2bf(hi) << 16); }

#define XB_TMO      128
#define XB_XCNT(j)  (256  + 64 * (j))
#define XB_XSUB(j)  (1280 + 64 * (j))
#define XB_XGEN(j)  (2304 + 64 * (j))
#define XB_TOP      3328
#define XB_TOPGEN   3392
#define XCD_BAR_WORDS 3456
#define XB_SPIN_CAP (1u << 18)

__device__ __forceinline__ unsigned xb_ld(unsigned* p)              { return __hip_atomic_load(p, __ATOMIC_RELAXED, __HIP_MEMORY_SCOPE_AGENT); }
__device__ __forceinline__ unsigned xb_add(unsigned* p, unsigned v) { return __hip_atomic_fetch_add(p, v, __ATOMIC_RELAXED, __HIP_MEMORY_SCOPE_AGENT); }
__device__ __forceinline__ unsigned xb_xcc_id() { return (unsigned)__builtin_amdgcn_s_getreg((3 << 11) | 20) & 0xFu; }
#define XB_SPIN(cond, bar) do { unsigned _sp = 0; while (cond) { __builtin_amdgcn_s_sleep(1); \
    if ((++_sp & 255u) == 0u) { if (xb_ld(&(bar)[XB_TMO])) break; if (_sp > XB_SPIN_CAP) { atomicAdd(&(bar)[XB_TMO], 1u); break; } } } } while (0)

struct XcdBarrier {
    unsigned* bar; unsigned x;
    volatile LAS unsigned* st;
};

__device__ __forceinline__ XcdBarrier xcd_barrier_post(unsigned* bar, volatile LAS unsigned* st) {
    XcdBarrier b; b.bar = bar; b.x = xb_xcc_id(); b.st = st;
    if (threadIdx.x == 0) (void)xb_add(&bar[XB_XCNT(b.x)], 1u);
    return b;
}
__device__ __forceinline__ void xcd_barrier_complete(unsigned* bar, unsigned x, unsigned& nloc, unsigned& nx) {
    const unsigned G = gridDim.x * gridDim.y * gridDim.z;
    unsigned sum, cnt, mine, sp = 0u;
    for (;;) {
        sum = 0u; cnt = 0u; mine = 0u;
#pragma unroll
        for (unsigned j = 0; j < 16; ++j) { const unsigned c = xb_ld(&bar[XB_XCNT(j)]); sum += c; cnt += (c > 0u) ? 1u : 0u; mine = (j == x) ? c : mine; }
        if (sum == G) break;
        __builtin_amdgcn_s_sleep(1);
        if ((++sp & 255u) == 0u) { if (xb_ld(&bar[XB_TMO])) break; if (sp > XB_SPIN_CAP) { atomicAdd(&bar[XB_TMO], 1u); break; } }
    }
    nloc = mine > 0u ? mine : 1u; nx = cnt > 0u ? cnt : 1u;
}

__device__ __forceinline__ void xcd_barrier(const XcdBarrier& b) {
    asm volatile("s_waitcnt vmcnt(0)" ::: "memory");
    __syncthreads();
    if (threadIdx.x == 0) {
        unsigned* bar = b.bar;
        __builtin_amdgcn_s_waitcnt(0);
        unsigned nloc = b.st[0], nx = b.st[1];
        if (nloc == 0u) { xcd_barrier_complete(bar, b.x, nloc, nx); b.st[0] = nloc; b.st[1] = nx; }
        const unsigned old = xb_add(&bar[XB_XSUB(b.x)], 1u);
        const unsigned gen = old / nloc;
        if (old + 1u == (gen + 1u) * nloc) {
            __builtin_amdgcn_fence(__ATOMIC_RELEASE, "agent");
            asm volatile("s_waitcnt vmcnt(0)" ::: "memory");
            const unsigned og = xb_add(&bar[XB_TOP], 1u);
            const unsigned tg = og / nx;
            if (og + 1u == (tg + 1u) * nx) xb_add(&bar[XB_TOPGEN], 1u);
            else XB_SPIN(xb_ld(&bar[XB_TOPGEN]) == tg, bar);
            __builtin_amdgcn_fence(__ATOMIC_ACQUIRE, "agent");
            xb_add(&bar[XB_XGEN(b.x)], 1u);
            asm volatile("s_waitcnt vmcnt(0)" ::: "memory");
        } else {
            XB_SPIN(xb_ld(&bar[XB_XGEN(b.x)]) == gen, bar);
            __builtin_amdgcn_fence(__ATOMIC_ACQUIRE, "agent");
            asm volatile("s_waitcnt vmcnt(0)" ::: "memory");
        }
    }
    __syncthreads();
}
typedef unsigned u32x2 __attribute__((ext_vector_type(2)));
struct Frame {
    LAS unsigned char* lds;
    volatile LAS unsigned* MISC;
    gu32* ctl;
    int vcu, G;
    unsigned char* ws;
    const float* in[16];
    float* x;
};
#define OPQ_TID() int tid = threadIdx.x; asm volatile("" : "+v"(tid)); const int lane = tid & 63, w = __builtin_amdgcn_readfirstlane(tid >> 6), fr = lane & 15, fq = lane >> 4; (void)w; (void)fr; (void)fq
__device__ __forceinline__ float wave_sum(float v) {
#pragma unroll
    for (int o = 1; o < 64; o <<= 1) v += __shfl_xor(v, o);
    return v;
}
__device__ __forceinline__ float wave_max(float v) {
#pragma unroll
    for (int o = 1; o < 64; o <<= 1) v = fmaxf(v, __shfl_xor(v, o));
    return v;
}
__device__ __forceinline__ float bf2f(unsigned short h) { return __builtin_bit_cast(float, (unsigned)h << 16); }
__device__ __forceinline__ float logsig(float x) { return fminf(x, 0.f) - log1pf(expf(-fabsf(x))); }

__device__ __forceinline__ void p0_item(const float* W, int ldw, int K, int sc0, bf16* Bt, int dr0, int k0, const float* gain, float cs, LAS float* scr, int lane) {
#pragma unroll 8
    for (int i = 0; i < 32; ++i) { const int kk = 2 * i + (lane >> 5); const float gk = gain ? gain[k0 + kk] : 1.0f; scr[kk * 33 + (lane & 31)] = W[(size_t)(k0 + kk) * ldw + sc0 + (lane & 31)] * gk; }
    LDS_WAIT(); asm volatile("" ::: "memory");
    const int c = lane & 7;
#pragma unroll
    for (int j = 0; j < 4; ++j) { const int n = (lane >> 3) + 8 * j; const LAS float* s = scr + (8 * c) * 33 + n;
        v4u o; o.x = pk2(s[0 * 33] * cs, s[1 * 33] * cs); o.y = pk2(s[2 * 33] * cs, s[3 * 33] * cs); o.z = pk2(s[4 * 33] * cs, s[5 * 33] * cs); o.w = pk2(s[6 * 33] * cs, s[7 * 33] * cs);
        *(GAS v4u*)(Bt + (size_t)(dr0 + n) * K + k0 + 8 * c) = o; }
    LDS_WAIT(); asm volatile("" ::: "memory");
}
__device__ __forceinline__ void p0_prologue(Frame& F, const float* xin) {
    OPQ_TID();
    LAS float* scr = (LAS float*)(F.lds + w * 16384);
    const int gw = F.vcu * NWAVES + w, NGW = F.G * NWAVES;
    const float* norm_mix = F.in[1]; const float* norm_ffn = F.in[2];
    constexpr int I_EI = 112 * 16, I_EO = 32 * 16, I_OI = 64 * 16, I_OO = 32 * 16, I_FI = 176 * 16, I_FO = 32 * 44;
    constexpr int N0 = 2 * I_EI, N1 = N0 + 2 * I_EO, N2 = N1 + 2 * I_OI, N3 = N2 + 2 * I_OO, N4 = N3 + 4 * I_FI, N5 = N4 + 4 * I_FO, NG = N5 + 32;
    for (int it = gw; it < NG; it += NGW) {
        if (it < N0) { const int j = it / I_EI, r = it % I_EI, kb = r / 112, nb = r % 112, c0 = 32 * nb;
            p0_item(F.in[3] + (size_t)j * DM * EVEN_IN, EVEN_IN, DM, c0, (bf16*)(F.ws + WS_WEI) + (size_t)j * EVEN_NP * DM, c0, 64 * kb, norm_mix + (size_t)(2 * j) * DM, (c0 >= 2048 && c0 < 2560) ? 0.08838834764831845f : 1.0f, scr, lane);
        } else if (it < N1) { const int q = it - N0, j = q / I_EO, r = q % I_EO, kb = r / 32, nb = r % 32;
            p0_item(F.in[7] + (size_t)j * DM * DM, DM, DM, 32 * nb, (bf16*)(F.ws + WS_WEO) + (size_t)j * DM * DM, 32 * nb, 64 * kb, nullptr, 1.0f, scr, lane);
        } else if (it < N2) { const int q = it - N1, j = q / I_OI, r = q % I_OI, kb = r / 64, nb = r % 64;
            p0_item(F.in[8] + (size_t)j * DM * 2048, 2048, DM, 32 * nb, (bf16*)(F.ws + WS_WOI) + (size_t)j * 2048 * DM, 32 * nb, 64 * kb, norm_mix + (size_t)(2 * j + 1) * DM, 1.0f, scr, lane);
        } else if (it < N3) { const int q = it - N2, j = q / I_OO, r = q % I_OO, kb = r / 32, nb = r % 32;
            p0_item(F.in[12] + (size_t)j * DM * DM, DM, DM, 32 * nb, (bf16*)(F.ws + WS_WOO) + (size_t)j * DM * DM, 32 * nb, 64 * kb, nullptr, 1.0f, scr, lane);
        } else if (it < N4) { const int q = it - N3, l = q / I_FI, r = q % I_FI, kb = r / 176, nb = r % 176, c0 = 32 * nb;
            const int up = c0 >= DFF, cc = up ? c0 - DFF : c0, dr = 256 * (cc >> 7) + (up ? 128 : 0) + (cc & 127);
            p0_item(F.in[13] + (size_t)l * DM * 2 * DFF, 2 * DFF, DM, c0, (bf16*)(F.ws + WS_WFI) + (size_t)l * 2 * DFF * DM, dr, 64 * kb, norm_ffn + (size_t)l * DM, 1.0f, scr, lane);
        } else if (it < N5) { const int q = it - N4, l = q / I_FO, r = q % I_FO, kb = r / 32, nb = r % 32;
            p0_item(F.in[14] + (size_t)l * DFF * DM, DM, DFF, 32 * nb, (bf16*)(F.ws + WS_WFO) + (size_t)l * DM * DFF, 32 * nb, 64 * kb, nullptr, 1.0f, scr, lane);
        } else { const int q = it - N5, j = q >> 4, k0 = 64 * (q & 15);
            const float* W = F.in[3] + (size_t)j * DM * EVEN_IN; bf16* Bt = (bf16*)(F.ws + WS_WEI) + (size_t)j * EVEN_NP * DM; const float* gain = norm_mix + (size_t)(2 * j) * DM;
#pragma unroll
            for (int e = 0; e < 8; ++e) { const int id = lane + 64 * e, col = id & 7, kk = k0 + (id >> 3);
                Bt[(size_t)(EVEN_W + col) * DM + kk] = (bf16)f2bf(W[(size_t)kk * EVEN_IN + EVEN_W + col] * gain[kk]); }
        }
    }
    float* sq16 = (float*)(F.ws + WS_SQ); bf16* xb = (bf16*)(F.ws + WS_XB);
    for (int m = gw; m < M; m += NGW) {
        const GAS f32x4* xr = (const GAS f32x4*)(xin + (size_t)m * DM) + lane; GAS f32x4* xo = (GAS f32x4*)(F.x + (size_t)m * DM) + lane;
        GAS u32x2* bo = (GAS u32x2*)(xb + (size_t)m * DM) + lane; float s = 0.f;
#pragma unroll
        for (int j = 0; j < 4; ++j) { const f32x4 v = xr[64 * j]; xo[64 * j] = v; u32x2 w; w.x = pk2(v.x, v.y); w.y = pk2(v.z, v.w); bo[64 * j] = w; s += (v.x * v.x + v.y * v.y) + (v.z * v.z + v.w * v.w); }
        s = wave_sum(s);
        if (lane < 16) sq16[(size_t)m * 16 + lane] = (lane == 0) ? s : 0.f;
    }
}
__device__ __forceinline__ void final_norm(Frame& F) {
    OPQ_TID();
    const int gw = F.vcu * NWAVES + w, NGW = F.G * NWAVES;
    const float* sq16 = (const float*)(F.ws + WS_SQ); const float* gf = F.in[15];
    f32x4 g[4];
#pragma unroll
    for (int j = 0; j < 4; ++j) g[j] = ((const f32x4*)gf)[lane + 64 * j];
    for (int m = gw; m < M; m += NGW) {
        const float r = pg8::row_rstd16(sq16, m);
        GAS f32x4* xo = (GAS f32x4*)(F.x + (size_t)m * DM) + lane;
#pragma unroll
        for (int j = 0; j < 4; ++j) { f32x4 v = xo[64 * j]; v = v * r * g[j]; xo[64 * j] = v; }
    }
}
__device__ __forceinline__ void scan128_add(float& v0, float& v1, int lane) {
#pragma unroll
    for (int o = 1; o < 64; o <<= 1) { const float a = __shfl_up(v0, o), b = __shfl_up(v1, o); if (lane >= o) { v0 += a; v1 += b; } }
    v1 += __shfl(v0, 63);
}
__device__ __forceinline__ void scan128_max(float& v0, float& v1, int lane) {
#pragma unroll
    for (int o = 1; o < 64; o <<= 1) { const float a = __shfl_up(v0, o), b = __shfl_up(v1, o); if (lane >= o) { v0 = fmaxf(v0, a); v1 = fmaxf(v1, b); } }
    v1 = fmaxf(v1, __shfl(v0, 63));
}
__device__ __forceinline__ void stage_tr(LAS unsigned char* tile, const bf16* src, int ld, const LAS float* sc, int tid) {
#pragma unroll
    for (int i = 0; i < 4; ++i) { const int id = tid + 512 * i, s = id & 127, dc = id >> 7;
        const v4u v = *(const GAS v4u*)(src + (size_t)s * ld + 8 * dc); const float f = sc ? sc[s] : 1.0f;
        const unsigned w[4] = {v.x, v.y, v.z, v.w};
#pragma unroll
        for (int j = 0; j < 4; ++j) { unsigned lo = w[j] & 0xffffu, hi = w[j] >> 16;
            if (sc) { lo = f2bf(bf2f((unsigned short)lo) * f); hi = f2bf(bf2f((unsigned short)hi) * f); }
            *(LAS unsigned short*)(tile + (8 * dc + 2 * j) * TSTR + 2 * s) = (unsigned short)lo; *(LAS unsigned short*)(tile + (8 * dc + 2 * j + 1) * TSTR + 2 * s) = (unsigned short)hi; } }
}
__device__ __forceinline__ void stage_rows(LAS unsigned char* tile, const bf16* src, int ld, int tid) {
#pragma unroll
    for (int i = 0; i < 4; ++i) { const int id = tid + 512 * i, r = id >> 4, dc = id & 15;
        *(LAS v4u*)(tile + r * TSTR + 16 * dc) = *(const GAS v4u*)(src + (size_t)r * ld + 8 * dc); }
}
#define FRAG(tile, row, kk, fq) (*(const LAS bf16x8*)((tile) + (row) * TSTR + (32 * (kk) + 8 * (fq)) * 2))

__device__ __forceinline__ void mlstm_phase_a(Frame& F) {
    LAS unsigned char* TK = F.lds; LAS unsigned char* TV = F.lds + TILE_B; LAS float* aS = (LAS float*)(F.lds + 2 * TILE_B);
    const bf16* proj = (const bf16*)(F.ws + WS_BIG); const float* gates = (const float*)(F.ws + WS_GATES);
    float* Cloc = (float*)(F.ws + WS_CLOC); float* nloc = (float*)(F.ws + WS_NLOC); float* mloc = (float*)(F.ws + WS_MLOC); float* bLv = (float*)(F.ws + WS_BL);
    for (int u = F.vcu; u < NUNIT; u += F.G) {
        OPQ_TID();
        const int bh = u >> 6, c = u & 63, b = bh >> 2, h = bh & 3, row0 = b * SEQ + c * CHUNK;
        if (w == 0) {
            const float i0 = gates[(size_t)(row0 + lane) * 8 + h], i1 = gates[(size_t)(row0 + lane + 64) * 8 + h];
            float b0 = logsig(gates[(size_t)(row0 + lane) * 8 + 4 + h]), b1 = logsig(gates[(size_t)(row0 + lane + 64) * 8 + 4 + h]);
            scan128_add(b0, b1, lane);
            const float bL = __shfl(b1, 63);
            const float w0 = bL - b0 + i0, w1 = bL - b1 + i1;
            const float ml = wave_max(fmaxf(w0, w1));
            aS[lane] = __expf(w0 - ml); aS[lane + 64] = __expf(w1 - ml);
            if (lane == 0) { mloc[u] = ml; bLv[u] = bL; }
        }
        __syncthreads();
        stage_tr(TK, proj + (size_t)row0 * EVEN_W + 2048 + h * HD, EVEN_W, aS, tid);
        stage_tr(TV, proj + (size_t)row0 * EVEN_W + 2560 + h * HD, EVEN_W, nullptr, tid);
        __syncthreads();
        {
            const int d = tid >> 2, q = tid & 3; float s = 0.f;
#pragma unroll
            for (int i = 0; i < 4; ++i) { const bf16x8 v = *(const LAS bf16x8*)(TK + d * TSTR + (32 * q + 8 * i) * 2);
#pragma unroll
                for (int j = 0; j < 8; ++j) s += bf2f((unsigned short)v[j]); }
            s += __shfl_xor(s, 1); s += __shfl_xor(s, 2);
            if (q == 0) nloc[(size_t)u * HD + d] = s;
        }
        bf16x8 vf[4];
#pragma unroll
        for (int kk = 0; kk < 4; ++kk) vf[kk] = FRAG(TV, 16 * w + fr, kk, fq);
#pragma unroll
        for (int db = 0; db < 8; ++db) { f32x4 acc = {0.f, 0.f, 0.f, 0.f};
#pragma unroll
            for (int kk = 0; kk < 4; ++kk) acc = __builtin_amdgcn_mfma_f32_16x16x32_bf16(FRAG(TK, 16 * db + fr, kk, fq), vf[kk], acc, 0, 0, 0);
            *(GAS f32x4*)(Cloc + (size_t)u * (HD * HD) + (size_t)(16 * w + fr) * HD + 16 * db + 4 * fq) = acc; }
        __syncthreads();
    }
}
__device__ __forceinline__ void mlstm_scan_and_conv(Frame& F, const float* wconv) {
    const float* Cloc = (const float*)(F.ws + WS_CLOC); const float* nloc = (const float*)(F.ws + WS_NLOC); const float* mloc = (const float*)(F.ws + WS_MLOC); const float* bLv = (const float*)(F.ws + WS_BL);
    bf16* Cin = (bf16*)(F.ws + WS_CIN); float* nin = (float*)(F.ws + WS_NIN); float* minv = (float*)(F.ws + WS_MIN);
    OPQ_TID();
    const int NT = F.G * 512;
    for (int g = F.vcu * 512 + tid; g < NB * HEADS * (HD * HD + HD); g += NT) {
        const bool isn = g >= NB * HEADS * HD * HD; const int q = isn ? g - NB * HEADS * HD * HD : g;
        const int bh = isn ? (q >> 7) : (q >> 14), idx = isn ? (q & 127) : (q & 16383);
        float C = 0.f, m = 0.f;
        for (int c0 = 0; c0 < NCH; c0 += 8) {
            float cl[8], ml[8], bl[8];
#pragma unroll
            for (int i = 0; i < 8; ++i) { const int u = bh * NCH + c0 + i; cl[i] = isn ? nloc[(size_t)u * HD + idx] : Cloc[(size_t)u * (HD * HD) + idx]; ml[i] = mloc[u]; bl[i] = bLv[u]; }
#pragma unroll
            for (int i = 0; i < 8; ++i) { const int u = bh * NCH + c0 + i;
                if (isn) { nin[(size_t)u * HD + idx] = C; if (idx == 0) minv[u] = m; } else Cin[(size_t)u * (HD * HD) + idx] = (bf16)f2bf(C);
                const float mn = fmaxf(bl[i] + m, ml[i]);
                C = __expf(bl[i] + m - mn) * C + __expf(ml[i] - mn) * cl[i]; m = mn; }
        }
    }
    const bf16* proj = (const bf16*)(F.ws + WS_BIG); bf16* Y = (bf16*)(F.ws + WS_Y);
    for (int g = F.vcu * 512 + tid; g < M * (CD / 8); g += NT) {
        const int t = g >> 6, c8 = (g & 63) * 8, ts = t & (SEQ - 1);
        float acc[8];
#pragma unroll
        for (int j = 0; j < 8; ++j) acc[j] = 0.f;
#pragma unroll
        for (int jj = 0; jj < 3; ++jj) { if (ts - 2 + jj >= 0) { const bf16* p = proj + (size_t)(t - 2 + jj) * EVEN_W;
                const v4u cg = *(const GAS v4u*)(p + CD + c8), xa = *(const GAS v4u*)(p + 2 * CD + c8);
                const unsigned cw[4] = {cg.x, cg.y, cg.z, cg.w}, xw[4] = {xa.x, xa.y, xa.z, xa.w};
#pragma unroll
                for (int j = 0; j < 4; ++j) { acc[2 * j] += wconv[jj * CD + c8 + 2 * j] * (bf2f((unsigned short)(cw[j] & 0xffffu)) * bf2f((unsigned short)(xw[j] & 0xffffu)));
                    acc[2 * j + 1] += wconv[jj * CD + c8 + 2 * j + 1] * (bf2f((unsigned short)(cw[j] >> 16)) * bf2f((unsigned short)(xw[j] >> 16))); } } }
        const v4u bg = *(const GAS v4u*)(proj + (size_t)t * EVEN_W + c8); const unsigned bw[4] = {bg.x, bg.y, bg.z, bg.w}; v4u o; unsigned ow[4];
#pragma unroll
        for (int j = 0; j < 4; ++j) ow[j] = pk2(bf2f((unsigned short)(bw[j] & 0xffffu)) * acc[2 * j], bf2f((unsigned short)(bw[j] >> 16)) * acc[2 * j + 1]);
        o.x = ow[0]; o.y = ow[1]; o.z = ow[2]; o.w = ow[3];
        *(GAS v4u*)(Y + (size_t)t * DM + c8) = o;
    }
}
__device__ __forceinline__ void mlstm_phase_c(Frame& F, const float* ghead) {
    LAS unsigned char* TK = F.lds; LAS unsigned char* TV = F.lds + TILE_B; LAS unsigned char* TC = F.lds + 2 * TILE_B; LAS unsigned char* TS = F.lds + 3 * TILE_B;
    LAS float* gS = (LAS float*)(F.lds + 4 * TILE_B); LAS float* mxS = gS + 128; LAS float* bS = gS + 256; LAS float* nS = gS + 384;
    const bf16* proj = (const bf16*)(F.ws + WS_BIG); const float* gates = (const float*)(F.ws + WS_GATES);
    const bf16* Cin = (const bf16*)(F.ws + WS_CIN); const float* nin = (const float*)(F.ws + WS_NIN); const float* minv = (const float*)(F.ws + WS_MIN);
    bf16* Y = (bf16*)(F.ws + WS_Y);
    for (int u = F.vcu; u < NUNIT; u += F.G) {
        OPQ_TID();
        const int bh = u >> 6, c = u & 63, b = bh >> 2, h = bh & 3, row0 = b * SEQ + c * CHUNK;
        const float m_in = minv[u];
        if (w == 0) {
            const float i0 = gates[(size_t)(row0 + lane) * 8 + h], i1 = gates[(size_t)(row0 + lane + 64) * 8 + h];
            float b0 = logsig(gates[(size_t)(row0 + lane) * 8 + 4 + h]), b1 = logsig(gates[(size_t)(row0 + lane + 64) * 8 + 4 + h]);
            scan128_add(b0, b1, lane);
            const float g0 = i0 - b0, g1 = i1 - b1; float p0 = g0, p1 = g1;
            scan128_max(p0, p1, lane);
            gS[lane] = g0; gS[lane + 64] = g1; mxS[lane] = fmaxf(m_in, p0); mxS[lane + 64] = fmaxf(m_in, p1); bS[lane] = b0; bS[lane + 64] = b1;
        } else if (w == 1) { nS[lane] = nin[(size_t)u * HD + lane]; nS[lane + 64] = nin[(size_t)u * HD + lane + 64]; }
        const int t = 16 * w + fr;
        bf16x8 qf[4];
#pragma unroll
        for (int kk = 0; kk < 4; ++kk) qf[kk] = *(const GAS bf16x8*)(proj + (size_t)(row0 + t) * EVEN_W + 1536 + h * HD + 32 * kk + 8 * fq);
        stage_rows(TK, proj + (size_t)row0 * EVEN_W + 2048 + h * HD, EVEN_W, tid);
        stage_rows(TC, Cin + (size_t)u * (HD * HD), HD, tid);
        stage_tr(TV, proj + (size_t)row0 * EVEN_W + 2560 + h * HD, EVEN_W, nullptr, tid);
        __syncthreads();
        const float mx_t = mxS[t], b_t = bS[t], inter = __expf(m_in - mx_t);
        float den1 = 0.f;
#pragma unroll
        for (int sb = 0; sb < 8; ++sb) {
            u32x2 pk = {0u, 0u};
            if (sb <= w) { f32x4 acc = {0.f, 0.f, 0.f, 0.f};
#pragma unroll
                for (int kk = 0; kk < 4; ++kk) acc = __builtin_amdgcn_mfma_f32_16x16x32_bf16(FRAG(TK, 16 * sb + fr, kk, fq), qf[kk], acc, 0, 0, 0);
                float sv[4];
#pragma unroll
                for (int r = 0; r < 4; ++r) { const int s = 16 * sb + 4 * fq + r; const float e = __expf(gS[s] - mx_t); sv[r] = (s <= t) ? acc[r] * e : 0.f; den1 += sv[r]; }
                pk.x = pk2(sv[0], sv[1]); pk.y = pk2(sv[2], sv[3]); }
            *(LAS u32x2*)(TS + t * TSTR + (16 * sb + 4 * fq) * 2) = pk;
        }
        den1 += __shfl_xor(den1, 16); den1 += __shfl_xor(den1, 32);
        float qn = 0.f;
#pragma unroll
        for (int kk = 0; kk < 4; ++kk)
#pragma unroll
            for (int j = 0; j < 8; ++j) qn += bf2f((unsigned short)qf[kk][j]) * nS[32 * kk + 8 * fq + j];
        qn += __shfl_xor(qn, 16); qn += __shfl_xor(qn, 32);
        const float den = den1 + inter * qn, m_t = b_t + mx_t;
        const float rden = 1.0f / fmaxf(fabsf(den), __expf(-m_t));
        bf16x8 sf[4];
#pragma unroll
        for (int kk = 0; kk < 4; ++kk) sf[kk] = FRAG(TS, t, kk, fq);
        float hh[32]; float ssq = 0.f;
#pragma unroll
        for (int eb = 0; eb < 8; ++eb) { f32x4 a1 = {0.f, 0.f, 0.f, 0.f}, a2 = {0.f, 0.f, 0.f, 0.f};
#pragma unroll
            for (int kk = 0; kk < 4; ++kk) { if (2 * kk <= w) a1 = __builtin_amdgcn_mfma_f32_16x16x32_bf16(FRAG(TV, 16 * eb + fr, kk, fq), sf[kk], a1, 0, 0, 0);
                a2 = __builtin_amdgcn_mfma_f32_16x16x32_bf16(FRAG(TC, 16 * eb + fr, kk, fq), qf[kk], a2, 0, 0, 0); }
#pragma unroll
            for (int r = 0; r < 4; ++r) { const float v = (a1[r] + inter * a2[r]) * rden; hh[4 * eb + r] = v; ssq += v * v; } }
        ssq += __shfl_xor(ssq, 16); ssq += __shfl_xor(ssq, 32);
        const float rs = __builtin_amdgcn_rsqf(ssq * (1.0f / 128.0f) + RMS_EPS);
#pragma unroll
        for (int eb = 0; eb < 8; ++eb) { const int e = 16 * eb + 4 * fq;
            const u32x2 ov = *(const GAS u32x2*)(proj + (size_t)(row0 + t) * EVEN_W + 3072 + h * HD + e); const f32x4 gh = *(const f32x4*)(ghead + h * HD + e);
            const float o0 = bf2f((unsigned short)(ov.x & 0xffffu)), o1 = bf2f((unsigned short)(ov.x >> 16)), o2 = bf2f((unsigned short)(ov.y & 0xffffu)), o3 = bf2f((unsigned short)(ov.y >> 16));
            u32x2 y; y.x = pk2(pg8::fast_sigmoid(o0) * hh[4 * eb] * rs * gh[0], pg8::fast_sigmoid(o1) * hh[4 * eb + 1] * rs * gh[1]);
            y.y = pk2(pg8::fast_sigmoid(o2) * hh[4 * eb + 2] * rs * gh[2], pg8::fast_sigmoid(o3) * hh[4 * eb + 3] * rs * gh[3]);
            *(GAS u32x2*)(Y + (size_t)(row0 + t) * DM + MD + h * HD + e) = y; }
        __syncthreads();
    }
}
__device__ __forceinline__ void sgu_phase(Frame& F, const float* gv, const float* wsp, const float* bsp) {
    LAS unsigned char* TW = F.lds; LAS unsigned char* TV = F.lds + TILE_B; LAS float* rS = (LAS float*)(F.lds + 2 * TILE_B);
    const bf16* Z = (const bf16*)(F.ws + WS_BIG); const float* vsq16 = (const float*)(F.ws + WS_VSQ); bf16* Y = (bf16*)(F.ws + WS_Y);
    for (int u = F.vcu; u < (M / CHUNK) * 8; u += F.G) {
        OPQ_TID();
        const int cb = u >> 3, g = u & 7, row0 = cb * CHUNK;
        if (tid < 128) rS[tid] = pg8::row_rstd16(vsq16, row0 + tid);
        __syncthreads();
#pragma unroll
        for (int i = 0; i < 8; ++i) { const int id = tid + 512 * i, t = id >> 5, s4 = (id & 31) * 4;
            const f32x4 wv = *(const f32x4*)(wsp + ((size_t)g * CHUNK + t) * CHUNK + s4); float v[4];
#pragma unroll
            for (int j = 0; j < 4; ++j) v[j] = (s4 + j <= t) ? wv[j] * rS[s4 + j] : 0.f;
            u32x2 pk; pk.x = pk2(v[0], v[1]); pk.y = pk2(v[2], v[3]);
            *(LAS u32x2*)(TW + t * TSTR + s4 * 2) = pk; }
        stage_tr(TV, Z + (size_t)row0 * 2048 + 1024 + g * 128, 2048, nullptr, tid);
        __syncthreads();
        const int t = 16 * w + fr;
        bf16x8 wf[4];
#pragma unroll
        for (int kk = 0; kk < 4; ++kk) wf[kk] = FRAG(TW, t, kk, fq);
        const float bst = bsp[g * CHUNK + t];
#pragma unroll
        for (int db = 0; db < 8; ++db) { f32x4 acc = {0.f, 0.f, 0.f, 0.f};
#pragma unroll
            for (int kk = 0; kk < 4; ++kk) if (2 * kk <= w) acc = __builtin_amdgcn_mfma_f32_16x16x32_bf16(FRAG(TV, 16 * db + fr, kk, fq), wf[kk], acc, 0, 0, 0);
            const int col = g * 128 + 16 * db + 4 * fq;
            const f32x4 gvv = *(const f32x4*)(gv + col); const u32x2 uv = *(const GAS u32x2*)(Z + (size_t)(row0 + t) * 2048 + col);
            const float u0 = bf2f((unsigned short)(uv.x & 0xffffu)), u1 = bf2f((unsigned short)(uv.x >> 16)), u2 = bf2f((unsigned short)(uv.y & 0xffffu)), u3 = bf2f((unsigned short)(uv.y >> 16));
            u32x2 y; y.x = pk2(u0 * (acc[0] * gvv[0] + bst), u1 * (acc[1] * gvv[1] + bst)); y.y = pk2(u2 * (acc[2] * gvv[2] + bst), u3 * (acc[3] * gvv[3] + bst));
            *(GAS u32x2*)(Y + (size_t)(row0 + t) * DM + col) = y; }
        __syncthreads();
    }
}
struct Args { const float* in[16]; float* out; unsigned char* ws; int ph_lo, ph_hi; };
constexpr int N_PHASES = 26;
enum Kind { K_P0, K_E1, K_E2, K_E3, K_E4, K_RESMIX, K_F1, K_RESFFN, K_O1, K_O2, K_FINAL };
__device__ __forceinline__ void decode_phase(int p, int& kind, int& layer) {
    if (p == 0) { kind = K_P0; layer = 0; return; }
    if (p == 25) { kind = K_FINAL; layer = 0; return; }
    int q = p - 1; const int pair = q / 12; q -= pair * 12;
    if (q < 7) { layer = 2 * pair; kind = q == 0 ? K_E1 : q == 1 ? K_E2 : q == 2 ? K_E3 : q == 3 ? K_E4 : q == 4 ? K_RESMIX : q == 5 ? K_F1 : K_RESFFN; }
    else { layer = 2 * pair + 1; q -= 7; kind = q == 0 ? K_O1 : q == 1 ? K_O2 : q == 2 ? K_RESMIX : q == 3 ? K_F1 : K_RESFFN; }
}
__global__ void __launch_bounds__(NWAVES * 64, 2) trunk_fwd(Args args) {
    extern __shared__ __attribute__((aligned(16))) unsigned char lds[];
    Frame F;
    F.lds = (LAS unsigned char*)lds;
    F.MISC = (volatile LAS unsigned*)(F.lds + MISC_OFF);
    F.G = gridDim.x; { const int bx = blockIdx.x; F.vcu = (F.G % 8 == 0) ? (bx % 8) * (F.G / 8) + bx / 8 : bx; }
    F.ws = args.ws; F.ctl = (gu32*)(args.ws + WS_CTL); F.x = args.out;
#pragma unroll
    for (int i = 0; i < 16; ++i) F.in[i] = args.in[i];
    for (int u = threadIdx.x; u < (LDS_BYTES - LDSCTL_OFF) / 4; u += NWAVES * 64) ((LAS unsigned*)(F.lds + LDSCTL_OFF))[u] = 0u;
    __syncthreads();
    XcdBarrier bar; bar.bar = (unsigned*)(F.ctl + CW_BAR); bar.x = 0; bar.st = nullptr;
    if (!MK_PER_PHASE) bar = xcd_barrier_post((unsigned*)(F.ctl + CW_BAR), F.MISC + 8);
    bf16* xb = (bf16*)(F.ws + WS_XB); bf16* Yb = (bf16*)(F.ws + WS_Y); bf16* big = (bf16*)(F.ws + WS_BIG);
    float* sq16 = (float*)(F.ws + WS_SQ);
    for (int p = args.ph_lo; p < args.ph_hi; ++p) {
        int kind, layer; decode_phase(p, kind, layer);
        const int j = layer >> 1;
        if (kind == K_P0) { p0_prologue(F, F.in[0]); }
        else if (kind == K_E1) {
            pg8::Gemm g{xb, (const bf16*)(F.ws + WS_WEI) + (size_t)j * EVEN_NP * DM, M, EVEN_NP, DM}; pg8::StaticOrder S; S.init(M, EVEN_NP, F.G, (int)blockIdx.x);
            pg8::EpiEvenIn E{big, sq16, (float*)(F.ws + WS_GATES), F.in[5] + (size_t)j * 8};
            pg8::gemm_phase<pg8::EpiEvenIn, pg8::StaticOrder, true, true>(F.lds, g, S, E);
        }
        else if (kind == K_E2) { mlstm_phase_a(F); }
        else if (kind == K_E3) { mlstm_scan_and_conv(F, F.in[4] + (size_t)j * 3 * CD); }
        else if (kind == K_E4) { mlstm_phase_c(F, F.in[6] + (size_t)j * MD); }
        else if (kind == K_RESMIX || kind == K_RESFFN) {
            const bool ffn = kind == K_RESFFN, odd = layer & 1;
            const bf16* A = ffn ? big : Yb;
            const bf16* Bt = ffn ? (const bf16*)(F.ws + WS_WFO) + (size_t)layer * DM * DFF : odd ? (const bf16*)(F.ws + WS_WOO) + (size_t)j * DM * DM : (const bf16*)(F.ws + WS_WEO) + (size_t)j * DM * DM;
            pg8::Gemm g{A, Bt, M, DM, ffn ? DFF : DM}; pg8::StaticOrder S; S.init(M, DM, F.G, (int)blockIdx.x);
            pg8::EpiResid E{F.x, xb, sq16};
            pg8::gemm_phase<pg8::EpiResid, pg8::StaticOrder, false, true>(F.lds, g, S, E);
        }
        else if (kind == K_F1) {
            pg8::Gemm g{xb, (const bf16*)(F.ws + WS_WFI) + (size_t)layer * 2 * DFF * DM, M, 2 * DFF, DM}; pg8::StaticOrder S; S.init(M, 2 * DFF, F.G, (int)blockIdx.x);
            pg8::EpiSwiGLU E{big, sq16};
            pg8::gemm_phase<pg8::EpiSwiGLU, pg8::StaticOrder, true, true>(F.lds, g, S, E);
        }
        else if (kind == K_O1) {
            pg8::Gemm g{xb, (const bf16*)(F.ws + WS_WOI) + (size_t)j * 2048 * DM, M, 2048, DM}; pg8::StaticOrder S; S.init(M, 2048, F.G, (int)blockIdx.x);
            pg8::EpiGeluZ E{big, sq16, (float*)(F.ws + WS_VSQ)};
            pg8::gemm_phase<pg8::EpiGeluZ, pg8::StaticOrder, true, true>(F.lds, g, S, E);
        }
        else if (kind == K_O2) { sgu_phase(F, F.in[9] + (size_t)j * DM, F.in[10] + (size_t)j * 8 * CHUNK * CHUNK, F.in[11] + (size_t)j * 8 * CHUNK); }
        else { final_norm(F); }
        if (p + 1 < args.ph_hi) xcd_barrier(bar);
    }
}

extern "C" void kernel_launch(void* const* d_in, const int* in_sizes, int n_in, void* d_out, int out_size, void* d_ws, size_t ws_size, hipStream_t stream) {
    static int grid = 0;
    if (grid == 0) {
        if (n_in != 16 || in_sizes[0] != M * DM || out_size != M * DM || ws_size < WS_END) { fprintf(stderr, "kernel_launch: unexpected shapes / workspace (n_in %d, ws %zu < %zu); nothing launched\n", n_in, ws_size, (size_t)WS_END); grid = -1; return; }
        int dev = 0, cus = 0, per_cu = 0;
        if (hipGetDevice(&dev) != hipSuccess || hipDeviceGetAttribute(&cus, hipDeviceAttributeMultiprocessorCount, dev) != hipSuccess) { grid = -1; return; }
        if (hipFuncSetAttribute((const void*)trunk_fwd, hipFuncAttributeMaxDynamicSharedMemorySize, LDS_BYTES) != hipSuccess) { fprintf(stderr, "kernel_launch: hipFuncSetAttribute failed\n"); grid = -1; return; }
        if (hipOccupancyMaxActiveBlocksPerMultiprocessor(&per_cu, (const void*)trunk_fwd, NWAVES * 64, LDS_BYTES) != hipSuccess || per_cu < 1) fprintf(stderr, "kernel_launch: note: occupancy query says %d\n", per_cu);
        (void)hipGetLastError();
        grid = cus;
    }
    if (grid < 0) return;
    if (hipMemsetAsync((char*)d_ws + WS_CTL, 0, CTL_ZERO_BYTES, stream) != hipSuccess) return;
    Args a{};
    for (int i = 0; i < 16; ++i) a.in[i] = (const float*)d_in[i];
    a.out = (float*)d_out; a.ws = (unsigned char*)d_ws;
#if MK_PER_PHASE
    for (int p = 0; p < N_PHASES; ++p) { a.ph_lo = p; a.ph_hi = p + 1; hipLaunchKernelGGL(trunk_fwd, dim3(grid), dim3(NWAVES * 64), LDS_BYTES, stream, a); }
#else
    a.ph_lo = 0; a.ph_hi = N_PHASES; hipLaunchKernelGGL(trunk_fwd, dim3(grid), dim3(NWAVES * 64), LDS_BYTES, stream, a);
#endif
}
```

```cpp
#include <hip/hip_runtime.h>
#include <cstdio>
#include <cstdint>
#define MK_PER_PHASE 0
namespace pg8 {
#define PG8_LAS __attribute__((address_space(3)))
typedef unsigned short bf16_t;
typedef short bf16x8 __attribute__((ext_vector_type(8)));
typedef float f32x4 __attribute__((ext_vector_type(4)));
typedef unsigned u32x4 __attribute__((ext_vector_type(4)));
constexpr int BM = 256, BK = 64, HALF = 128, HTB = HALF * BK * 2  , STAGE_BYTES = 8 * HTB, NXCD = 8, WGM = 8;

__host__ __device__ __forceinline__ int lds_byte(int r, int c) { const int st = (r >> 4) * 2 + (c >> 5), rr = r & 15, cc = c & 31, ob = rr * 64 + cc * 2; return st * 1024 + (ob ^ (((ob >> 9) & 1) << 5)); }
__host__ __device__ __forceinline__ void stage_rc(int b, int& R, int& C) { const int st = b / 1024, sb = b % 1024, swz = sb ^ (((sb >> 9) & 1) << 5); R = (st >> 1) * 16 + swz / 64; C = (st & 1) * 32 + (swz % 64) / 2; }
__host__ __device__ __forceinline__ int perm32(int rho) { const int n = rho >> 4, i = rho & 15; return 8 * (i >> 2) + 4 * n + (i & 3); }

struct Unit { int pm, pn; };
struct Gemm { const bf16_t* A; const bf16_t* Bt; int M, N, K; };

struct StaticOrder {
    int nM, nN, nwg, G, c;
    __host__ __device__ void init(int M, int N, int G_, int c_) { nM = M / BM; nN = N / BM; nwg = nM * nN; G = G_; c = c_; }
    __host__ __device__ bool next(int i, Unit& u) const {
        const long L = (long)i * G + c; if (L >= nwg) return false;
        int wgid = (int)L; { const int q = nwg / NXCD, r = nwg % NXCD, xcd = wgid % NXCD, off = wgid / NXCD; wgid = (xcd < r ? xcd * (q + 1) : r * (q + 1) + (xcd - r) * q) + off; }
        const int nig = WGM * nN, gid = wgid / nig, fm = gid * WGM, gsz = (nM - fm) < WGM ? (nM - fm) : WGM;
        u.pm = fm + ((wgid % nig) % gsz); u.pn = (wgid % nig) / gsz; return true;
    }
    __device__ __forceinline__ void a_ready(const Unit&) const {}
    __device__ __forceinline__ void done(const Unit&) const {}
};

__device__ __forceinline__ unsigned cvt_pk_bf16(float lo, float hi) { unsigned r; asm volatile("v_cvt_pk_bf16_f32 %0, %1, %2" : "=v"(r) : "v"(lo), "v"(hi)); return r; }
typedef float f32x2 __attribute__((ext_vector_type(2)));
constexpr float RMS_EPS_F = 1e-6f;
typedef unsigned u32x2 __attribute__((ext_vector_type(2)));
__device__ __forceinline__ float row_rstd4(const float* sq4, int row) {
    const f32x4 a = *(const f32x4*)(sq4 + (size_t)row * 4);
    return __builtin_amdgcn_rsqf(((a[0] + a[1]) + (a[2] + a[3])) * (1.0f / 1024.0f) + RMS_EPS_F);
}
__device__ __forceinline__ float row_rstd16(const float* sq16, int row) {
    const f32x4* p = (const f32x4*)(sq16 + (size_t)row * 16);
    const f32x4 a = p[0], b = p[1], c = p[2], d = p[3];
    const float s = ((a[0] + a[1]) + (a[2] + a[3])) + ((b[0] + b[1]) + (b[2] + b[3])) + ((c[0] + c[1]) + (c[2] + c[3])) + ((d[0] + d[1]) + (d[2] + d[3]));
    return __builtin_amdgcn_rsqf(s * (1.0f / 1024.0f) + RMS_EPS_F);
}
__device__ __forceinline__ float bf_lo(unsigned w) { return __builtin_bit_cast(float, w << 16); }
__device__ __forceinline__ float bf_hi(unsigned w) { return __builtin_bit_cast(float, w & 0xffff0000u); }
__device__ __forceinline__ float fast_sigmoid(float x) { return __builtin_amdgcn_rcpf(1.0f + __expf(-x)); }
struct EpiEvenIn {
    static constexpr bool PERM = true, AFTER_DRAIN = false;
    bf16_t* O; const float* sq16; float* gates; const float* bgate;
    __device__ __forceinline__ void operator()(const f32x4 (&acc)[2][2][4][2], const Unit& u, int wr, int wc, int fr, int fq) const {
        const int row0 = u.pm * BM + wr * 64 + fr;
        if (u.pn < 14) {
            const int col0 = u.pn * BM + wc * 32 + 8 * fq;
#pragma unroll
            for (int ai = 0; ai < 2; ++ai)
#pragma unroll
                for (int m = 0; m < 4; ++m) { const int row = row0 + ai * HALF + m * 16; const float r = row_rstd4(sq16, row); bf16_t* rowp = O + (size_t)row * 3584 + col0;
#pragma unroll
                    for (int bj = 0; bj < 2; ++bj) { const f32x4 v0 = acc[ai][bj][m][0] * r, v1 = acc[ai][bj][m][1] * r;
                        u32x4 w; w.x = cvt_pk_bf16(v0[0], v0[1]); w.y = cvt_pk_bf16(v0[2], v0[3]); w.z = cvt_pk_bf16(v1[0], v1[1]); w.w = cvt_pk_bf16(v1[2], v1[3]);
                        *(u32x4*)(rowp + bj * HALF) = w; } }
        } else if (wc == 0 && fq == 0) {
            const f32x4 b0 = *(const f32x4*)(bgate), b1 = *(const f32x4*)(bgate + 4);
#pragma unroll
            for (int ai = 0; ai < 2; ++ai)
#pragma unroll
                for (int m = 0; m < 4; ++m) { const int row = row0 + ai * HALF + m * 16; const float r = row_rstd4(sq16, row);
                    *(f32x4*)(gates + (size_t)row * 8) = acc[ai][0][m][0] * r + b0; *(f32x4*)(gates + (size_t)row * 8 + 4) = acc[ai][0][m][1] * r + b1; }
        }
    }
};
struct EpiResid {
    static constexpr bool PERM = true, AFTER_DRAIN = false;
    bf16_t* xb; PG8_LAS float* sqs;
    __device__ __forceinline__ void operator()(const f32x4 (&acc)[2][2][4][2], const Unit& u, int wr, int wc, int fr, int fq) const {
        const int rl0 = wr * 64 + fr, col0 = u.pn * BM + wc * 32 + 8 * fq;
#pragma unroll
        for (int ai = 0; ai < 2; ++ai)
#pragma unroll
            for (int m = 0; m < 4; ++m) { const int rl = rl0 + ai * HALF + m * 16; bf16_t* rowp = xb + (size_t)(u.pm * BM + rl) * 1024 + col0; float ss = 0.f;
#pragma unroll
                for (int bj = 0; bj < 2; ++bj) { const u32x4 o = *(const u32x4*)(rowp + bj * HALF);
                    const f32x4 v0 = acc[ai][bj][m][0] + (f32x4){bf_lo(o.x), bf_hi(o.x), bf_lo(o.y), bf_hi(o.y)}, v1 = acc[ai][bj][m][1] + (f32x4){bf_lo(o.z), bf_hi(o.z), bf_lo(o.w), bf_hi(o.w)};
                    u32x4 w; w.x = cvt_pk_bf16(v0[0], v0[1]); w.y = cvt_pk_bf16(v0[2], v0[3]); w.z = cvt_pk_bf16(v1[0], v1[1]); w.w = cvt_pk_bf16(v1[2], v1[3]);
                    *(u32x4*)(rowp + bj * HALF) = w;
                    ss += ((v0[0] * v0[0] + v0[1] * v0[1]) + (v0[2] * v0[2] + v0[3] * v0[3])) + ((v1[0] * v1[0] + v1[1] * v1[1]) + (v1[2] * v1[2] + v1[3] * v1[3])); }
                ss += __shfl_xor(ss, 16); ss += __shfl_xor(ss, 32);
                if (fq == 0) sqs[rl * 4 + wc] = ss;
                asm volatile("" ::: "memory"); }
    }
};
struct EpiSwiGLU {
    static constexpr bool PERM = true, AFTER_DRAIN = false;
    bf16_t* O; const float* sq16;
    __device__ __forceinline__ void operator()(const f32x4 (&acc)[2][2][4][2], const Unit& u, int wr, int wc, int fr, int fq) const {
        const int row0 = u.pm * BM + wr * 64 + fr, col0 = u.pn * HALF + wc * 32 + 8 * fq;
#pragma unroll
        for (int ai = 0; ai < 2; ++ai)
#pragma unroll
            for (int m = 0; m < 4; ++m) { const int row = row0 + ai * HALF + m * 16; const float r = row_rstd4(sq16, row);
                float h[8];
#pragma unroll
                for (int n = 0; n < 2; ++n)
#pragma unroll
                    for (int j = 0; j < 4; ++j) { const float g = acc[ai][0][m][n][j] * r, up = acc[ai][1][m][n][j] * r; h[4 * n + j] = g * fast_sigmoid(g) * up; }
                u32x4 w; w.x = cvt_pk_bf16(h[0], h[1]); w.y = cvt_pk_bf16(h[2], h[3]); w.z = cvt_pk_bf16(h[4], h[5]); w.w = cvt_pk_bf16(h[6], h[7]);
                *(u32x4*)(O + (size_t)row * 2816 + col0) = w; }
    }
};
struct EpiGeluZ {
    static constexpr bool PERM = true, AFTER_DRAIN = false;
    bf16_t* O; const float* sq16; float* vsq16;
    __device__ __forceinline__ void operator()(const f32x4 (&acc)[2][2][4][2], const Unit& u, int wr, int wc, int fr, int fq) const {
        const int row0 = u.pm * BM + wr * 64 + fr, col0 = u.pn * BM + wc * 32 + 8 * fq;
#pragma unroll
        for (int ai = 0; ai < 2; ++ai)
#pragma unroll
            for (int m = 0; m < 4; ++m) { const int row = row0 + ai * HALF + m * 16; const float r = row_rstd4(sq16, row); float ss = 0.f;
#pragma unroll
                for (int bj = 0; bj < 2; ++bj) { float z[8];
#pragma unroll
                    for (int n = 0; n < 2; ++n)
#pragma unroll
                        for (int j = 0; j < 4; ++j) { const float v = acc[ai][bj][m][n][j] * r; const float t = 1.5957691216057308f * (v + 0.044715f * v * v * v); const float zz = v * fast_sigmoid(t); z[4 * n + j] = zz; ss += zz * zz; }
                    u32x4 w; w.x = cvt_pk_bf16(z[0], z[1]); w.y = cvt_pk_bf16(z[2], z[3]); w.z = cvt_pk_bf16(z[4], z[5]); w.w = cvt_pk_bf16(z[6], z[7]);
                    *(u32x4*)(O + (size_t)row * 2048 + col0 + bj * HALF) = w; }
                if (u.pn >= 4) { ss += __shfl_xor(ss, 16); ss += __shfl_xor(ss, 32); if (fq == 0) vsq16[(size_t)row * 16 + (u.pn - 4) * 4 + wc] = ss; } }
    }
};
template <class Epi, class Sched, bool ALIGN_EPI = false, bool SP2 = false>
__device__ __forceinline__ void gemm_phase(PG8_LAS unsigned char* lds, const Gemm g, const Sched& S, const Epi& E) {
    int tid_ = threadIdx.x; asm volatile("" : "+v"(tid_)); const int tid = tid_, wid = __builtin_amdgcn_readfirstlane(tid >> 6), lane = tid & 63, wr = wid >> 2, wc = wid & 3, fr = lane & 15, fq = lane >> 4;
    const int K = g.K, nt = K / BK;
    unsigned voffA[2], voffB[2];
#pragma unroll
    for (int i = 0; i < 2; ++i) { int R, C; stage_rc(tid * 16 + i * 8192, R, C); const int Rb = Epi::PERM ? ((R & ~31) + perm32(R & 31)) : R;
        voffA[i] = (unsigned)(R * K + C) * 2u; voffB[i] = (unsigned)(Rb * K + C) * 2u; }
    const size_t kstep = (size_t)(BK * 2);
    const size_t hstep = (size_t)HALF * K * 2;
    const size_t tstep = 2 * hstep;
    const unsigned ldsw = (unsigned)wid * 1024u;
    const int aoff = lds_byte(wr * 64 + fr, fq * 8), boff = lds_byte(wc * 32 + fr, fq * 8);
#define PG8_SA(b, h) (((b) * 2 + (h)) * HTB)
#define PG8_SB(b, h) ((4 + (b) * 2 + (h)) * HTB)
#define PG8_STAGE(bufoff, gbase, voff) do { _Pragma("unroll") for (int _i = 0; _i < 2; ++_i) \
        __builtin_amdgcn_global_load_lds((const unsigned*)((const char*)(gbase) + (voff)[_i]), (PG8_LAS unsigned*)(lds + (bufoff) + ldsw + _i * 8192), 16, 0, 0); } while (0)
#define PG8_LDA(dst, b, h) do { _Pragma("unroll") for (int m = 0; m < 4; ++m) _Pragma("unroll") for (int k = 0; k < 2; ++k) dst[m][k] = *(const PG8_LAS bf16x8*)(lds + PG8_SA(b, h) + aoff + m * 2048 + k * 1024); } while (0)
#define PG8_LDB(dst, b, h) do { _Pragma("unroll") for (int n = 0; n < 2; ++n) _Pragma("unroll") for (int k = 0; k < 2; ++k) dst[n][k] = *(const PG8_LAS bf16x8*)(lds + PG8_SB(b, h) + boff + n * 2048 + k * 1024); } while (0)
#define PG8_MMA(ai, bj, At, Bt) do { __builtin_amdgcn_s_setprio(1); _Pragma("unroll") for (int m = 0; m < 4; ++m) _Pragma("unroll") for (int n = 0; n < 2; ++n) _Pragma("unroll") for (int k = 0; k < 2; ++k) \
        acc[ai][bj][m][n] = __builtin_amdgcn_mfma_f32_16x16x32_bf16(Bt[n][k], At[m][k], acc[ai][bj][m][n], 0, 0, 0); __builtin_amdgcn_s_setprio(0); } while (0)
#define PG8_WAIT_V(n) asm volatile("s_waitcnt vmcnt(" #n ")" ::: "memory")
#define PG8_WAIT_L(n) asm volatile("s_waitcnt lgkmcnt(" #n ")" ::: "memory")
#define PG8_BAR __builtin_amdgcn_s_barrier()
#define PG8_SCHED __builtin_amdgcn_sched_barrier(0)
    Unit cur, nxt; int ui = 0;
    if (!S.next(0, cur)) return;
    f32x4 acc[2][2][4][2];
#pragma unroll
    for (int a = 0; a < 2; ++a)
#pragma unroll
        for (int b = 0; b < 2; ++b)
#pragma unroll
            for (int m = 0; m < 4; ++m)
#pragma unroll
                for (int n = 0; n < 2; ++n) acc[a][b][m][n] = (f32x4){0.f, 0.f, 0.f, 0.f};
    bf16x8 At[4][2], B0[2][2], B1[2][2];
    const char* cA = (const char*)g.A + (size_t)cur.pm * tstep; const char* cB = (const char*)g.Bt + (size_t)cur.pn * tstep;
    S.a_ready(cur);
    if constexpr (SP2) {
        PG8_STAGE(PG8_SB(0, 0), cB, voffB); PG8_STAGE(PG8_SB(0, 1), cB + hstep, voffB); PG8_STAGE(PG8_SA(0, 0), cA, voffA); PG8_STAGE(PG8_SA(0, 1), cA + hstep, voffA);
        if (wr == 1) PG8_BAR;
        PG8_WAIT_V(2); PG8_BAR;
        PG8_STAGE(PG8_SB(1, 0), cB + kstep, voffB); PG8_STAGE(PG8_SA(1, 0), cA + kstep, voffA); PG8_STAGE(PG8_SB(1, 1), cB + hstep + kstep, voffB);
        PG8_WAIT_V(6); PG8_BAR;
    } else {
        PG8_STAGE(PG8_SB(0, 0), cB, voffB); PG8_STAGE(PG8_SA(0, 0), cA, voffA); PG8_STAGE(PG8_SB(0, 1), cB + hstep, voffB); PG8_STAGE(PG8_SA(0, 1), cA + hstep, voffA);
        if (wr == 1) PG8_BAR;
        PG8_WAIT_V(4); PG8_BAR;
        PG8_STAGE(PG8_SB(1, 0), cB + kstep, voffB); PG8_STAGE(PG8_SA(1, 0), cA + kstep, voffA); PG8_STAGE(PG8_SB(1, 1), cB + hstep + kstep, voffB);
        PG8_WAIT_V(6); PG8_BAR;
    }
    for (;;) {
        const bool has_next = S.next(ui + 1, nxt);
        const char* nA = has_next ? (const char*)g.A + (size_t)nxt.pm * tstep : cA; const char* nB = has_next ? (const char*)g.Bt + (size_t)nxt.pn * tstep : cB;
        for (int t = 0; t < nt; t += 2) {
            const bool last = (t == nt - 2);
            const char* a1 = cA + (size_t)(t + 1) * kstep;
            const char* a2 = last ? nA : cA + (size_t)(t + 2) * kstep; const char* b2 = last ? nB : cB + (size_t)(t + 2) * kstep;
            const char* a3 = a2 + kstep; const char* b3 = b2 + kstep;
            if (last && has_next) S.a_ready(nxt);
            if constexpr (SP2) {
            PG8_LDB(B0, 0, 0); PG8_LDB(B1, 0, 1); PG8_SCHED; PG8_LDA(At, 0, 0); PG8_STAGE(PG8_SA(1, 1), a1 + hstep, voffA);
            PG8_WAIT_V(8); PG8_WAIT_L(0); PG8_BAR; PG8_MMA(0, 0, At, B0); PG8_MMA(0, 1, At, B1); PG8_BAR; PG8_SCHED;
            PG8_LDA(At, 0, 1); PG8_STAGE(PG8_SB(0, 0), b2, voffB); PG8_STAGE(PG8_SB(0, 1), b2 + hstep, voffB); PG8_STAGE(PG8_SA(0, 0), a2, voffA);
            PG8_WAIT_V(8); PG8_WAIT_L(0); PG8_BAR; PG8_MMA(1, 0, At, B0); PG8_MMA(1, 1, At, B1); PG8_BAR; PG8_SCHED;
            PG8_LDB(B0, 1, 0); PG8_LDB(B1, 1, 1); PG8_SCHED; PG8_LDA(At, 1, 0); PG8_STAGE(PG8_SA(0, 1), a2 + hstep, voffA);
            PG8_WAIT_V(8); PG8_WAIT_L(0); PG8_BAR; PG8_MMA(0, 0, At, B0); PG8_MMA(0, 1, At, B1); PG8_BAR; PG8_SCHED;
            PG8_LDA(At, 1, 1); PG8_STAGE(PG8_SB(1, 0), b3, voffB); PG8_STAGE(PG8_SB(1, 1), b3 + hstep, voffB); PG8_STAGE(PG8_SA(1, 0), a3, voffA);
            PG8_WAIT_V(8); PG8_WAIT_L(0); PG8_BAR; PG8_MMA(1, 0, At, B0); PG8_MMA(1, 1, At, B1); PG8_BAR; PG8_SCHED;
            } else {
            PG8_LDB(B0, 0, 0); PG8_SCHED; PG8_LDA(At, 0, 0); PG8_STAGE(PG8_SA(1, 1), a1 + hstep, voffA);
            PG8_WAIT_L(8); PG8_BAR; PG8_WAIT_L(0); PG8_MMA(0, 0, At, B0); PG8_BAR; PG8_SCHED;
            PG8_LDB(B1, 0, 1); PG8_STAGE(PG8_SB(0, 0), b2, voffB);
            PG8_BAR; PG8_WAIT_L(0); PG8_MMA(0, 1, At, B1); PG8_BAR;
            PG8_LDA(At, 0, 1); PG8_STAGE(PG8_SA(0, 0), a2, voffA);
            PG8_BAR; PG8_WAIT_L(0); PG8_MMA(1, 0, At, B0); PG8_BAR; PG8_SCHED;
            PG8_STAGE(PG8_SB(0, 1), b2 + hstep, voffB);
            PG8_WAIT_V(6); PG8_BAR; PG8_MMA(1, 1, At, B1); PG8_BAR;
            PG8_LDB(B0, 1, 0); PG8_SCHED; PG8_LDA(At, 1, 0); PG8_STAGE(PG8_SA(0, 1), a2 + hstep, voffA);
            PG8_WAIT_L(8); PG8_BAR; PG8_WAIT_L(0); PG8_MMA(0, 0, At, B0); PG8_BAR; PG8_SCHED;
            PG8_LDB(B1, 1, 1); PG8_STAGE(PG8_SB(1, 0), b3, voffB);
            PG8_BAR; PG8_WAIT_L(0); PG8_MMA(0, 1, At, B1); PG8_BAR;
            PG8_LDA(At, 1, 1); PG8_STAGE(PG8_SA(1, 0), a3, voffA);
            PG8_BAR; PG8_WAIT_L(0); PG8_MMA(1, 0, At, B0); PG8_BAR; PG8_SCHED;
            PG8_STAGE(PG8_SB(1, 1), b3 + hstep, voffB);
            PG8_WAIT_V(6); PG8_BAR; PG8_MMA(1, 1, At, B1); PG8_BAR;
            }
        }
        if constexpr (ALIGN_EPI) { if (wr == 0) PG8_BAR; }
        if constexpr (!Epi::AFTER_DRAIN) { E(acc, cur, wr, wc, fr, fq); S.done(cur); }
        if (!has_next) break;
#pragma unroll
        for (int a = 0; a < 2; ++a)
#pragma unroll
            for (int b = 0; b < 2; ++b)
#pragma unroll
                for (int m = 0; m < 4; ++m)
#pragma unroll
                    for (int n = 0; n < 2; ++n) acc[a][b][m][n] = (f32x4){0.f, 0.f, 0.f, 0.f};
        cur = nxt; cA = nA; cB = nB; ++ui;
        if constexpr (ALIGN_EPI) { if (wr == 1) PG8_BAR; }
    }
    PG8_WAIT_V(0);
    if constexpr (!ALIGN_EPI) { if (wr == 0) PG8_BAR; }
    PG8_BAR;
    if constexpr (Epi::AFTER_DRAIN) { E.fused(acc, cur, wr, wc, fr, fq, lds, wid, lane); S.done(cur); }
#undef PG8_SA
#undef PG8_SB
#undef PG8_STAGE
#undef PG8_LDA
#undef PG8_LDB
#undef PG8_MMA
#undef PG8_WAIT_V
#undef PG8_WAIT_L
#undef PG8_BAR
#undef PG8_SCHED
}
}
constexpr int NWAVES = 8;
#ifndef MK_PER_PHASE
#define MK_PER_PHASE 0
#endif
constexpr int DM = 1024, NB = 2, SEQ = 8192, M = NB * SEQ, DEPTH = 4;
constexpr int CD = 512, HEADS = 4, HD = 128, MD = 512, EVEN_IN = 3592, EVEN_NP = 3840, EVEN_W = 3584, DFF = 2816, CHUNK = 128, NCH = SEQ / CHUNK, NUNIT = NB * HEADS * NCH;
constexpr float RMS_EPS = 1e-6f;
constexpr size_t MiB = 1u << 20;
constexpr size_t WS_CTL = 0, CTL_ZERO_BYTES = 1 * MiB;
constexpr size_t WS_SQ = 1 * MiB;
constexpr size_t WS_VSQ = 2 * MiB;
constexpr size_t WS_GATES = 3 * MiB;
constexpr size_t WS_NLOC = 4 * MiB;
constexpr size_t WS_NIN = 4 * MiB + 256 * 1024;
constexpr size_t WS_MLOC = 4 * MiB + 512 * 1024;
constexpr size_t WS_BL = WS_MLOC + 4096;
constexpr size_t WS_MIN = WS_BL + 4096;
constexpr size_t WS_WEI = 5 * MiB;
constexpr size_t WS_WEO = 20 * MiB;
constexpr size_t WS_WOI = 24 * MiB;
constexpr size_t WS_WOO = 32 * MiB;
constexpr size_t WS_WFI = 36 * MiB;
constexpr size_t WS_WFO = 80 * MiB;
constexpr size_t WS_XB = 102 * MiB;
constexpr size_t WS_Y = 134 * MiB;
constexpr size_t WS_BIG = 166 * MiB;
constexpr size_t WS_CLOC = 278 * MiB;
constexpr size_t WS_CIN = 310 * MiB;
constexpr size_t WS_END = 326 * MiB;
constexpr int CW_BAR = 4096;
constexpr int RING_BYTES = 131072;
constexpr int SQS_OFF = RING_BYTES;
constexpr int LDS_BYTES = 163840;
constexpr int LDSCTL_OFF = LDS_BYTES - 512, MISC_OFF = LDSCTL_OFF + 320;
constexpr int TSTR = 272;
constexpr int TILE_B = 128 * TSTR;
#define GAS __attribute__((address_space(1)))
#define LAS __attribute__((address_space(3)))
typedef unsigned short bf16;
typedef unsigned v4u __attribute__((ext_vector_type(4)));
typedef float f32x4 __attribute__((ext_vector_type(4)));
typedef short bf16x8 __attribute__((ext_vector_type(8)));
typedef GAS unsigned gu32;
typedef GAS unsigned long long gu64;
#define RLX_AGENT __ATOMIC_RELAXED, __HIP_MEMORY_SCOPE_AGENT
#define LDS_WAIT() asm volatile("s_waitcnt lgkmcnt(0)" ::: "memory")
#define VM_WAIT() asm volatile("s_waitcnt vmcnt(0)" ::: "memory")
__device__ __forceinline__ unsigned long long rt() { return __builtin_amdgcn_s_memrealtime(); }
__device__ __forceinline__ unsigned f2bf(float f) { unsigned u = __builtin_bit_cast(unsigned, f); return (u + 0x7fffu + ((u >> 16) & 1u)) >> 16; }
__device__ __forceinline__ unsigned pk2(float lo, float hi) { return f2bf(lo) | (f2bf(hi) << 16); }

#define XB_TMO      128
#define XB_XCNT(j)  (256  + 64 * (j))
#define XB_XSUB(j)  (1280 + 64 * (j))
#define XB_XGEN(j)  (2304 + 64 * (j))
#define XB_TOP      3328
#define XB_TOPGEN   3392
#define XCD_BAR_WORDS 3456
#define XB_SPIN_CAP (1u << 18)

__device__ __forceinline__ unsigned xb_ld(unsigned* p)              { return __hip_atomic_load(p, __ATOMIC_RELAXED, __HIP_MEMORY_SCOPE_AGENT); }
__device__ __forceinline__ unsigned xb_add(unsigned* p, unsigned v) { return __hip_atomic_fetch_add(p, v, __ATOMIC_RELAXED, __HIP_MEMORY_SCOPE_AGENT); }
__device__ __forceinline__ unsigned xb_xcc_id() { return (unsigned)__builtin_amdgcn_s_getreg((3 << 11) | 20) & 0xFu; }
#define XB_SPIN(cond, bar) do { unsigned _sp = 0; while (cond) { __builtin_amdgcn_s_sleep(1); \
    if ((++_sp & 255u) == 0u) { if (xb_ld(&(bar)[XB_TMO])) break; if (_sp > XB_SPIN_CAP) { atomicAdd(&(bar)[XB_TMO], 1u); break; } } } } while (0)

struct XcdBarrier {
    unsigned* bar; unsigned x;
    volatile LAS unsigned* st;
};

__device__ __forceinline__ XcdBarrier xcd_barrier_post(unsigned* bar, volatile LAS unsigned* st) {
    XcdBarrier b; b.bar = bar; b.x = xb_xcc_id(); b.st = st;
    if (threadIdx.x == 0) (void)xb_add(&bar[XB_XCNT(b.x)], 1u);
    return b;
}
__device__ __forceinline__ void xcd_barrier_complete(unsigned* bar, unsigned x, unsigned& nloc, unsigned& nx) {
    const unsigned G = gridDim.x * gridDim.y * gridDim.z;
    unsigned sum, cnt, mine, sp = 0u;
    for (;;) {
        sum = 0u; cnt = 0u; mine = 0u;
#pragma unroll
        for (unsigned j = 0; j < 16; ++j) { const unsigned c = xb_ld(&bar[XB_XCNT(j)]); sum += c; cnt += (c > 0u) ? 1u : 0u; mine = (j == x) ? c : mine; }
        if (sum == G) break;
        __builtin_amdgcn_s_sleep(1);
        if ((++sp & 255u) == 0u) { if (xb_ld(&bar[XB_TMO])) break; if (sp > XB_SPIN_CAP) { atomicAdd(&bar[XB_TMO], 1u); break; } }
    }
    nloc = mine > 0u ? mine : 1u; nx = cnt > 0u ? cnt : 1u;
}

__device__ __forceinline__ void xcd_barrier(const XcdBarrier& b) {
    asm volatile("s_waitcnt vmcnt(0)" ::: "memory");
    __syncthreads();
    if (threadIdx.x == 0) {
        unsigned* bar = b.bar;
        __builtin_amdgcn_s_waitcnt(0);
        unsigned nloc = b.st[0], nx = b.st[1];
        if (nloc == 0u) { xcd_barrier_complete(bar, b.x, nloc, nx); b.st[0] = nloc; b.st[1] = nx; }
        const unsigned old = xb_add(&bar[XB_XSUB(b.x)], 1u);
        const unsigned gen = old / nloc;
        if (old + 1u == (gen + 1u) * nloc) {
            __builtin_amdgcn_fence(__ATOMIC_RELEASE, "agent");
            asm volatile("s_waitcnt vmcnt(0)" ::: "memory");
            const unsigned og = xb_add(&bar[XB_TOP], 1u);
            const unsigned tg = og / nx;
            if (og + 1u == (tg + 1u) * nx) xb_add(&bar[XB_TOPGEN], 1u);
            else XB_SPIN(xb_ld(&bar[XB_TOPGEN]) == tg, bar);
            __builtin_amdgcn_fence(__ATOMIC_ACQUIRE, "agent");
            xb_add(&bar[XB_XGEN(b.x)], 1u);
            asm volatile("s_waitcnt vmcnt(0)" ::: "memory");
        } else {
            XB_SPIN(xb_ld(&bar[XB_XGEN(b.x)]) == gen, bar);
            __builtin_amdgcn_fence(__ATOMIC_ACQUIRE, "agent");
            asm volatile("s_waitcnt vmcnt(0)" ::: "memory");
        }
    }
    __syncthreads();
}
typedef unsigned u32x2 __attribute__((ext_vector_type(2)));
struct Frame {
    LAS unsigned char* lds;
    volatile LAS unsigned* MISC;
    gu32* ctl;
    int vcu, G;
    unsigned char* ws;
    const float* in[16];
    float* x;
};
#define OPQ_TID() int tid = threadIdx.x; asm volatile("" : "+v"(tid)); const int lane = tid & 63, w = __builtin_amdgcn_readfirstlane(tid >> 6), fr = lane & 15, fq = lane >> 4; (void)w; (void)fr; (void)fq
__device__ __forceinline__ float wave_sum(float v) {
#pragma unroll
    for (int o = 1; o < 64; o <<= 1) v += __shfl_xor(v, o);
    return v;
}
__device__ __forceinline__ float wave_max(float v) {
#pragma unroll
    for (int o = 1; o < 64; o <<= 1) v = fmaxf(v, __shfl_xor(v, o));
    return v;
}
__device__ __forceinline__ float bf2f(unsigned short h) { return __builtin_bit_cast(float, (unsigned)h << 16); }
__device__ __forceinline__ float logsig(float x) { return fminf(x, 0.f) - log1pf(expf(-fabsf(x))); }

__device__ __forceinline__ void p0_item(const float* W, int ldw, int K, int sc0, bf16* Bt, int dr0, int k0, const float* gain, float cs, LAS float* scr, int lane) {
#pragma unroll 8
    for (int i = 0; i < 32; ++i) { const int kk = 2 * i + (lane >> 5); const float gk = gain ? gain[k0 + kk] : 1.0f; scr[kk * 33 + (lane & 31)] = W[(size_t)(k0 + kk) * ldw + sc0 + (lane & 31)] * gk; }
    LDS_WAIT(); asm volatile("" ::: "memory");
    const int c = lane & 7;
#pragma unroll
    for (int j = 0; j < 4; ++j) { const int n = (lane >> 3) + 8 * j; const LAS float* s = scr + (8 * c) * 33 + n;
        v4u o; o.x = pk2(s[0 * 33] * cs, s[1 * 33] * cs); o.y = pk2(s[2 * 33] * cs, s[3 * 33] * cs); o.z = pk2(s[4 * 33] * cs, s[5 * 33] * cs); o.w = pk2(s[6 * 33] * cs, s[7 * 33] * cs);
        *(GAS v4u*)(Bt + (size_t)(dr0 + n) * K + k0 + 8 * c) = o; }
    LDS_WAIT(); asm volatile("" ::: "memory");
}
__device__ __forceinline__ void p0_prologue(Frame& F, const float* xin) {
    OPQ_TID();
    LAS float* scr = (LAS float*)(F.lds + w * 16384);
    const int gw = F.vcu * NWAVES + w, NGW = F.G * NWAVES;
    const float* norm_mix = F.in[1]; const float* norm_ffn = F.in[2];
    constexpr int I_EI = 112 * 16, I_EO = 32 * 16, I_OI = 64 * 16, I_OO = 32 * 16, I_FI = 176 * 16, I_FO = 32 * 44;
    constexpr int N0 = 2 * I_EI, N1 = N0 + 2 * I_EO, N2 = N1 + 2 * I_OI, N3 = N2 + 2 * I_OO, N4 = N3 + 4 * I_FI, N5 = N4 + 4 * I_FO, NG = N5 + 32;
    for (int it = gw; it < NG; it += NGW) {
        if (it < N0) { const int j = it / I_EI, r = it % I_EI, kb = r / 112, nb = r % 112, c0 = 32 * nb;
            p0_item(F.in[3] + (size_t)j * DM * EVEN_IN, EVEN_IN, DM, c0, (bf16*)(F.ws + WS_WEI) + (size_t)j * EVEN_NP * DM, c0, 64 * kb, norm_mix + (size_t)(2 * j) * DM, (c0 >= 2048 && c0 < 2560) ? 0.08838834764831845f : 1.0f, scr, lane);
        } else if (it < N1) { const int q = it - N0, j = q / I_EO, r = q % I_EO, kb = r / 32, nb = r % 32;
            p0_item(F.in[7] + (size_t)j * DM * DM, DM, DM, 32 * nb, (bf16*)(F.ws + WS_WEO) + (size_t)j * DM * DM, 32 * nb, 64 * kb, nullptr, 1.0f, scr, lane);
        } else if (it < N2) { const int q = it - N1, j = q / I_OI, r = q % I_OI, kb = r / 64, nb = r % 64;
            p0_item(F.in[8] + (size_t)j * DM * 2048, 2048, DM, 32 * nb, (bf16*)(F.ws + WS_WOI) + (size_t)j * 2048 * DM, 32 * nb, 64 * kb, norm_mix + (size_t)(2 * j + 1) * DM, 1.0f, scr, lane);
        } else if (it < N3) { const int q = it - N2, j = q / I_OO, r = q % I_OO, kb = r / 32, nb = r % 32;
            p0_item(F.in[12] + (size_t)j * DM * DM, DM, DM, 32 * nb, (bf16*)(F.ws + WS_WOO) + (size_t)j * DM * DM, 32 * nb, 64 * kb, nullptr, 1.0f, scr, lane);
        } else if (it < N4) { const int q = it - N3, l = q / I_FI, r = q % I_FI, kb = r / 176, nb = r % 176, c0 = 32 * nb;
            const int up = c0 >= DFF, cc = up ? c0 - DFF : c0, dr = 256 * (cc >> 7) + (up ? 128 : 0) + (cc & 127);
            p0_item(F.in[13] + (size_t)l * DM * 2 * DFF, 2 * DFF, DM, c0, (bf16*)(F.ws + WS_WFI) + (size_t)l * 2 * DFF * DM, dr, 64 * kb, norm_ffn + (size_t)l * DM, 1.0f, scr, lane);
        } else if (it < N5) { const int q = it - N4, l = q / I_FO, r = q % I_FO, kb = r / 32, nb = r % 32;
            p0_item(F.in[14] + (size_t)l * DFF * DM, DM, DFF, 32 * nb, (bf16*)(F.ws + WS_WFO) + (size_t)l * DM * DFF, 32 * nb, 64 * kb, nullptr, 1.0f, scr, lane);
        } else { const int q = it - N5, j = q >> 4, k0 = 64 * (q & 15);
            const float* W = F.in[3] + (size_t)j * DM * EVEN_IN; bf16* Bt = (bf16*)(F.ws + WS_WEI) + (size_t)j * EVEN_NP * DM; const float* gain = norm_mix + (size_t)(2 * j) * DM;
#pragma unroll
            for (int e = 0; e < 8; ++e) { const int id = lane + 64 * e, col = id & 7, kk = k0 + (id >> 3);
                Bt[(size_t)(EVEN_W + col) * DM + kk] = (bf16)f2bf(W[(size_t)kk * EVEN_IN + EVEN_W + col] * gain[kk]); }
        }
    }
    float* sq4 = (float*)(F.ws + WS_SQ); bf16* xb = (bf16*)(F.ws + WS_XB);
    for (int m = gw; m < M; m += NGW) {
        const GAS f32x4* xr = (const GAS f32x4*)(xin + (size_t)m * DM) + lane;
        GAS u32x2* bo = (GAS u32x2*)(xb + (size_t)m * DM) + lane; float s = 0.f;
#pragma unroll
        for (int j = 0; j < 4; ++j) { const f32x4 v = xr[64 * j]; u32x2 w; w.x = pk2(v.x, v.y); w.y = pk2(v.z, v.w); bo[64 * j] = w; s += (v.x * v.x + v.y * v.y) + (v.z * v.z + v.w * v.w); }
        s = wave_sum(s);
        if (lane < 4) sq4[(size_t)m * 4 + lane] = (lane == 0) ? s : 0.f;
    }
}
__device__ __forceinline__ void final_norm(Frame& F) {
    OPQ_TID();
    const int gw = F.vcu * NWAVES + w, NGW = F.G * NWAVES;
    const float* sq4 = (const float*)(F.ws + WS_SQ); const float* gf = F.in[15]; const bf16* xb = (const bf16*)(F.ws + WS_XB);
    f32x4 g[4];
#pragma unroll
    for (int j = 0; j < 4; ++j) g[j] = ((const f32x4*)gf)[lane + 64 * j];
    for (int m = gw; m < M; m += NGW) {
        const float r = pg8::row_rstd4(sq4, m);
        GAS f32x4* xo = (GAS f32x4*)(F.x + (size_t)m * DM) + lane; const GAS u32x2* bi = (const GAS u32x2*)(xb + (size_t)m * DM) + lane;
#pragma unroll
        for (int j = 0; j < 4; ++j) { const u32x2 b = bi[64 * j]; f32x4 v = {pg8::bf_lo(b.x), pg8::bf_hi(b.x), pg8::bf_lo(b.y), pg8::bf_hi(b.y)}; v = v * r * g[j]; xo[64 * j] = v; }
    }
}
__device__ __forceinline__ void scan128_add(float& v0, float& v1, int lane) {
#pragma unroll
    for (int o = 1; o < 64; o <<= 1) { const float a = __shfl_up(v0, o), b = __shfl_up(v1, o); if (lane >= o) { v0 += a; v1 += b; } }
    v1 += __shfl(v0, 63);
}
__device__ __forceinline__ void scan128_max(float& v0, float& v1, int lane) {
#pragma unroll
    for (int o = 1; o < 64; o <<= 1) { const float a = __shfl_up(v0, o), b = __shfl_up(v1, o); if (lane >= o) { v0 = fmaxf(v0, a); v1 = fmaxf(v1, b); } }
    v1 = fmaxf(v1, __shfl(v0, 63));
}
__device__ __forceinline__ void stage_tr(LAS unsigned char* tile, const bf16* src, int ld, const LAS float* sc, int tid) {
#pragma unroll
    for (int i = 0; i < 4; ++i) { const int id = tid + 512 * i, s = id & 127, dc = id >> 7;
        const v4u v = *(const GAS v4u*)(src + (size_t)s * ld + 8 * dc); const float f = sc ? sc[s] : 1.0f;
        const unsigned w[4] = {v.x, v.y, v.z, v.w};
#pragma unroll
        for (int j = 0; j < 4; ++j) { unsigned lo = w[j] & 0xffffu, hi = w[j] >> 16;
            if (sc) { lo = f2bf(bf2f((unsigned short)lo) * f); hi = f2bf(bf2f((unsigned short)hi) * f); }
            *(LAS unsigned short*)(tile + (8 * dc + 2 * j) * TSTR + 2 * s) = (unsigned short)lo; *(LAS unsigned short*)(tile + (8 * dc + 2 * j + 1) * TSTR + 2 * s) = (unsigned short)hi; } }
}
__device__ __forceinline__ void stage_rows(LAS unsigned char* tile, const bf16* src, int ld, int tid) {
#pragma unroll
    for (int i = 0; i < 4; ++i) { const int id = tid + 512 * i, r = id >> 4, dc = id & 15;
        *(LAS v4u*)(tile + r * TSTR + 16 * dc) = *(const GAS v4u*)(src + (size_t)r * ld + 8 * dc); }
}
#define FRAG(tile, row, kk, fq) (*(const LAS bf16x8*)((tile) + (row) * TSTR + (32 * (kk) + 8 * (fq)) * 2))

__device__ __forceinline__ void mlstm_phase_a(Frame& F) {
    LAS unsigned char* TK = F.lds; LAS unsigned char* TV = F.lds + TILE_B; LAS float* aS = (LAS float*)(F.lds + 2 * TILE_B);
    const bf16* proj = (const bf16*)(F.ws + WS_BIG); const float* gates = (const float*)(F.ws + WS_GATES);
    float* Cloc = (float*)(F.ws + WS_CLOC); float* nloc = (float*)(F.ws + WS_NLOC); float* mloc = (float*)(F.ws + WS_MLOC); float* bLv = (float*)(F.ws + WS_BL);
    for (int u = F.vcu; u < NUNIT; u += F.G) {
        OPQ_TID();
        const int bh = u >> 6, c = u & 63, b = bh >> 2, h = bh & 3, row0 = b * SEQ + c * CHUNK;
        if (w == 0) {
            const float i0 = gates[(size_t)(row0 + lane) * 8 + h], i1 = gates[(size_t)(row0 + lane + 64) * 8 + h];
            float b0 = logsig(gates[(size_t)(row0 + lane) * 8 + 4 + h]), b1 = logsig(gates[(size_t)(row0 + lane + 64) * 8 + 4 + h]);
            scan128_add(b0, b1, lane);
            const float bL = __shfl(b1, 63);
            const float w0 = bL - b0 + i0, w1 = bL - b1 + i1;
            const float ml = wave_max(fmaxf(w0, w1));
            aS[lane] = __expf(w0 - ml); aS[lane + 64] = __expf(w1 - ml);
            if (lane == 0) { mloc[u] = ml; bLv[u] = bL; }
        }
        __syncthreads();
        stage_tr(TK, proj + (size_t)row0 * EVEN_W + 2048 + h * HD, EVEN_W, aS, tid);
        stage_tr(TV, proj + (size_t)row0 * EVEN_W + 2560 + h * HD, EVEN_W, nullptr, tid);
        __syncthreads();
        {
            const int d = tid >> 2, q = tid & 3; float s = 0.f;
#pragma unroll
            for (int i = 0; i < 4; ++i) { const bf16x8 v = *(const LAS bf16x8*)(TK + d * TSTR + (32 * q + 8 * i) * 2);
#pragma unroll
                for (int j = 0; j < 8; ++j) s += bf2f((unsigned short)v[j]); }
            s += __shfl_xor(s, 1); s += __shfl_xor(s, 2);
            if (q == 0) nloc[(size_t)u * HD + d] = s;
        }
        bf16x8 vf[4];
#pragma unroll
        for (int kk = 0; kk < 4; ++kk) vf[kk] = FRAG(TV, 16 * w + fr, kk, fq);
#pragma unroll
        for (int db = 0; db < 8; ++db) { f32x4 acc = {0.f, 0.f, 0.f, 0.f};
#pragma unroll
            for (int kk = 0; kk < 4; ++kk) acc = __builtin_amdgcn_mfma_f32_16x16x32_bf16(FRAG(TK, 16 * db + fr, kk, fq), vf[kk], acc, 0, 0, 0);
            *(GAS f32x4*)(Cloc + (size_t)u * (HD * HD) + (size_t)(16 * w + fr) * HD + 16 * db + 4 * fq) = acc; }
        __syncthreads();
    }
}
__device__ __forceinline__ void mlstm_scan_and_conv(Frame& F, const float* wconv) {
    const float* Cloc = (const float*)(F.ws + WS_CLOC); const float* nloc = (const float*)(F.ws + WS_NLOC); const float* mloc = (const float*)(F.ws + WS_MLOC); const float* bLv = (const float*)(F.ws + WS_BL);
    bf16* Cin = (bf16*)(F.ws + WS_CIN); float* nin = (float*)(F.ws + WS_NIN); float* minv = (float*)(F.ws + WS_MIN);
    OPQ_TID();
    const int NT = F.G * 512;
    for (int g = F.vcu * 512 + tid; g < NB * HEADS * (HD * HD + HD); g += NT) {
        const bool isn = g >= NB * HEADS * HD * HD; const int q = isn ? g - NB * HEADS * HD * HD : g;
        const int bh = isn ? (q >> 7) : (q >> 14), idx = isn ? (q & 127) : (q & 16383);
        float C = 0.f, m = 0.f;
        for (int c0 = 0; c0 < NCH; c0 += 8) {
            float cl[8], ml[8], bl[8];
#pragma unroll
            for (int i = 0; i < 8; ++i) { const int u = bh * NCH + c0 + i; cl[i] = isn ? nloc[(size_t)u * HD + idx] : Cloc[(size_t)u * (HD * HD) + idx]; ml[i] = mloc[u]; bl[i] = bLv[u]; }
#pragma unroll
            for (int i = 0; i < 8; ++i) { const int u = bh * NCH + c0 + i;
                if (isn) { nin[(size_t)u * HD + idx] = C; if (idx == 0) minv[u] = m; } else Cin[(size_t)u * (HD * HD) + idx] = (bf16)f2bf(C);
                const float mn = fmaxf(bl[i] + m, ml[i]);
                C = __expf(bl[i] + m - mn) * C + __expf(ml[i] - mn) * cl[i]; m = mn; }
        }
    }
    const bf16* proj = (const bf16*)(F.ws + WS_BIG); bf16* Y = (bf16*)(F.ws + WS_Y);
    for (int g = F.vcu * 512 + tid; g < M * (CD / 8); g += NT) {
        const int t = g >> 6, c8 = (g & 63) * 8, ts = t & (SEQ - 1);
        float acc[8];
#pragma unroll
        for (int j = 0; j < 8; ++j) acc[j] = 0.f;
#pragma unroll
        for (int jj = 0; jj < 3; ++jj) { if (ts - 2 + jj >= 0) { const bf16* p = proj + (size_t)(t - 2 + jj) * EVEN_W;
                const v4u cg = *(const GAS v4u*)(p + CD + c8), xa = *(const GAS v4u*)(p + 2 * CD + c8);
                const unsigned cw[4] = {cg.x, cg.y, cg.z, cg.w}, xw[4] = {xa.x, xa.y, xa.z, xa.w};
#pragma unroll
                for (int j = 0; j < 4; ++j) { acc[2 * j] += wconv[jj * CD + c8 + 2 * j] * (bf2f((unsigned short)(cw[j] & 0xffffu)) * bf2f((unsigned short)(xw[j] & 0xffffu)));
                    acc[2 * j + 1] += wconv[jj * CD + c8 + 2 * j + 1] * (bf2f((unsigned short)(cw[j] >> 16)) * bf2f((unsigned short)(xw[j] >> 16))); } } }
        const v4u bg = *(const GAS v4u*)(proj + (size_t)t * EVEN_W + c8); const unsigned bw[4] = {bg.x, bg.y, bg.z, bg.w}; v4u o; unsigned ow[4];
#pragma unroll
        for (int j = 0; j < 4; ++j) ow[j] = pk2(bf2f((unsigned short)(bw[j] & 0xffffu)) * acc[2 * j], bf2f((unsigned short)(bw[j] >> 16)) * acc[2 * j + 1]);
        o.x = ow[0]; o.y = ow[1]; o.z = ow[2]; o.w = ow[3];
        *(GAS v4u*)(Y + (size_t)t * DM + c8) = o;
    }
}
__device__ __forceinline__ void mlstm_phase_c(Frame& F, const float* ghead) {
    LAS unsigned char* TK = F.lds; LAS unsigned char* TV = F.lds + TILE_B; LAS unsigned char* TC = F.lds + 2 * TILE_B; LAS unsigned char* TS = F.lds + 3 * TILE_B;
    LAS float* gS = (LAS float*)(F.lds + 4 * TILE_B); LAS float* mxS = gS + 128; LAS float* bS = gS + 256; LAS float* nS = gS + 384;
    const bf16* proj = (const bf16*)(F.ws + WS_BIG); const float* gates = (const float*)(F.ws + WS_GATES);
    const bf16* Cin = (const bf16*)(F.ws + WS_CIN); const float* nin = (const float*)(F.ws + WS_NIN); const float* minv = (const float*)(F.ws + WS_MIN);
    bf16* Y = (bf16*)(F.ws + WS_Y);
    for (int u = F.vcu; u < NUNIT; u += F.G) {
        OPQ_TID();
        const int bh = u >> 6, c = u & 63, b = bh >> 2, h = bh & 3, row0 = b * SEQ + c * CHUNK;
        const float m_in = minv[u];
        if (w == 0) {
            const float i0 = gates[(size_t)(row0 + lane) * 8 + h], i1 = gates[(size_t)(row0 + lane + 64) * 8 + h];
            float b0 = logsig(gates[(size_t)(row0 + lane) * 8 + 4 + h]), b1 = logsig(gates[(size_t)(row0 + lane + 64) * 8 + 4 + h]);
            scan128_add(b0, b1, lane);
            const float g0 = i0 - b0, g1 = i1 - b1; float p0 = g0, p1 = g1;
            scan128_max(p0, p1, lane);
            gS[lane] = g0; gS[lane + 64] = g1; mxS[lane] = fmaxf(m_in, p0); mxS[lane + 64] = fmaxf(m_in, p1); bS[lane] = b0; bS[lane + 64] = b1;
        } else if (w == 1) { nS[lane] = nin[(size_t)u * HD + lane]; nS[lane + 64] = nin[(size_t)u * HD + lane + 64]; }
        const int t = 16 * w + fr;
        bf16x8 qf[4];
#pragma unroll
        for (int kk = 0; kk < 4; ++kk) qf[kk] = *(const GAS bf16x8*)(proj + (size_t)(row0 + t) * EVEN_W + 1536 + h * HD + 32 * kk + 8 * fq);
        stage_rows(TK, proj + (size_t)row0 * EVEN_W + 2048 + h * HD, EVEN_W, tid);
        stage_rows(TC, Cin + (size_t)u * (HD * HD), HD, tid);
        stage_tr(TV, proj + (size_t)row0 * EVEN_W + 2560 + h * HD, EVEN_W, nullptr, tid);
        __syncthreads();
        const float mx_t = mxS[t], b_t = bS[t], inter = __expf(m_in - mx_t);
        float den1 = 0.f;
#pragma unroll
        for (int sb = 0; sb < 8; ++sb) {
            u32x2 pk = {0u, 0u};
            if (sb <= w) { f32x4 acc = {0.f, 0.f, 0.f, 0.f};
#pragma unroll
                for (int kk = 0; kk < 4; ++kk) acc = __builtin_amdgcn_mfma_f32_16x16x32_bf16(FRAG(TK, 16 * sb + fr, kk, fq), qf[kk], acc, 0, 0, 0);
                float sv[4];
#pragma unroll
                for (int r = 0; r < 4; ++r) { const int s = 16 * sb + 4 * fq + r; const float e = __expf(gS[s] - mx_t); sv[r] = (s <= t) ? acc[r] * e : 0.f; den1 += sv[r]; }
                pk.x = pk2(sv[0], sv[1]); pk.y = pk2(sv[2], sv[3]); }
            *(LAS u32x2*)(TS + t * TSTR + (16 * sb + 4 * fq) * 2) = pk;
        }
        den1 += __shfl_xor(den1, 16); den1 += __shfl_xor(den1, 32);
        float qn = 0.f;
#pragma unroll
        for (int kk = 0; kk < 4; ++kk)
#pragma unroll
            for (int j = 0; j < 8; ++j) qn += bf2f((unsigned short)qf[kk][j]) * nS[32 * kk + 8 * fq + j];
        qn += __shfl_xor(qn, 16); qn += __shfl_xor(qn, 32);
        const float den = den1 + inter * qn, m_t = b_t + mx_t;
        const float rden = 1.0f / fmaxf(fabsf(den), __expf(-m_t));
        bf16x8 sf[4];
#pragma unroll
        for (int kk = 0; kk < 4; ++kk) sf[kk] = FRAG(TS, t, kk, fq);
        float hh[32]; float ssq = 0.f;
#pragma unroll
        for (int eb = 0; eb < 8; ++eb) { f32x4 a1 = {0.f, 0.f, 0.f, 0.f}, a2 = {0.f, 0.f, 0.f, 0.f};
#pragma unroll
            for (int kk = 0; kk < 4; ++kk) { if (2 * kk <= w) a1 = __builtin_amdgcn_mfma_f32_16x16x32_bf16(FRAG(TV, 16 * eb + fr, kk, fq), sf[kk], a1, 0, 0, 0);
                a2 = __builtin_amdgcn_mfma_f32_16x16x32_bf16(FRAG(TC, 16 * eb + fr, kk, fq), qf[kk], a2, 0, 0, 0); }
#pragma unroll
            for (int r = 0; r < 4; ++r) { const float v = (a1[r] + inter * a2[r]) * rden; hh[4 * eb + r] = v; ssq += v * v; } }
        ssq += __shfl_xor(ssq, 16); ssq += __shfl_xor(ssq, 32);
        const float rs = __builtin_amdgcn_rsqf(ssq * (1.0f / 128.0f) + RMS_EPS);
#pragma unroll
        for (int eb = 0; eb < 8; ++eb) { const int e = 16 * eb + 4 * fq;
            const u32x2 ov = *(const GAS u32x2*)(proj + (size_t)(row0 + t) * EVEN_W + 3072 + h * HD + e); const f32x4 gh = *(const f32x4*)(ghead + h * HD + e);
            const float o0 = bf2f((unsigned short)(ov.x & 0xffffu)), o1 = bf2f((unsigned short)(ov.x >> 16)), o2 = bf2f((unsigned short)(ov.y & 0xffffu)), o3 = bf2f((unsigned short)(ov.y >> 16));
            u32x2 y; y.x = pk2(pg8::fast_sigmoid(o0) * hh[4 * eb] * rs * gh[0], pg8::fast_sigmoid(o1) * hh[4 * eb + 1] * rs * gh[1]);
            y.y = pk2(pg8::fast_sigmoid(o2) * hh[4 * eb + 2] * rs * gh[2], pg8::fast_sigmoid(o3) * hh[4 * eb + 3] * rs * gh[3]);
            *(GAS u32x2*)(Y + (size_t)(row0 + t) * DM + MD + h * HD + e) = y; }
        __syncthreads();
    }
}
__device__ __forceinline__ void sgu_phase(Frame& F, const float* gv, const float* wsp, const float* bsp) {
    LAS unsigned char* TW = F.lds; LAS unsigned char* TV = F.lds + TILE_B; LAS float* rS = (LAS float*)(F.lds + 2 * TILE_B);
    const bf16* Z = (const bf16*)(F.ws + WS_BIG); const float* vsq16 = (const float*)(F.ws + WS_VSQ); bf16* Y = (bf16*)(F.ws + WS_Y);
    for (int u = F.vcu; u < (M / CHUNK) * 8; u += F.G) {
        OPQ_TID();
        const int cb = u >> 3, g = u & 7, row0 = cb * CHUNK;
        if (tid < 128) rS[tid] = pg8::row_rstd16(vsq16, row0 + tid);
        __syncthreads();
#pragma unroll
        for (int i = 0; i < 8; ++i) { const int id = tid + 512 * i, t = id >> 5, s4 = (id & 31) * 4;
            const f32x4 wv = *(const f32x4*)(wsp + ((size_t)g * CHUNK + t) * CHUNK + s4); float v[4];
#pragma unroll
            for (int j = 0; j < 4; ++j) v[j] = (s4 + j <= t) ? wv[j] * rS[s4 + j] : 0.f;
            u32x2 pk; pk.x = pk2(v[0], v[1]); pk.y = pk2(v[2], v[3]);
            *(LAS u32x2*)(TW + t * TSTR + s4 * 2) = pk; }
        stage_tr(TV, Z + (size_t)row0 * 2048 + 1024 + g * 128, 2048, nullptr, tid);
        __syncthreads();
        const int t = 16 * w + fr;
        bf16x8 wf[4];
#pragma unroll
        for (int kk = 0; kk < 4; ++kk) wf[kk] = FRAG(TW, t, kk, fq);
        const float bst = bsp[g * CHUNK + t];
#pragma unroll
        for (int db = 0; db < 8; ++db) { f32x4 acc = {0.f, 0.f, 0.f, 0.f};
#pragma unroll
            for (int kk = 0; kk < 4; ++kk) if (2 * kk <= w) acc = __builtin_amdgcn_mfma_f32_16x16x32_bf16(FRAG(TV, 16 * db + fr, kk, fq), wf[kk], acc, 0, 0, 0);
            const int col = g * 128 + 16 * db + 4 * fq;
            const f32x4 gvv = *(const f32x4*)(gv + col); const u32x2 uv = *(const GAS u32x2*)(Z + (size_t)(row0 + t) * 2048 + col);
            const float u0 = bf2f((unsigned short)(uv.x & 0xffffu)), u1 = bf2f((unsigned short)(uv.x >> 16)), u2 = bf2f((unsigned short)(uv.y & 0xffffu)), u3 = bf2f((unsigned short)(uv.y >> 16));
            u32x2 y; y.x = pk2(u0 * (acc[0] * gvv[0] + bst), u1 * (acc[1] * gvv[1] + bst)); y.y = pk2(u2 * (acc[2] * gvv[2] + bst), u3 * (acc[3] * gvv[3] + bst));
            *(GAS u32x2*)(Y + (size_t)(row0 + t) * DM + col) = y; }
        __syncthreads();
    }
}
#ifndef PROBE_MASK
#define PROBE_MASK 0
#endif
struct Args { const float* in[16]; float* out; unsigned char* ws; int ph_lo, ph_hi; };
constexpr int N_PHASES = 26;
enum Kind { K_P0, K_E1, K_E2, K_E3, K_E4, K_RESMIX, K_F1, K_RESFFN, K_O1, K_O2, K_FINAL };
__device__ __forceinline__ void decode_phase(int p, int& kind, int& layer) {
    if (p == 0) { kind = K_P0; layer = 0; return; }
    if (p == 25) { kind = K_FINAL; layer = 0; return; }
    int q = p - 1; const int pair = q / 12; q -= pair * 12;
    if (q < 7) { layer = 2 * pair; kind = q == 0 ? K_E1 : q == 1 ? K_E2 : q == 2 ? K_E3 : q == 3 ? K_E4 : q == 4 ? K_RESMIX : q == 5 ? K_F1 : K_RESFFN; }
    else { layer = 2 * pair + 1; q -= 7; kind = q == 0 ? K_O1 : q == 1 ? K_O2 : q == 2 ? K_RESMIX : q == 3 ? K_F1 : K_RESFFN; }
}
__global__ void __launch_bounds__(NWAVES * 64, 2) trunk_fwd(Args args) {
    extern __shared__ __attribute__((aligned(16))) unsigned char lds[];
    Frame F;
    F.lds = (LAS unsigned char*)lds;
    F.MISC = (volatile LAS unsigned*)(F.lds + MISC_OFF);
    F.G = gridDim.x; { const int bx = blockIdx.x; F.vcu = (F.G % 8 == 0) ? (bx % 8) * (F.G / 8) + bx / 8 : bx; }
    F.ws = args.ws; F.ctl = (gu32*)(args.ws + WS_CTL); F.x = args.out;
#pragma unroll
    for (int i = 0; i < 16; ++i) F.in[i] = args.in[i];
    for (int u = threadIdx.x; u < (LDS_BYTES - LDSCTL_OFF) / 4; u += NWAVES * 64) ((LAS unsigned*)(F.lds + LDSCTL_OFF))[u] = 0u;
    __syncthreads();
    XcdBarrier bar; bar.bar = (unsigned*)(F.ctl + CW_BAR); bar.x = 0; bar.st = nullptr;
    if (!MK_PER_PHASE) bar = xcd_barrier_post((unsigned*)(F.ctl + CW_BAR), F.MISC + 8);
    bf16* xb = (bf16*)(F.ws + WS_XB); bf16* Yb = (bf16*)(F.ws + WS_Y); bf16* big = (bf16*)(F.ws + WS_BIG);
    float* sq16 = (float*)(F.ws + WS_SQ);
    for (int p = args.ph_lo; p < args.ph_hi; ++p) {
        int kind, layer; decode_phase(p, kind, layer);
        const int j = layer >> 1;
        const int reps = ((PROBE_MASK >> kind) & 1) ? 2 : 1;
        for (int rep = 0; rep < reps; ++rep) {
        if (kind == K_P0) { p0_prologue(F, F.in[0]); }
        else if (kind == K_E1) {
            pg8::Gemm g{xb, (const bf16*)(F.ws + WS_WEI) + (size_t)j * EVEN_NP * DM, M, EVEN_NP, DM}; pg8::StaticOrder S; S.init(M, EVEN_NP, F.G, (int)blockIdx.x);
            pg8::EpiEvenIn E{big, sq16, (float*)(F.ws + WS_GATES), F.in[5] + (size_t)j * 8};
            pg8::gemm_phase<pg8::EpiEvenIn, pg8::StaticOrder, true, true>(F.lds, g, S, E);
        }
        else if (kind == K_E2) { mlstm_phase_a(F); }
        else if (kind == K_E3) { mlstm_scan_and_conv(F, F.in[4] + (size_t)j * 3 * CD); }
        else if (kind == K_E4) { mlstm_phase_c(F, F.in[6] + (size_t)j * MD); }
        else if (kind == K_RESMIX || kind == K_RESFFN) {
            const bool ffn = kind == K_RESFFN, odd = layer & 1;
            const bf16* A = ffn ? big : Yb;
            const bf16* Bt = ffn ? (const bf16*)(F.ws + WS_WFO) + (size_t)layer * DM * DFF : odd ? (const bf16*)(F.ws + WS_WOO) + (size_t)j * DM * DM : (const bf16*)(F.ws + WS_WEO) + (size_t)j * DM * DM;
            pg8::Gemm g{A, Bt, M, DM, ffn ? DFF : DM}; pg8::StaticOrder S; S.init(M, DM, F.G, (int)blockIdx.x);
            pg8::EpiResid E{xb, (LAS float*)(F.lds + SQS_OFF)};
            pg8::gemm_phase<pg8::EpiResid, pg8::StaticOrder, false, true>(F.lds, g, S, E);
            __syncthreads();
            { OPQ_TID(); (void)lane; pg8::Unit u0; if (S.next(0, u0) && tid < 256) { const f32x4 q = *(const LAS f32x4*)(F.lds + SQS_OFF + tid * 16);
                sq16[(size_t)(u0.pm * 256 + tid) * 4 + u0.pn] = (q[0] + q[1]) + (q[2] + q[3]); } }
        }
        else if (kind == K_F1) {
            pg8::Gemm g{xb, (const bf16*)(F.ws + WS_WFI) + (size_t)layer * 2 * DFF * DM, M, 2 * DFF, DM}; pg8::StaticOrder S; S.init(M, 2 * DFF, F.G, (int)blockIdx.x);
            pg8::EpiSwiGLU E{big, sq16};
            pg8::gemm_phase<pg8::EpiSwiGLU, pg8::StaticOrder, true, true>(F.lds, g, S, E);
        }
        else if (kind == K_O1) {
            pg8::Gemm g{xb, (const bf16*)(F.ws + WS_WOI) + (size_t)j * 2048 * DM, M, 2048, DM}; pg8::StaticOrder S; S.init(M, 2048, F.G, (int)blockIdx.x);
            pg8::EpiGeluZ E{big, sq16, (float*)(F.ws + WS_VSQ)};
            pg8::gemm_phase<pg8::EpiGeluZ, pg8::StaticOrder, true, true>(F.lds, g, S, E);
        }
        else if (kind == K_O2) { sgu_phase(F, F.in[9] + (size_t)j * DM, F.in[10] + (size_t)j * 8 * CHUNK * CHUNK, F.in[11] + (size_t)j * 8 * CHUNK); }
        else { final_norm(F); }
        if (rep + 1 < reps) xcd_barrier(bar);
        }
        if (p + 1 < args.ph_hi) xcd_barrier(bar);
    }
}

extern "C" void kernel_launch(void* const* d_in, const int* in_sizes, int n_in, void* d_out, int out_size, void* d_ws, size_t ws_size, hipStream_t stream) {
    static int grid = 0;
    if (grid == 0) {
        if (n_in != 16 || in_sizes[0] != M * DM || out_size != M * DM || ws_size < WS_END) { fprintf(stderr, "kernel_launch: unexpected shapes / workspace (n_in %d, ws %zu < %zu); nothing launched\n", n_in, ws_size, (size_t)WS_END); grid = -1; return; }
        int dev = 0, cus = 0, per_cu = 0;
        if (hipGetDevice(&dev) != hipSuccess || hipDeviceGetAttribute(&cus, hipDeviceAttributeMultiprocessorCount, dev) != hipSuccess) { grid = -1; return; }
        if (hipFuncSetAttribute((const void*)trunk_fwd, hipFuncAttributeMaxDynamicSharedMemorySize, LDS_BYTES) != hipSuccess) { fprintf(stderr, "kernel_launch: hipFuncSetAttribute failed\n"); grid = -1; return; }
        if (hipOccupancyMaxActiveBlocksPerMultiprocessor(&per_cu, (const void*)trunk_fwd, NWAVES * 64, LDS_BYTES) != hipSuccess || per_cu < 1) fprintf(stderr, "kernel_launch: note: occupancy query says %d\n", per_cu);
        (void)hipGetLastError();
        grid = cus;
    }
    if (grid < 0) return;
    if (hipMemsetAsync((char*)d_ws + WS_CTL, 0, CTL_ZERO_BYTES, stream) != hipSuccess) return;
    Args a{};
    for (int i = 0; i < 16; ++i) a.in[i] = (const float*)d_in[i];
    a.out = (float*)d_out; a.ws = (unsigned char*)d_ws;
#if MK_PER_PHASE
    for (int p = 0; p < N_PHASES; ++p) { a.ph_lo = p; a.ph_hi = p + 1; hipLaunchKernelGGL(trunk_fwd, dim3(grid), dim3(NWAVES * 64), LDS_BYTES, stream, a); }
#else
    a.ph_lo = 0; a.ph_hi = N_PHASES; hipLaunchKernelGGL(trunk_fwd, dim3(grid), dim3(NWAVES * 64), LDS_BYTES, stream, a);
#endif
}
```

```cpp
#include <hip/hip_runtime.h>
#include <cstdio>
#include <cstdint>
#define MK_PER_PHASE 0
namespace pg8 {
#define PG8_LAS __attribute__((address_space(3)))
typedef unsigned short bf16_t;
typedef short bf16x8 __attribute__((ext_vector_type(8)));
typedef float f32x4 __attribute__((ext_vector_type(4)));
typedef unsigned u32x4 __attribute__((ext_vector_type(4)));
constexpr int BM = 256, BK = 64, HALF = 128, HTB = HALF * BK * 2  , STAGE_BYTES = 8 * HTB, NXCD = 8, WGM = 8;

__host__ __device__ __forceinline__ int lds_byte(int r, int c) { const int st = (r >> 4) * 2 + (c >> 5), rr = r & 15, cc = c & 31, ob = rr * 64 + cc * 2; return st * 1024 + (ob ^ (((ob >> 9) & 1) << 5)); }
__host__ __device__ __forceinline__ void stage_rc(int b, int& R, int& C) { const int st = b / 1024, sb = b % 1024, swz = sb ^ (((sb >> 9) & 1) << 5); R = (st >> 1) * 16 + swz / 64; C = (st & 1) * 32 + (swz % 64) / 2; }
__host__ __device__ __forceinline__ int perm32(int rho) { const int n = rho >> 4, i = rho & 15; return 8 * (i >> 2) + 4 * n + (i & 3); }

struct Unit { int pm, pn; };
struct Gemm { const bf16_t* A; const bf16_t* Bt; int M, N, K; };

struct StaticOrder {
    int nM, nN, nwg, G, c;
    __host__ __device__ void init(int M, int N, int G_, int c_) { nM = M / BM; nN = N / BM; nwg = nM * nN; G = G_; c = c_; }
    __host__ __device__ bool next(int i, Unit& u) const {
        const long L = (long)i * G + c; if (L >= nwg) return false;
        int wgid = (int)L; { const int q = nwg / NXCD, r = nwg % NXCD, xcd = wgid % NXCD, off = wgid / NXCD; wgid = (xcd < r ? xcd * (q + 1) : r * (q + 1) + (xcd - r) * q) + off; }
        const int nig = WGM * nN, gid = wgid / nig, fm = gid * WGM, gsz = (nM - fm) < WGM ? (nM - fm) : WGM;
        u.pm = fm + ((wgid % nig) % gsz); u.pn = (wgid % nig) / gsz; return true;
    }
    __device__ __forceinline__ void a_ready(const Unit&) const {}
    __device__ __forceinline__ void done(const Unit&) const {}
};

__device__ __forceinline__ unsigned cvt_pk_bf16(float lo, float hi) { unsigned r; asm volatile("v_cvt_pk_bf16_f32 %0, %1, %2" : "=v"(r) : "v"(lo), "v"(hi)); return r; }
typedef float f32x2 __attribute__((ext_vector_type(2)));
constexpr float RMS_EPS_F = 1e-6f;
typedef unsigned u32x2 __attribute__((ext_vector_type(2)));
__device__ __forceinline__ float row_rstd4(const float* sq4, int row) {
    const f32x4 a = *(const f32x4*)(sq4 + (size_t)row * 4);
    return __builtin_amdgcn_rsqf(((a[0] + a[1]) + (a[2] + a[3])) * (1.0f / 1024.0f) + RMS_EPS_F);
}
__device__ __forceinline__ float row_rstd16(const float* sq16, int row) {
    const f32x4* p = (const f32x4*)(sq16 + (size_t)row * 16);
    const f32x4 a = p[0], b = p[1], c = p[2], d = p[3];
    const float s = ((a[0] + a[1]) + (a[2] + a[3])) + ((b[0] + b[1]) + (b[2] + b[3])) + ((c[0] + c[1]) + (c[2] + c[3])) + ((d[0] + d[1]) + (d[2] + d[3]));
    return __builtin_amdgcn_rsqf(s * (1.0f / 1024.0f) + RMS_EPS_F);
}
__device__ __forceinline__ float bf_lo(unsigned w) { return __builtin_bit_cast(float, w << 16); }
__device__ __forceinline__ float bf_hi(unsigned w) { return __builtin_bit_cast(float, w & 0xffff0000u); }
__device__ __forceinline__ float fast_sigmoid(float x) { return __builtin_amdgcn_rcpf(1.0f + __expf(-x)); }
struct EpiEvenIn {
    static constexpr bool PERM = true, AFTER_DRAIN = false;
    bf16_t* O; const float* sq16; float* gates; const float* bgate;
    __device__ __forceinline__ void operator()(const f32x4 (&acc)[2][2][4][2], const Unit& u, int wr, int wc, int fr, int fq) const {
        const int row0 = u.pm * BM + wr * 64 + fr;
        if (u.pn < 14) {
            const int col0 = u.pn * BM + wc * 32 + 8 * fq;
#pragma unroll
            for (int ai = 0; ai < 2; ++ai)
#pragma unroll
                for (int m = 0; m < 4; ++m) { const int row = row0 + ai * HALF + m * 16; const float r = row_rstd4(sq16, row); bf16_t* rowp = O + (size_t)row * 3584 + col0;
#pragma unroll
                    for (int bj = 0; bj < 2; ++bj) { const f32x4 v0 = acc[ai][bj][m][0] * r, v1 = acc[ai][bj][m][1] * r;
                        u32x4 w; w.x = cvt_pk_bf16(v0[0], v0[1]); w.y = cvt_pk_bf16(v0[2], v0[3]); w.z = cvt_pk_bf16(v1[0], v1[1]); w.w = cvt_pk_bf16(v1[2], v1[3]);
                        *(u32x4*)(rowp + bj * HALF) = w; } }
        } else if (wc == 0 && fq == 0) {
            const f32x4 b0 = *(const f32x4*)(bgate), b1 = *(const f32x4*)(bgate + 4);
#pragma unroll
            for (int ai = 0; ai < 2; ++ai)
#pragma unroll
                for (int m = 0; m < 4; ++m) { const int row = row0 + ai * HALF + m * 16; const float r = row_rstd4(sq16, row);
                    *(f32x4*)(gates + (size_t)row * 8) = acc[ai][0][m][0] * r + b0; *(f32x4*)(gates + (size_t)row * 8 + 4) = acc[ai][0][m][1] * r + b1; }
        }
    }
};
struct EpiResid {
    static constexpr bool PERM = true, AFTER_DRAIN = false;
    bf16_t* xb; PG8_LAS float* sqs;
    __device__ __forceinline__ void operator()(const f32x4 (&acc)[2][2][4][2], const Unit& u, int wr, int wc, int fr, int fq) const {
        const int rl0 = wr * 64 + fr, col0 = u.pn * BM + wc * 32 + 8 * fq;
#pragma unroll
        for (int ai = 0; ai < 2; ++ai)
#pragma unroll
            for (int m = 0; m < 4; ++m) { const int rl = rl0 + ai * HALF + m * 16; bf16_t* rowp = xb + (size_t)(u.pm * BM + rl) * 1024 + col0; float ss = 0.f;
#pragma unroll
                for (int bj = 0; bj < 2; ++bj) { const u32x4 o = *(const u32x4*)(rowp + bj * HALF);
                    const f32x4 v0 = acc[ai][bj][m][0] + (f32x4){bf_lo(o.x), bf_hi(o.x), bf_lo(o.y), bf_hi(o.y)}, v1 = acc[ai][bj][m][1] + (f32x4){bf_lo(o.z), bf_hi(o.z), bf_lo(o.w), bf_hi(o.w)};
                    u32x4 w; w.x = cvt_pk_bf16(v0[0], v0[1]); w.y = cvt_pk_bf16(v0[2], v0[3]); w.z = cvt_pk_bf16(v1[0], v1[1]); w.w = cvt_pk_bf16(v1[2], v1[3]);
                    *(u32x4*)(rowp + bj * HALF) = w;
                    ss += ((v0[0] * v0[0] + v0[1] * v0[1]) + (v0[2] * v0[2] + v0[3] * v0[3])) + ((v1[0] * v1[0] + v1[1] * v1[1]) + (v1[2] * v1[2] + v1[3] * v1[3])); }
                ss += __shfl_xor(ss, 16); ss += __shfl_xor(ss, 32);
                if (fq == 0) sqs[rl * 4 + wc] = ss;
                asm volatile("" ::: "memory"); }
    }
};
struct EpiSwiGLU {
    static constexpr bool PERM = true, AFTER_DRAIN = false;
    bf16_t* O; const float* sq16;
    __device__ __forceinline__ void operator()(const f32x4 (&acc)[2][2][4][2], const Unit& u, int wr, int wc, int fr, int fq) const {
        const int row0 = u.pm * BM + wr * 64 + fr, col0 = u.pn * HALF + wc * 32 + 8 * fq;
#pragma unroll
        for (int ai = 0; ai < 2; ++ai)
#pragma unroll
            for (int m = 0; m < 4; ++m) { const int row = row0 + ai * HALF + m * 16; const float r = row_rstd4(sq16, row);
                float h[8];
#pragma unroll
                for (int n = 0; n < 2; ++n)
#pragma unroll
                    for (int j = 0; j < 4; ++j) { const float g = acc[ai][0][m][n][j] * r, up = acc[ai][1][m][n][j] * r; h[4 * n + j] = g * fast_sigmoid(g) * up; }
                u32x4 w; w.x = cvt_pk_bf16(h[0], h[1]); w.y = cvt_pk_bf16(h[2], h[3]); w.z = cvt_pk_bf16(h[4], h[5]); w.w = cvt_pk_bf16(h[6], h[7]);
                *(u32x4*)(O + (size_t)row * 2816 + col0) = w; }
    }
};
struct EpiGeluZ {
    static constexpr bool PERM = true, AFTER_DRAIN = false;
    bf16_t* O; const float* sq16; float* vsq16;
    __device__ __forceinline__ void operator()(const f32x4 (&acc)[2][2][4][2], const Unit& u, int wr, int wc, int fr, int fq) const {
        const int row0 = u.pm * BM + wr * 64 + fr, col0 = u.pn * BM + wc * 32 + 8 * fq;
#pragma unroll
        for (int ai = 0; ai < 2; ++ai)
#pragma unroll
            for (int m = 0; m < 4; ++m) { const int row = row0 + ai * HALF + m * 16; const float r = row_rstd4(sq16, row); float ss = 0.f;
#pragma unroll
                for (int bj = 0; bj < 2; ++bj) { float z[8];
#pragma unroll
                    for (int n = 0; n < 2; ++n)
#pragma unroll
                        for (int j = 0; j < 4; ++j) { const float v = acc[ai][bj][m][n][j] * r; const float t = 1.5957691216057308f * (v + 0.044715f * v * v * v); const float zz = v * fast_sigmoid(t); z[4 * n + j] = zz; ss += zz * zz; }
                    u32x4 w; w.x = cvt_pk_bf16(z[0], z[1]); w.y = cvt_pk_bf16(z[2], z[3]); w.z = cvt_pk_bf16(z[4], z[5]); w.w = cvt_pk_bf16(z[6], z[7]);
                    *(u32x4*)(O + (size_t)row * 2048 + col0 + bj * HALF) = w; }
                if (u.pn >= 4) { ss += __shfl_xor(ss, 16); ss += __shfl_xor(ss, 32); if (fq == 0) vsq16[(size_t)row * 16 + (u.pn - 4) * 4 + wc] = ss; } }
    }
};
template <class Epi, class Sched, bool ALIGN_EPI = false, bool SP2 = false>
__device__ __forceinline__ void gemm_phase(PG8_LAS unsigned char* lds, const Gemm g, const Sched& S, const Epi& E) {
    int tid_ = threadIdx.x; asm volatile("" : "+v"(tid_)); const int tid = tid_, wid = __builtin_amdgcn_readfirstlane(tid >> 6), lane = tid & 63, wr = wid >> 2, wc = wid & 3, fr = lane & 15, fq = lane >> 4;
    const int K = g.K, nt = K / BK;
    unsigned voffA[2], voffB[2];
#pragma unroll
    for (int i = 0; i < 2; ++i) { int R, C; stage_rc(tid * 16 + i * 8192, R, C); const int Rb = Epi::PERM ? ((R & ~31) + perm32(R & 31)) : R;
        voffA[i] = (unsigned)(R * K + C) * 2u; voffB[i] = (unsigned)(Rb * K + C) * 2u; }
    const size_t kstep = (size_t)(BK * 2);
    const size_t hstep = (size_t)HALF * K * 2;
    const size_t tstep = 2 * hstep;
    const unsigned ldsw = (unsigned)wid * 1024u;
    const int aoff = lds_byte(wr * 64 + fr, fq * 8), boff = lds_byte(wc * 32 + fr, fq * 8);
#define PG8_SA(b, h) (((b) * 2 + (h)) * HTB)
#define PG8_SB(b, h) ((4 + (b) * 2 + (h)) * HTB)
#define PG8_STAGE(bufoff, gbase, voff) do { _Pragma("unroll") for (int _i = 0; _i < 2; ++_i) \
        __builtin_amdgcn_global_load_lds((const unsigned*)((const char*)(gbase) + (voff)[_i]), (PG8_LAS unsigned*)(lds + (bufoff) + ldsw + _i * 8192), 16, 0, 0); } while (0)
#define PG8_LDA(dst, b, h) do { _Pragma("unroll") for (int m = 0; m < 4; ++m) _Pragma("unroll") for (int k = 0; k < 2; ++k) dst[m][k] = *(const PG8_LAS bf16x8*)(lds + PG8_SA(b, h) + aoff + m * 2048 + k * 1024); } while (0)
#define PG8_LDB(dst, b, h) do { _Pragma("unroll") for (int n = 0; n < 2; ++n) _Pragma("unroll") for (int k = 0; k < 2; ++k) dst[n][k] = *(const PG8_LAS bf16x8*)(lds + PG8_SB(b, h) + boff + n * 2048 + k * 1024); } while (0)
#define PG8_MMA(ai, bj, At, Bt) do { __builtin_amdgcn_s_setprio(1); _Pragma("unroll") for (int m = 0; m < 4; ++m) _Pragma("unroll") for (int n = 0; n < 2; ++n) _Pragma("unroll") for (int k = 0; k < 2; ++k) \
        acc[ai][bj][m][n] = __builtin_amdgcn_mfma_f32_16x16x32_bf16(Bt[n][k], At[m][k], acc[ai][bj][m][n], 0, 0, 0); __builtin_amdgcn_s_setprio(0); } while (0)
#define PG8_WAIT_V(n) asm volatile("s_waitcnt vmcnt(" #n ")" ::: "memory")
#define PG8_WAIT_L(n) asm volatile("s_waitcnt lgkmcnt(" #n ")" ::: "memory")
#define PG8_BAR __builtin_amdgcn_s_barrier()
#define PG8_SCHED __builtin_amdgcn_sched_barrier(0)
    Unit cur, nxt; int ui = 0;
    if (!S.next(0, cur)) return;
    f32x4 acc[2][2][4][2];
#pragma unroll
    for (int a = 0; a < 2; ++a)
#pragma unroll
        for (int b = 0; b < 2; ++b)
#pragma unroll
            for (int m = 0; m < 4; ++m)
#pragma unroll
                for (int n = 0; n < 2; ++n) acc[a][b][m][n] = (f32x4){0.f, 0.f, 0.f, 0.f};
    bf16x8 At[4][2], B0[2][2], B1[2][2];
    const char* cA = (const char*)g.A + (size_t)cur.pm * tstep; const char* cB = (const char*)g.Bt + (size_t)cur.pn * tstep;
    S.a_ready(cur);
    if constexpr (SP2) {
        PG8_STAGE(PG8_SB(0, 0), cB, voffB); PG8_STAGE(PG8_SB(0, 1), cB + hstep, voffB); PG8_STAGE(PG8_SA(0, 0), cA, voffA); PG8_STAGE(PG8_SA(0, 1), cA + hstep, voffA);
        if (wr == 1) PG8_BAR;
        PG8_WAIT_V(2); PG8_BAR;
        PG8_STAGE(PG8_SB(1, 0), cB + kstep, voffB); PG8_STAGE(PG8_SA(1, 0), cA + kstep, voffA); PG8_STAGE(PG8_SB(1, 1), cB + hstep + kstep, voffB);
        PG8_WAIT_V(6); PG8_BAR;
    } else {
        PG8_STAGE(PG8_SB(0, 0), cB, voffB); PG8_STAGE(PG8_SA(0, 0), cA, voffA); PG8_STAGE(PG8_SB(0, 1), cB + hstep, voffB); PG8_STAGE(PG8_SA(0, 1), cA + hstep, voffA);
        if (wr == 1) PG8_BAR;
        PG8_WAIT_V(4); PG8_BAR;
        PG8_STAGE(PG8_SB(1, 0), cB + kstep, voffB); PG8_STAGE(PG8_SA(1, 0), cA + kstep, voffA); PG8_STAGE(PG8_SB(1, 1), cB + hstep + kstep, voffB);
        PG8_WAIT_V(6); PG8_BAR;
    }
    for (;;) {
        const bool has_next = S.next(ui + 1, nxt);
        const char* nA = has_next ? (const char*)g.A + (size_t)nxt.pm * tstep : cA; const char* nB = has_next ? (const char*)g.Bt + (size_t)nxt.pn * tstep : cB;
        for (int t = 0; t < nt; t += 2) {
            const bool last = (t == nt - 2);
            const char* a1 = cA + (size_t)(t + 1) * kstep;
            const char* a2 = last ? nA : cA + (size_t)(t + 2) * kstep; const char* b2 = last ? nB : cB + (size_t)(t + 2) * kstep;
            const char* a3 = a2 + kstep; const char* b3 = b2 + kstep;
            if (last && has_next) S.a_ready(nxt);
            if constexpr (SP2) {
            PG8_LDB(B0, 0, 0); PG8_LDB(B1, 0, 1); PG8_SCHED; PG8_LDA(At, 0, 0); PG8_STAGE(PG8_SA(1, 1), a1 + hstep, voffA);
            PG8_WAIT_V(8); PG8_WAIT_L(0); PG8_BAR; PG8_MMA(0, 0, At, B0); PG8_MMA(0, 1, At, B1); PG8_BAR; PG8_SCHED;
            PG8_LDA(At, 0, 1); PG8_STAGE(PG8_SB(0, 0), b2, voffB); PG8_STAGE(PG8_SB(0, 1), b2 + hstep, voffB); PG8_STAGE(PG8_SA(0, 0), a2, voffA);
            PG8_WAIT_V(8); PG8_WAIT_L(0); PG8_BAR; PG8_MMA(1, 0, At, B0); PG8_MMA(1, 1, At, B1); PG8_BAR; PG8_SCHED;
            PG8_LDB(B0, 1, 0); PG8_LDB(B1, 1, 1); PG8_SCHED; PG8_LDA(At, 1, 0); PG8_STAGE(PG8_SA(0, 1), a2 + hstep, voffA);
            PG8_WAIT_V(8); PG8_WAIT_L(0); PG8_BAR; PG8_MMA(0, 0, At, B0); PG8_MMA(0, 1, At, B1); PG8_BAR; PG8_SCHED;
            PG8_LDA(At, 1, 1); PG8_STAGE(PG8_SB(1, 0), b3, voffB); PG8_STAGE(PG8_SB(1, 1), b3 + hstep, voffB); PG8_STAGE(PG8_SA(1, 0), a3, voffA);
            PG8_WAIT_V(8); PG8_WAIT_L(0); PG8_BAR; PG8_MMA(1, 0, At, B0); PG8_MMA(1, 1, At, B1); PG8_BAR; PG8_SCHED;
            } else {
            PG8_LDB(B0, 0, 0); PG8_SCHED; PG8_LDA(At, 0, 0); PG8_STAGE(PG8_SA(1, 1), a1 + hstep, voffA);
            PG8_WAIT_L(8); PG8_BAR; PG8_WAIT_L(0); PG8_MMA(0, 0, At, B0); PG8_BAR; PG8_SCHED;
            PG8_LDB(B1, 0, 1); PG8_STAGE(PG8_SB(0, 0), b2, voffB);
            PG8_BAR; PG8_WAIT_L(0); PG8_MMA(0, 1, At, B1); PG8_BAR;
            PG8_LDA(At, 0, 1); PG8_STAGE(PG8_SA(0, 0), a2, voffA);
            PG8_BAR; PG8_WAIT_L(0); PG8_MMA(1, 0, At, B0); PG8_BAR; PG8_SCHED;
            PG8_STAGE(PG8_SB(0, 1), b2 + hstep, voffB);
            PG8_WAIT_V(6); PG8_BAR; PG8_MMA(1, 1, At, B1); PG8_BAR;
            PG8_LDB(B0, 1, 0); PG8_SCHED; PG8_LDA(At, 1, 0); PG8_STAGE(PG8_SA(0, 1), a2 + hstep, voffA);
            PG8_WAIT_L(8); PG8_BAR; PG8_WAIT_L(0); PG8_MMA(0, 0, At, B0); PG8_BAR; PG8_SCHED;
            PG8_LDB(B1, 1, 1); PG8_STAGE(PG8_SB(1, 0), b3, voffB);
            PG8_BAR; PG8_WAIT_L(0); PG8_MMA(0, 1, At, B1); PG8_BAR;
            PG8_LDA(At, 1, 1); PG8_STAGE(PG8_SA(1, 0), a3, voffA);
            PG8_BAR; PG8_WAIT_L(0); PG8_MMA(1, 0, At, B0); PG8_BAR; PG8_SCHED;
            PG8_STAGE(PG8_SB(1, 1), b3 + hstep, voffB);
            PG8_WAIT_V(6); PG8_BAR; PG8_MMA(1, 1, At, B1); PG8_BAR;
            }
        }
        if constexpr (ALIGN_EPI) { if (wr == 0) PG8_BAR; }
        if constexpr (!Epi::AFTER_DRAIN) { E(acc, cur, wr, wc, fr, fq); S.done(cur); }
        if (!has_next) break;
#pragma unroll
        for (int a = 0; a < 2; ++a)
#pragma unroll
            for (int b = 0; b < 2; ++b)
#pragma unroll
                for (int m = 0; m < 4; ++m)
#pragma unroll
                    for (int n = 0; n < 2; ++n) acc[a][b][m][n] = (f32x4){0.f, 0.f, 0.f, 0.f};
        cur = nxt; cA = nA; cB = nB; ++ui;
        if constexpr (ALIGN_EPI) { if (wr == 1) PG8_BAR; }
    }
    PG8_WAIT_V(0);
    if constexpr (!ALIGN_EPI) { if (wr == 0) PG8_BAR; }
    PG8_BAR;
    if constexpr (Epi::AFTER_DRAIN) { E.fused(acc, cur, wr, wc, fr, fq, lds, wid, lane); S.done(cur); }
#undef PG8_SA
#undef PG8_SB
#undef PG8_STAGE
#undef PG8_LDA
#undef PG8_LDB
#undef PG8_MMA
#undef PG8_WAIT_V
#undef PG8_WAIT_L
#undef PG8_BAR
#undef PG8_SCHED
}
}
constexpr int NWAVES = 8;
#ifndef MK_PER_PHASE
#define MK_PER_PHASE 0
#endif
constexpr int DM = 1024, NB = 2, SEQ = 8192, M = NB * SEQ, DEPTH = 4;
constexpr int CD = 512, HEADS = 4, HD = 128, MD = 512, EVEN_IN = 3592, EVEN_NP = 3840, EVEN_W = 3584, DFF = 2816, CHUNK = 128, NCH = SEQ / CHUNK, NUNIT = NB * HEADS * NCH;
constexpr float RMS_EPS = 1e-6f;
constexpr size_t MiB = 1u << 20;
constexpr size_t WS_CTL = 0, CTL_ZERO_BYTES = 1 * MiB;
constexpr size_t WS_SQ = 1 * MiB;
constexpr size_t WS_VSQ = 2 * MiB;
constexpr size_t WS_GATES = 3 * MiB;
constexpr size_t WS_NLOC = 4 * MiB;
constexpr size_t WS_NIN = 4 * MiB + 256 * 1024;
constexpr size_t WS_MLOC = 4 * MiB + 512 * 1024;
constexpr size_t WS_BL = WS_MLOC + 4096;
constexpr size_t WS_MIN = WS_BL + 4096;
constexpr size_t WS_WEI = 5 * MiB;
constexpr size_t WS_WEO = 20 * MiB;
constexpr size_t WS_WOI = 24 * MiB;
constexpr size_t WS_WOO = 32 * MiB;
constexpr size_t WS_WFI = 36 * MiB;
constexpr size_t WS_WFO = 80 * MiB;
constexpr size_t WS_XB = 102 * MiB;
constexpr size_t WS_Y = 134 * MiB;
constexpr size_t WS_BIG = 166 * MiB;
constexpr size_t WS_CLOC = 278 * MiB;
constexpr size_t WS_CIN = 310 * MiB;
constexpr size_t WS_END = 326 * MiB;
constexpr int CW_BAR = 4096;
constexpr int RING_BYTES = 131072;
constexpr int SQS_OFF = RING_BYTES;
constexpr int LDS_BYTES = 163840;
constexpr int LDSCTL_OFF = LDS_BYTES - 512, MISC_OFF = LDSCTL_OFF + 320;
constexpr int TSTR = 272;
constexpr int TILE_B = 128 * TSTR;
#define GAS __attribute__((address_space(1)))
#define LAS __attribute__((address_space(3)))
typedef unsigned short bf16;
typedef unsigned v4u __attribute__((ext_vector_type(4)));
typedef float f32x4 __attribute__((ext_vector_type(4)));
typedef short bf16x8 __attribute__((ext_vector_type(8)));
typedef GAS unsigned gu32;
typedef GAS unsigned long long gu64;
#define RLX_AGENT __ATOMIC_RELAXED, __HIP_MEMORY_SCOPE_AGENT
#define LDS_WAIT() asm volatile("s_waitcnt lgkmcnt(0)" ::: "memory")
#define VM_WAIT() asm volatile("s_waitcnt vmcnt(0)" ::: "memory")
__device__ __forceinline__ unsigned long long rt() { return __builtin_amdgcn_s_memrealtime(); }
__device__ __forceinline__ unsigned f2bf(float f) { unsigned u = __builtin_bit_cast(unsigned, f); return (u + 0x7fffu + ((u >> 16) & 1u)) >> 16; }
__device__ __forceinline__ unsigned pk2(float lo, float hi) { return f2bf(lo) | (f2bf(hi) << 16); }

#define XB_TMO      128
#define XB_XCNT(j)  (256  + 64 * (j))
#define XB_XSUB(j)  (1280 + 64 * (j))
#define XB_XGEN(j)  (2304 + 64 * (j))
#define XB_TOP      3328
#define XB_TOPGEN   3392
#define XCD_BAR_WORDS 3456
#define XB_SPIN_CAP (1u << 18)

__device__ __forceinline__ unsigned xb_ld(unsigned* p)              { return __hip_atomic_load(p, __ATOMIC_RELAXED, __HIP_MEMORY_SCOPE_AGENT); }
__device__ __forceinline__ unsigned xb_add(unsigned* p, unsigned v) { return __hip_atomic_fetch_add(p, v, __ATOMIC_RELAXED, __HIP_MEMORY_SCOPE_AGENT); }
__device__ __forceinline__ unsigned xb_xcc_id() { return (unsigned)__builtin_amdgcn_s_getreg((3 << 11) | 20) & 0xFu; }
#define XB_SPIN(cond, bar) do { unsigned _sp = 0; while (cond) { __builtin_amdgcn_s_sleep(1); \
    if ((++_sp & 255u) == 0u) { if (xb_ld(&(bar)[XB_TMO])) break; if (_sp > XB_SPIN_CAP) { atomicAdd(&(bar)[XB_TMO], 1u); break; } } } } while (0)

struct XcdBarrier {
    unsigned* bar; unsigned x;
    volatile LAS unsigned* st;
};

__device__ __forceinline__ XcdBarrier xcd_barrier_post(unsigned* bar, volatile LAS unsigned* st) {
    XcdBarrier b; b.bar = bar; b.x = xb_xcc_id(); b.st = st;
    if (threadIdx.x == 0) (void)xb_add(&bar[XB_XCNT(b.x)], 1u);
    return b;
}
__device__ __forceinline__ void xcd_barrier_complete(unsigned* bar, unsigned x, unsigned& nloc, unsigned& nx) {
    const unsigned G = gridDim.x * gridDim.y * gridDim.z;
    unsigned sum, cnt, mine, sp = 0u;
    for (;;) {
        sum = 0u; cnt = 0u; mine = 0u;
#pragma unroll
        for (unsigned j = 0; j < 16; ++j) { const unsigned c = xb_ld(&bar[XB_XCNT(j)]); sum += c; cnt += (c > 0u) ? 1u : 0u; mine = (j == x) ? c : mine; }
        if (sum == G) break;
        __builtin_amdgcn_s_sleep(1);
        if ((++sp & 255u) == 0u) { if (xb_ld(&bar[XB_TMO])) break; if (sp > XB_SPIN_CAP) { atomicAdd(&bar[XB_TMO], 1u); break; } }
    }
    nloc = mine > 0u ? mine : 1u; nx = cnt > 0u ? cnt : 1u;
}

__device__ __forceinline__ void xcd_barrier(const XcdBarrier& b) {
    asm volatile("s_waitcnt vmcnt(0)" ::: "memory");
    __syncthreads();
    if (threadIdx.x == 0) {
        unsigned* bar = b.bar;
        __builtin_amdgcn_s_waitcnt(0);
        unsigned nloc = b.st[0], nx = b.st[1];
        if (nloc == 0u) { xcd_barrier_complete(bar, b.x, nloc, nx); b.st[0] = nloc; b.st[1] = nx; }
        const unsigned old = xb_add(&bar[XB_XSUB(b.x)], 1u);
        const unsigned gen = old / nloc;
        if (old + 1u == (gen + 1u) * nloc) {
            __builtin_amdgcn_fence(__ATOMIC_RELEASE, "agent");
            asm volatile("s_waitcnt vmcnt(0)" ::: "memory");
            const unsigned og = xb_add(&bar[XB_TOP], 1u);
            const unsigned tg = og / nx;
            if (og + 1u == (tg + 1u) * nx) xb_add(&bar[XB_TOPGEN], 1u);
            else XB_SPIN(xb_ld(&bar[XB_TOPGEN]) == tg, bar);
            __builtin_amdgcn_fence(__ATOMIC_ACQUIRE, "agent");
            xb_add(&bar[XB_XGEN(b.x)], 1u);
            asm volatile("s_waitcnt vmcnt(0)" ::: "memory");
        } else {
            XB_SPIN(xb_ld(&bar[XB_XGEN(b.x)]) == gen, bar);
            __builtin_amdgcn_fence(__ATOMIC_ACQUIRE, "agent");
            asm volatile("s_waitcnt vmcnt(0)" ::: "memory");
        }
    }
    __syncthreads();
}
typedef unsigned u32x2 __attribute__((ext_vector_type(2)));
struct Frame {
    LAS unsigned char* lds;
    volatile LAS unsigned* MISC;
    gu32* ctl;
    int vcu, G;
    unsigned char* ws;
    const float* in[16];
    float* x;
};
#define OPQ_TID() int tid = threadIdx.x; asm volatile("" : "+v"(tid)); const int lane = tid & 63, w = __builtin_amdgcn_readfirstlane(tid >> 6), fr = lane & 15, fq = lane >> 4; (void)w; (void)fr; (void)fq
__device__ __forceinline__ float wave_sum(float v) {
#pragma unroll
    for (int o = 1; o < 64; o <<= 1) v += __shfl_xor(v, o);
    return v;
}
__device__ __forceinline__ float wave_max(float v) {
#pragma unroll
    for (int o = 1; o < 64; o <<= 1) v = fmaxf(v, __shfl_xor(v, o));
    return v;
}
__device__ __forceinline__ float bf2f(unsigned short h) { return __builtin_bit_cast(float, (unsigned)h << 16); }
__device__ __forceinline__ float logsig(float x) { return fminf(x, 0.f) - log1pf(expf(-fabsf(x))); }

__device__ __forceinline__ void cv_item(const float* W, int ldw, int K, int sc0, bf16* Bt, int dr0, int k0, const float* gain, float cs, LAS float* scr, int lane) {
    float v[32];
    const float* wp = W + (size_t)(k0 + (lane >> 5)) * ldw + sc0 + (lane & 31);
#pragma unroll
    for (int i = 0; i < 32; ++i) v[i] = wp[(size_t)(2 * i) * ldw];
#pragma unroll
    for (int i = 0; i < 32; ++i) scr[(2 * i + (lane >> 5)) * 33 + (lane & 31)] = v[i];
    LDS_WAIT(); asm volatile("" ::: "memory");
    const int c = lane & 7;
    f32x4 g0 = {cs, cs, cs, cs}, g1 = g0;
    if (gain) { g0 = *(const f32x4*)(gain + k0 + 8 * c) * cs; g1 = *(const f32x4*)(gain + k0 + 8 * c + 4) * cs; }
#pragma unroll
    for (int j = 0; j < 4; ++j) { const int n = (lane >> 3) + 8 * j; const LAS float* s = scr + (8 * c) * 33 + n;
        v4u o; o.x = pk2(s[0 * 33] * g0[0], s[1 * 33] * g0[1]); o.y = pk2(s[2 * 33] * g0[2], s[3 * 33] * g0[3]); o.z = pk2(s[4 * 33] * g1[0], s[5 * 33] * g1[1]); o.w = pk2(s[6 * 33] * g1[2], s[7 * 33] * g1[3]);
        *(GAS v4u*)(Bt + (size_t)(dr0 + n) * K + k0 + 8 * c) = o; }
    LDS_WAIT(); asm volatile("" ::: "memory");
}
__device__ __forceinline__ void convert_layer(Frame& F, int l, int wbase, int nw) {
    OPQ_TID();
    const int wi = wbase + w;
    LAS float* scr = (LAS float*)(F.lds + w * 16384);
    const int j = l >> 1; const bool odd = l & 1;
    const float* norm_mix = F.in[1] + (size_t)l * DM; const float* norm_ffn = F.in[2] + (size_t)l * DM;
    const int nbi = odd ? 64 : 112, I_MI = nbi * 16, I_MO = 32 * 16, I_FI = 176 * 16, I_FO = 32 * 44;
    const int N0 = I_MI, N1 = N0 + I_MO, N2 = N1 + I_FI, N3 = N2 + I_FO, NT = N3 + (odd ? 0 : 16);
    for (int it = wi; it < NT; it += nw) {
        if (it < N0) { const int kb = it / nbi, nb = it % nbi, c0 = 32 * nb;
            if (odd) cv_item(F.in[8] + (size_t)j * DM * 2048, 2048, DM, c0, (bf16*)(F.ws + WS_WOI) + (size_t)j * 2048 * DM, c0, 64 * kb, norm_mix, 1.0f, scr, lane);
            else cv_item(F.in[3] + (size_t)j * DM * EVEN_IN, EVEN_IN, DM, c0, (bf16*)(F.ws + WS_WEI) + (size_t)j * EVEN_NP * DM, c0, 64 * kb, norm_mix, (c0 >= 2048 && c0 < 2560) ? 0.08838834764831845f : 1.0f, scr, lane);
        } else if (it < N1) { const int r = it - N0, kb = r / 32, nb = r % 32;
            cv_item((odd ? F.in[12] : F.in[7]) + (size_t)j * DM * DM, DM, DM, 32 * nb, (bf16*)(F.ws + (odd ? WS_WOO : WS_WEO)) + (size_t)j * DM * DM, 32 * nb, 64 * kb, nullptr, 1.0f, scr, lane);
        } else if (it < N2) { const int r = it - N1, kb = r / 176, nb = r % 176, c0 = 32 * nb;
            const int up = c0 >= DFF, cc = up ? c0 - DFF : c0, dr = 256 * (cc >> 7) + (up ? 128 : 0) + (cc & 127);
            cv_item(F.in[13] + (size_t)l * DM * 2 * DFF, 2 * DFF, DM, c0, (bf16*)(F.ws + WS_WFI) + (size_t)l * 2 * DFF * DM, dr, 64 * kb, norm_ffn, 1.0f, scr, lane);
        } else if (it < N3) { const int r = it - N2, kb = r / 32, nb = r % 32;
            cv_item(F.in[14] + (size_t)l * DFF * DM, DM, DFF, 32 * nb, (bf16*)(F.ws + WS_WFO) + (size_t)l * DM * DFF, 32 * nb, 64 * kb, nullptr, 1.0f, scr, lane);
        } else { const int k0 = 64 * (it - N3);
            const float* W = F.in[3] + (size_t)j * DM * EVEN_IN; bf16* Bt = (bf16*)(F.ws + WS_WEI) + (size_t)j * EVEN_NP * DM;
#pragma unroll
            for (int e = 0; e < 8; ++e) { const int id = lane + 64 * e, col = id & 7, kk = k0 + (id >> 3);
                Bt[(size_t)(EVEN_W + col) * DM + kk] = (bf16)f2bf(W[(size_t)kk * EVEN_IN + EVEN_W + col] * norm_mix[kk]); }
        }
    }
}
__device__ __forceinline__ void p0_prologue(Frame& F, const float* xin) {
    OPQ_TID();
    const int gw = F.vcu * NWAVES + w, NGW = F.G * NWAVES;
    float* sq4 = (float*)(F.ws + WS_SQ); bf16* xb = (bf16*)(F.ws + WS_XB);
    for (int m = gw; m < M; m += 2 * NGW) {
        const int m1 = m + NGW;
        const GAS f32x4* xr0 = (const GAS f32x4*)(xin + (size_t)m * DM) + lane; const GAS f32x4* xr1 = (const GAS f32x4*)(xin + (size_t)m1 * DM) + lane;
        f32x4 v0[4], v1[4];
#pragma unroll
        for (int jj = 0; jj < 4; ++jj) { v0[jj] = xr0[64 * jj]; v1[jj] = xr1[64 * jj]; }
        GAS u32x2* bo0 = (GAS u32x2*)(xb + (size_t)m * DM) + lane; GAS u32x2* bo1 = (GAS u32x2*)(xb + (size_t)m1 * DM) + lane; float s0 = 0.f, s1 = 0.f;
#pragma unroll
        for (int jj = 0; jj < 4; ++jj) { u32x2 q; q.x = pk2(v0[jj].x, v0[jj].y); q.y = pk2(v0[jj].z, v0[jj].w); bo0[64 * jj] = q; s0 += (v0[jj].x * v0[jj].x + v0[jj].y * v0[jj].y) + (v0[jj].z * v0[jj].z + v0[jj].w * v0[jj].w);
            u32x2 p; p.x = pk2(v1[jj].x, v1[jj].y); p.y = pk2(v1[jj].z, v1[jj].w); bo1[64 * jj] = p; s1 += (v1[jj].x * v1[jj].x + v1[jj].y * v1[jj].y) + (v1[jj].z * v1[jj].z + v1[jj].w * v1[jj].w); }
        s0 = wave_sum(s0); s1 = wave_sum(s1);
        if (lane < 4) { sq4[(size_t)m * 4 + lane] = (lane == 0) ? s0 : 0.f; sq4[(size_t)m1 * 4 + lane] = (lane == 0) ? s1 : 0.f; }
    }
    convert_layer(F, 0, F.vcu * NWAVES, NGW);
}
__device__ __forceinline__ void final_norm(Frame& F) {
    OPQ_TID();
    const int gw = F.vcu * NWAVES + w, NGW = F.G * NWAVES;
    const float* sq4 = (const float*)(F.ws + WS_SQ); const float* gf = F.in[15]; const bf16* xb = (const bf16*)(F.ws + WS_XB);
    f32x4 g[4];
#pragma unroll
    for (int j = 0; j < 4; ++j) g[j] = ((const f32x4*)gf)[lane + 64 * j];
    for (int m = gw; m < M; m += NGW) {
        const float r = pg8::row_rstd4(sq4, m);
        GAS f32x4* xo = (GAS f32x4*)(F.x + (size_t)m * DM) + lane; const GAS u32x2* bi = (const GAS u32x2*)(xb + (size_t)m * DM) + lane;
#pragma unroll
        for (int j = 0; j < 4; ++j) { const u32x2 b = bi[64 * j]; f32x4 v = {pg8::bf_lo(b.x), pg8::bf_hi(b.x), pg8::bf_lo(b.y), pg8::bf_hi(b.y)}; v = v * r * g[j]; xo[64 * j] = v; }
    }
}
__device__ __forceinline__ void scan128_add(float& v0, float& v1, int lane) {
#pragma unroll
    for (int o = 1; o < 64; o <<= 1) { const float a = __shfl_up(v0, o), b = __shfl_up(v1, o); if (lane >= o) { v0 += a; v1 += b; } }
    v1 += __shfl(v0, 63);
}
__device__ __forceinline__ void scan128_max(float& v0, float& v1, int lane) {
#pragma unroll
    for (int o = 1; o < 64; o <<= 1) { const float a = __shfl_up(v0, o), b = __shfl_up(v1, o); if (lane >= o) { v0 = fmaxf(v0, a); v1 = fmaxf(v1, b); } }
    v1 = fmaxf(v1, __shfl(v0, 63));
}
__device__ __forceinline__ void stage_tr(LAS unsigned char* tile, const bf16* src, int ld, const LAS float* sc, int tid) {
#pragma unroll
    for (int i = 0; i < 4; ++i) { const int id = tid + 512 * i, s = id & 127, dc = id >> 7;
        const v4u v = *(const GAS v4u*)(src + (size_t)s * ld + 8 * dc); const float f = sc ? sc[s] : 1.0f;
        const unsigned w[4] = {v.x, v.y, v.z, v.w};
#pragma unroll
        for (int j = 0; j < 4; ++j) { unsigned lo = w[j] & 0xffffu, hi = w[j] >> 16;
            if (sc) { lo = f2bf(bf2f((unsigned short)lo) * f); hi = f2bf(bf2f((unsigned short)hi) * f); }
            *(LAS unsigned short*)(tile + (8 * dc + 2 * j) * TSTR + 2 * s) = (unsigned short)lo; *(LAS unsigned short*)(tile + (8 * dc + 2 * j + 1) * TSTR + 2 * s) = (unsigned short)hi; } }
}
__device__ __forceinline__ void stage_rows(LAS unsigned char* tile, const bf16* src, int ld, int tid) {
#pragma unroll
    for (int i = 0; i < 4; ++i) { const int id = tid + 512 * i, r = id >> 4, dc = id & 15;
        *(LAS v4u*)(tile + r * TSTR + 16 * dc) = *(const GAS v4u*)(src + (size_t)r * ld + 8 * dc); }
}
#define FRAG(tile, row, kk, fq) (*(const LAS bf16x8*)((tile) + (row) * TSTR + (32 * (kk) + 8 * (fq)) * 2))

__device__ __forceinline__ void mlstm_phase_a(Frame& F) {
    LAS unsigned char* TK = F.lds; LAS unsigned char* TV = F.lds + TILE_B; LAS float* aS = (LAS float*)(F.lds + 2 * TILE_B);
    const bf16* proj = (const bf16*)(F.ws + WS_BIG); const float* gates = (const float*)(F.ws + WS_GATES);
    float* Cloc = (float*)(F.ws + WS_CLOC); float* nloc = (float*)(F.ws + WS_NLOC); float* mloc = (float*)(F.ws + WS_MLOC); float* bLv = (float*)(F.ws + WS_BL);
    for (int u = F.vcu; u < NUNIT; u += F.G) {
        OPQ_TID();
        const int bh = u >> 6, c = u & 63, b = bh >> 2, h = bh & 3, row0 = b * SEQ + c * CHUNK;
        if (w == 0) {
            const float i0 = gates[(size_t)(row0 + lane) * 8 + h], i1 = gates[(size_t)(row0 + lane + 64) * 8 + h];
            float b0 = logsig(gates[(size_t)(row0 + lane) * 8 + 4 + h]), b1 = logsig(gates[(size_t)(row0 + lane + 64) * 8 + 4 + h]);
            scan128_add(b0, b1, lane);
            const float bL = __shfl(b1, 63);
            const float w0 = bL - b0 + i0, w1 = bL - b1 + i1;
            const float ml = wave_max(fmaxf(w0, w1));
            aS[lane] = __expf(w0 - ml); aS[lane + 64] = __expf(w1 - ml);
            if (lane == 0) { mloc[u] = ml; bLv[u] = bL; }
        }
        __syncthreads();
        stage_tr(TK, proj + (size_t)row0 * EVEN_W + 2048 + h * HD, EVEN_W, aS, tid);
        stage_tr(TV, proj + (size_t)row0 * EVEN_W + 2560 + h * HD, EVEN_W, nullptr, tid);
        __syncthreads();
        {
            const int d = tid >> 2, q = tid & 3; float s = 0.f;
#pragma unroll
            for (int i = 0; i < 4; ++i) { const bf16x8 v = *(const LAS bf16x8*)(TK + d * TSTR + (32 * q + 8 * i) * 2);
#pragma unroll
                for (int j = 0; j < 8; ++j) s += bf2f((unsigned short)v[j]); }
            s += __shfl_xor(s, 1); s += __shfl_xor(s, 2);
            if (q == 0) nloc[(size_t)u * HD + d] = s;
        }
        bf16x8 vf[4];
#pragma unroll
        for (int kk = 0; kk < 4; ++kk) vf[kk] = FRAG(TV, 16 * w + fr, kk, fq);
#pragma unroll
        for (int db = 0; db < 8; ++db) { f32x4 acc = {0.f, 0.f, 0.f, 0.f};
#pragma unroll
            for (int kk = 0; kk < 4; ++kk) acc = __builtin_amdgcn_mfma_f32_16x16x32_bf16(FRAG(TK, 16 * db + fr, kk, fq), vf[kk], acc, 0, 0, 0);
            *(GAS f32x4*)(Cloc + (size_t)u * (HD * HD) + (size_t)(16 * w + fr) * HD + 16 * db + 4 * fq) = acc; }
        __syncthreads();
    }
}
__device__ __forceinline__ void mlstm_scan_and_conv(Frame& F, const float* wconv) {
    const float* Cloc = (const float*)(F.ws + WS_CLOC); const float* nloc = (const float*)(F.ws + WS_NLOC); const float* mloc = (const float*)(F.ws + WS_MLOC); const float* bLv = (const float*)(F.ws + WS_BL);
    bf16* Cin = (bf16*)(F.ws + WS_CIN); float* nin = (float*)(F.ws + WS_NIN); float* minv = (float*)(F.ws + WS_MIN);
    OPQ_TID();
    const int NT = F.G * 512;
    for (int g = F.vcu * 512 + tid; g < NB * HEADS * (HD * HD + HD); g += NT) {
        const bool isn = g >= NB * HEADS * HD * HD; const int q = isn ? g - NB * HEADS * HD * HD : g;
        const int bh = isn ? (q >> 7) : (q >> 14), idx = isn ? (q & 127) : (q & 16383);
        float C = 0.f, m = 0.f;
        for (int c0 = 0; c0 < NCH; c0 += 8) {
            float cl[8], ml[8], bl[8];
#pragma unroll
            for (int i = 0; i < 8; ++i) { const int u = bh * NCH + c0 + i; cl[i] = isn ? nloc[(size_t)u * HD + idx] : Cloc[(size_t)u * (HD * HD) + idx]; ml[i] = mloc[u]; bl[i] = bLv[u]; }
#pragma unroll
            for (int i = 0; i < 8; ++i) { const int u = bh * NCH + c0 + i;
                if (isn) { nin[(size_t)u * HD + idx] = C; if (idx == 0) minv[u] = m; } else Cin[(size_t)u * (HD * HD) + idx] = (bf16)f2bf(C);
                const float mn = fmaxf(bl[i] + m, ml[i]);
                C = __expf(bl[i] + m - mn) * C + __expf(ml[i] - mn) * cl[i]; m = mn; }
        }
    }
    const bf16* proj = (const bf16*)(F.ws + WS_BIG); bf16* Y = (bf16*)(F.ws + WS_Y);
    for (int g = F.vcu * 512 + tid; g < M * (CD / 8); g += NT) {
        const int t = g >> 6, c8 = (g & 63) * 8, ts = t & (SEQ - 1);
        float acc[8];
#pragma unroll
        for (int j = 0; j < 8; ++j) acc[j] = 0.f;
#pragma unroll
        for (int jj = 0; jj < 3; ++jj) { if (ts - 2 + jj >= 0) { const bf16* p = proj + (size_t)(t - 2 + jj) * EVEN_W;
                const v4u cg = *(const GAS v4u*)(p + CD + c8), xa = *(const GAS v4u*)(p + 2 * CD + c8);
                const unsigned cw[4] = {cg.x, cg.y, cg.z, cg.w}, xw[4] = {xa.x, xa.y, xa.z, xa.w};
#pragma unroll
                for (int j = 0; j < 4; ++j) { acc[2 * j] += wconv[jj * CD + c8 + 2 * j] * (bf2f((unsigned short)(cw[j] & 0xffffu)) * bf2f((unsigned short)(xw[j] & 0xffffu)));
                    acc[2 * j + 1] += wconv[jj * CD + c8 + 2 * j + 1] * (bf2f((unsigned short)(cw[j] >> 16)) * bf2f((unsigned short)(xw[j] >> 16))); } } }
        const v4u bg = *(const GAS v4u*)(proj + (size_t)t * EVEN_W + c8); const unsigned bw[4] = {bg.x, bg.y, bg.z, bg.w}; v4u o; unsigned ow[4];
#pragma unroll
        for (int j = 0; j < 4; ++j) ow[j] = pk2(bf2f((unsigned short)(bw[j] & 0xffffu)) * acc[2 * j], bf2f((unsigned short)(bw[j] >> 16)) * acc[2 * j + 1]);
        o.x = ow[0]; o.y = ow[1]; o.z = ow[2]; o.w = ow[3];
        *(GAS v4u*)(Y + (size_t)t * DM + c8) = o;
    }
}
__device__ __forceinline__ void mlstm_phase_c(Frame& F, const float* ghead) {
    LAS unsigned char* TK = F.lds; LAS unsigned char* TV = F.lds + TILE_B; LAS unsigned char* TC = F.lds + 2 * TILE_B; LAS unsigned char* TS = F.lds + 3 * TILE_B;
    LAS float* gS = (LAS float*)(F.lds + 4 * TILE_B); LAS float* mxS = gS + 128; LAS float* bS = gS + 256; LAS float* nS = gS + 384;
    const bf16* proj = (const bf16*)(F.ws + WS_BIG); const float* gates = (const float*)(F.ws + WS_GATES);
    const bf16* Cin = (const bf16*)(F.ws + WS_CIN); const float* nin = (const float*)(F.ws + WS_NIN); const float* minv = (const float*)(F.ws + WS_MIN);
    bf16* Y = (bf16*)(F.ws + WS_Y);
    for (int u = F.vcu; u < NUNIT; u += F.G) {
        OPQ_TID();
        const int bh = u >> 6, c = u & 63, b = bh >> 2, h = bh & 3, row0 = b * SEQ + c * CHUNK;
        const float m_in = minv[u];
        if (w == 0) {
            const float i0 = gates[(size_t)(row0 + lane) * 8 + h], i1 = gates[(size_t)(row0 + lane + 64) * 8 + h];
            float b0 = logsig(gates[(size_t)(row0 + lane) * 8 + 4 + h]), b1 = logsig(gates[(size_t)(row0 + lane + 64) * 8 + 4 + h]);
            scan128_add(b0, b1, lane);
            const float g0 = i0 - b0, g1 = i1 - b1; float p0 = g0, p1 = g1;
            scan128_max(p0, p1, lane);
            gS[lane] = g0; gS[lane + 64] = g1; mxS[lane] = fmaxf(m_in, p0); mxS[lane + 64] = fmaxf(m_in, p1); bS[lane] = b0; bS[lane + 64] = b1;
        } else if (w == 1) { nS[lane] = nin[(size_t)u * HD + lane]; nS[lane + 64] = nin[(size_t)u * HD + lane + 64]; }
        const int t = 16 * w + fr;
        bf16x8 qf[4];
#pragma unroll
        for (int kk = 0; kk < 4; ++kk) qf[kk] = *(const GAS bf16x8*)(proj + (size_t)(row0 + t) * EVEN_W + 1536 + h * HD + 32 * kk + 8 * fq);
        stage_rows(TK, proj + (size_t)row0 * EVEN_W + 2048 + h * HD, EVEN_W, tid);
        stage_rows(TC, Cin + (size_t)u * (HD * HD), HD, tid);
        stage_tr(TV, proj + (size_t)row0 * EVEN_W + 2560 + h * HD, EVEN_W, nullptr, tid);
        __syncthreads();
        const float mx_t = mxS[t], b_t = bS[t], inter = __expf(m_in - mx_t);
        float den1 = 0.f;
#pragma unroll
        for (int sb = 0; sb < 8; ++sb) {
            u32x2 pk = {0u, 0u};
            if (sb <= w) { f32x4 acc = {0.f, 0.f, 0.f, 0.f};
#pragma unroll
                for (int kk = 0; kk < 4; ++kk) acc = __builtin_amdgcn_mfma_f32_16x16x32_bf16(FRAG(TK, 16 * sb + fr, kk, fq), qf[kk], acc, 0, 0, 0);
                float sv[4];
#pragma unroll
                for (int r = 0; r < 4; ++r) { const int s = 16 * sb + 4 * fq + r; const float e = __expf(gS[s] - mx_t); sv[r] = (s <= t) ? acc[r] * e : 0.f; den1 += sv[r]; }
                pk.x = pk2(sv[0], sv[1]); pk.y = pk2(sv[2], sv[3]); }
            *(LAS u32x2*)(TS + t * TSTR + (16 * sb + 4 * fq) * 2) = pk;
        }
        den1 += __shfl_xor(den1, 16); den1 += __shfl_xor(den1, 32);
        float qn = 0.f;
#pragma unroll
        for (int kk = 0; kk < 4; ++kk)
#pragma unroll
            for (int j = 0; j < 8; ++j) qn += bf2f((unsigned short)qf[kk][j]) * nS[32 * kk + 8 * fq + j];
        qn += __shfl_xor(qn, 16); qn += __shfl_xor(qn, 32);
        const float den = den1 + inter * qn, m_t = b_t + mx_t;
        const float rden = 1.0f / fmaxf(fabsf(den), __expf(-m_t));
        bf16x8 sf[4];
#pragma unroll
        for (int kk = 0; kk < 4; ++kk) sf[kk] = FRAG(TS, t, kk, fq);
        float hh[32]; float ssq = 0.f;
#pragma unroll
        for (int eb = 0; eb < 8; ++eb) { f32x4 a1 = {0.f, 0.f, 0.f, 0.f}, a2 = {0.f, 0.f, 0.f, 0.f};
#pragma unroll
            for (int kk = 0; kk < 4; ++kk) { if (2 * kk <= w) a1 = __builtin_amdgcn_mfma_f32_16x16x32_bf16(FRAG(TV, 16 * eb + fr, kk, fq), sf[kk], a1, 0, 0, 0);
                a2 = __builtin_amdgcn_mfma_f32_16x16x32_bf16(FRAG(TC, 16 * eb + fr, kk, fq), qf[kk], a2, 0, 0, 0); }
#pragma unroll
            for (int r = 0; r < 4; ++r) { const float v = (a1[r] + inter * a2[r]) * rden; hh[4 * eb + r] = v; ssq += v * v; } }
        ssq += __shfl_xor(ssq, 16); ssq += __shfl_xor(ssq, 32);
        const float rs = __builtin_amdgcn_rsqf(ssq * (1.0f / 128.0f) + RMS_EPS);
#pragma unroll
        for (int eb = 0; eb < 8; ++eb) { const int e = 16 * eb + 4 * fq;
            const u32x2 ov = *(const GAS u32x2*)(proj + (size_t)(row0 + t) * EVEN_W + 3072 + h * HD + e); const f32x4 gh = *(const f32x4*)(ghead + h * HD + e);
            const float o0 = bf2f((unsigned short)(ov.x & 0xffffu)), o1 = bf2f((unsigned short)(ov.x >> 16)), o2 = bf2f((unsigned short)(ov.y & 0xffffu)), o3 = bf2f((unsigned short)(ov.y >> 16));
            u32x2 y; y.x = pk2(pg8::fast_sigmoid(o0) * hh[4 * eb] * rs * gh[0], pg8::fast_sigmoid(o1) * hh[4 * eb + 1] * rs * gh[1]);
            y.y = pk2(pg8::fast_sigmoid(o2) * hh[4 * eb + 2] * rs * gh[2], pg8::fast_sigmoid(o3) * hh[4 * eb + 3] * rs * gh[3]);
            *(GAS u32x2*)(Y + (size_t)(row0 + t) * DM + MD + h * HD + e) = y; }
        __syncthreads();
    }
}
__device__ __forceinline__ void sgu_phase(Frame& F, const float* gv, const float* wsp, const float* bsp) {
    LAS unsigned char* TW = F.lds; LAS unsigned char* TV = F.lds + TILE_B; LAS float* rS = (LAS float*)(F.lds + 2 * TILE_B);
    const bf16* Z = (const bf16*)(F.ws + WS_BIG); const float* vsq16 = (const float*)(F.ws + WS_VSQ); bf16* Y = (bf16*)(F.ws + WS_Y);
    for (int u = F.vcu; u < (M / CHUNK) * 8; u += F.G) {
        OPQ_TID();
        const int cb = u >> 3, g = u & 7, row0 = cb * CHUNK;
        if (tid < 128) rS[tid] = pg8::row_rstd16(vsq16, row0 + tid);
        __syncthreads();
#pragma unroll
        for (int i = 0; i < 8; ++i) { const int id = tid + 512 * i, t = id >> 5, s4 = (id & 31) * 4;
            const f32x4 wv = *(const f32x4*)(wsp + ((size_t)g * CHUNK + t) * CHUNK + s4); float v[4];
#pragma unroll
            for (int j = 0; j < 4; ++j) v[j] = (s4 + j <= t) ? wv[j] * rS[s4 + j] : 0.f;
            u32x2 pk; pk.x = pk2(v[0], v[1]); pk.y = pk2(v[2], v[3]);
            *(LAS u32x2*)(TW + t * TSTR + s4 * 2) = pk; }
        stage_tr(TV, Z + (size_t)row0 * 2048 + 1024 + g * 128, 2048, nullptr, tid);
        __syncthreads();
        const int t = 16 * w + fr;
        bf16x8 wf[4];
#pragma unroll
        for (int kk = 0; kk < 4; ++kk) wf[kk] = FRAG(TW, t, kk, fq);
        const float bst = bsp[g * CHUNK + t];
#pragma unroll
        for (int db = 0; db < 8; ++db) { f32x4 acc = {0.f, 0.f, 0.f, 0.f};
#pragma unroll
            for (int kk = 0; kk < 4; ++kk) if (2 * kk <= w) acc = __builtin_amdgcn_mfma_f32_16x16x32_bf16(FRAG(TV, 16 * db + fr, kk, fq), wf[kk], acc, 0, 0, 0);
            const int col = g * 128 + 16 * db + 4 * fq;
            const f32x4 gvv = *(const f32x4*)(gv + col); const u32x2 uv = *(const GAS u32x2*)(Z + (size_t)(row0 + t) * 2048 + col);
            const float u0 = bf2f((unsigned short)(uv.x & 0xffffu)), u1 = bf2f((unsigned short)(uv.x >> 16)), u2 = bf2f((unsigned short)(uv.y & 0xffffu)), u3 = bf2f((unsigned short)(uv.y >> 16));
            u32x2 y; y.x = pk2(u0 * (acc[0] * gvv[0] + bst), u1 * (acc[1] * gvv[1] + bst)); y.y = pk2(u2 * (acc[2] * gvv[2] + bst), u3 * (acc[3] * gvv[3] + bst));
            *(GAS u32x2*)(Y + (size_t)(row0 + t) * DM + col) = y; }
        __syncthreads();
    }
}
#ifndef PROBE_MASK
#define PROBE_MASK 0
#endif
struct Args { const float* in[16]; float* out; unsigned char* ws; int ph_lo, ph_hi; };
constexpr int N_PHASES = 26;
enum Kind { K_P0, K_E1, K_E2, K_E3, K_E4, K_RESMIX, K_F1, K_RESFFN, K_O1, K_O2, K_FINAL };
__device__ __forceinline__ void decode_phase(int p, int& kind, int& layer) {
    if (p == 0) { kind = K_P0; layer = 0; return; }
    if (p == 25) { kind = K_FINAL; layer = 0; return; }
    int q = p - 1; const int pair = q / 12; q -= pair * 12;
    if (q < 7) { layer = 2 * pair; kind = q == 0 ? K_E1 : q == 1 ? K_E2 : q == 2 ? K_E3 : q == 3 ? K_E4 : q == 4 ? K_RESMIX : q == 5 ? K_F1 : K_RESFFN; }
    else { layer = 2 * pair + 1; q -= 7; kind = q == 0 ? K_O1 : q == 1 ? K_O2 : q == 2 ? K_RESMIX : q == 3 ? K_F1 : K_RESFFN; }
}
__global__ void __launch_bounds__(NWAVES * 64, 2) trunk_fwd(Args args) {
    extern __shared__ __attribute__((aligned(16))) unsigned char lds[];
    Frame F;
    F.lds = (LAS unsigned char*)lds;
    F.MISC = (volatile LAS unsigned*)(F.lds + MISC_OFF);
    F.G = gridDim.x; { const int bx = blockIdx.x; F.vcu = (F.G % 8 == 0) ? (bx % 8) * (F.G / 8) + bx / 8 : bx; }
    F.ws = args.ws; F.ctl = (gu32*)(args.ws + WS_CTL); F.x = args.out;
#pragma unroll
    for (int i = 0; i < 16; ++i) F.in[i] = args.in[i];
    for (int u = threadIdx.x; u < (LDS_BYTES - LDSCTL_OFF) / 4; u += NWAVES * 64) ((LAS unsigned*)(F.lds + LDSCTL_OFF))[u] = 0u;
    __syncthreads();
    XcdBarrier bar; bar.bar = (unsigned*)(F.ctl + CW_BAR); bar.x = 0; bar.st = nullptr;
    if (!MK_PER_PHASE) bar = xcd_barrier_post((unsigned*)(F.ctl + CW_BAR), F.MISC + 8);
    bf16* xb = (bf16*)(F.ws + WS_XB); bf16* Yb = (bf16*)(F.ws + WS_Y); bf16* big = (bf16*)(F.ws + WS_BIG);
    float* sq16 = (float*)(F.ws + WS_SQ);
    for (int p = args.ph_lo; p < args.ph_hi; ++p) {
        int kind, layer; decode_phase(p, kind, layer);
        const int j = layer >> 1;
        const int reps = ((PROBE_MASK >> kind) & 1) ? 2 : 1;
        for (int rep = 0; rep < reps; ++rep) {
        if (kind == K_P0) { p0_prologue(F, F.in[0]); }
        else if (kind == K_E1) {
            pg8::Gemm g{xb, (const bf16*)(F.ws + WS_WEI) + (size_t)j * EVEN_NP * DM, M, EVEN_NP, DM}; pg8::StaticOrder S; S.init(M, EVEN_NP, F.G, (int)blockIdx.x);
            pg8::EpiEvenIn E{big, sq16, (float*)(F.ws + WS_GATES), F.in[5] + (size_t)j * 8};
            pg8::gemm_phase<pg8::EpiEvenIn, pg8::StaticOrder, true, true>(F.lds, g, S, E);
        }
        else if (kind == K_E2) { mlstm_phase_a(F); }
        else if (kind == K_E3) { mlstm_scan_and_conv(F, F.in[4] + (size_t)j * 3 * CD); }
        else if (kind == K_E4) { mlstm_phase_c(F, F.in[6] + (size_t)j * MD); }
        else if (kind == K_RESMIX || kind == K_RESFFN) {
            const bool ffn = kind == K_RESFFN, odd = layer & 1;
            const bf16* A = ffn ? big : Yb;
            const bf16* Bt = ffn ? (const bf16*)(F.ws + WS_WFO) + (size_t)layer * DM * DFF : odd ? (const bf16*)(F.ws + WS_WOO) + (size_t)j * DM * DM : (const bf16*)(F.ws + WS_WEO) + (size_t)j * DM * DM;
            pg8::Gemm g{A, Bt, M, DM, ffn ? DFF : DM}; pg8::StaticOrder S; S.init(M, DM, F.G, (int)blockIdx.x);
            pg8::EpiResid E{xb, (LAS float*)(F.lds + SQS_OFF)};
            pg8::gemm_phase<pg8::EpiResid, pg8::StaticOrder, false, true>(F.lds, g, S, E);
            __syncthreads();
            { OPQ_TID(); (void)lane; pg8::Unit u0; if (S.next(0, u0) && tid < 256) { const f32x4 q = *(const LAS f32x4*)(F.lds + SQS_OFF + tid * 16);
                sq16[(size_t)(u0.pm * 256 + tid) * 4 + u0.pn] = (q[0] + q[1]) + (q[2] + q[3]); } }
        }
        else if (kind == K_F1) {
            pg8::Gemm g{xb, (const bf16*)(F.ws + WS_WFI) + (size_t)layer * 2 * DFF * DM, M, 2 * DFF, DM}; pg8::StaticOrder S; S.init(M, 2 * DFF, F.G, (int)blockIdx.x);
            pg8::EpiSwiGLU E{big, sq16};
            pg8::gemm_phase<pg8::EpiSwiGLU, pg8::StaticOrder, true, true>(F.lds, g, S, E);
            if (layer + 1 < DEPTH && rep == 0 && blockIdx.x >= 128) { __syncthreads(); convert_layer(F, layer + 1, ((int)blockIdx.x - 128) * NWAVES, (F.G - 128) * NWAVES); }
        }
        else if (kind == K_O1) {
            pg8::Gemm g{xb, (const bf16*)(F.ws + WS_WOI) + (size_t)j * 2048 * DM, M, 2048, DM}; pg8::StaticOrder S; S.init(M, 2048, F.G, (int)blockIdx.x);
            pg8::EpiGeluZ E{big, sq16, (float*)(F.ws + WS_VSQ)};
            pg8::gemm_phase<pg8::EpiGeluZ, pg8::StaticOrder, true, true>(F.lds, g, S, E);
        }
        else if (kind == K_O2) { sgu_phase(F, F.in[9] + (size_t)j * DM, F.in[10] + (size_t)j * 8 * CHUNK * CHUNK, F.in[11] + (size_t)j * 8 * CHUNK); }
        else { final_norm(F); }
        if (rep + 1 < reps) xcd_barrier(bar);
        }
        if (p + 1 < args.ph_hi) xcd_barrier(bar);
    }
}

extern "C" void kernel_launch(void* const* d_in, const int* in_sizes, int n_in, void* d_out, int out_size, void* d_ws, size_t ws_size, hipStream_t stream) {
    static int grid = 0;
    if (grid == 0) {
        if (n_in != 16 || in_sizes[0] != M * DM || out_size != M * DM || ws_size < WS_END) { fprintf(stderr, "kernel_launch: unexpected shapes / workspace (n_in %d, ws %zu < %zu); nothing launched\n", n_in, ws_size, (size_t)WS_END); grid = -1; return; }
        int dev = 0, cus = 0, per_cu = 0;
        if (hipGetDevice(&dev) != hipSuccess || hipDeviceGetAttribute(&cus, hipDeviceAttributeMultiprocessorCount, dev) != hipSuccess) { grid = -1; return; }
        if (hipFuncSetAttribute((const void*)trunk_fwd, hipFuncAttributeMaxDynamicSharedMemorySize, LDS_BYTES) != hipSuccess) { fprintf(stderr, "kernel_launch: hipFuncSetAttribute failed\n"); grid = -1; return; }
        if (hipOccupancyMaxActiveBlocksPerMultiprocessor(&per_cu, (const void*)trunk_fwd, NWAVES * 64, LDS_BYTES) != hipSuccess || per_cu < 1) fprintf(stderr, "kernel_launch: note: occupancy query says %d\n", per_cu);
        (void)hipGetLastError();
        grid = cus;
    }
    if (grid < 0) return;
    if (hipMemsetAsync((char*)d_ws + WS_CTL, 0, CTL_ZERO_BYTES, stream) != hipSuccess) return;
    Args a{};
    for (int i = 0; i < 16; ++i) a.in[i] = (const float*)d_in[i];
    a.out = (float*)d_out; a.ws = (unsigned char*)d_ws;
#if MK_PER_PHASE
    for (int p = 0; p < N_PHASES; ++p) { a.ph_lo = p; a.ph_hi = p + 1; hipLaunchKernelGGL(trunk_fwd, dim3(grid), dim3(NWAVES * 64), LDS_BYTES, stream, a); }
#else
    a.ph_lo = 0; a.ph_hi = N_PHASES; hipLaunchKernelGGL(trunk_fwd, dim3(grid), dim3(NWAVES * 64), LDS_BYTES, stream, a);
#endif
}
```

```cpp
#include <hip/hip_runtime.h>
#include <cstdio>
#include <cstdint>
#define MK_PER_PHASE 0
namespace pg8 {
#define PG8_LAS __attribute__((address_space(3)))
typedef unsigned short bf16_t;
typedef short bf16x8 __attribute__((ext_vector_type(8)));
typedef float f32x4 __attribute__((ext_vector_type(4)));
typedef unsigned u32x4 __attribute__((ext_vector_type(4)));
constexpr int BM = 256, BK = 64, HALF = 128, HTB = HALF * BK * 2  , STAGE_BYTES = 8 * HTB, NXCD = 8, WGM = 8;

__host__ __device__ __forceinline__ int lds_byte(int r, int c) { const int st = (r >> 4) * 2 + (c >> 5), rr = r & 15, cc = c & 31, ob = rr * 64 + cc * 2; return st * 1024 + (ob ^ (((ob >> 9) & 1) << 5)); }
__host__ __device__ __forceinline__ void stage_rc(int b, int& R, int& C) { const int st = b / 1024, sb = b % 1024, swz = sb ^ (((sb >> 9) & 1) << 5); R = (st >> 1) * 16 + swz / 64; C = (st & 1) * 32 + (swz % 64) / 2; }
__host__ __device__ __forceinline__ int perm32(int rho) { const int n = rho >> 4, i = rho & 15; return 8 * (i >> 2) + 4 * n + (i & 3); }

struct Unit { int pm, pn; };
struct Gemm { const bf16_t* A; const bf16_t* Bt; int M, N, K; };

struct StaticOrder {
    int nM, nN, nwg, G, c;
    __host__ __device__ void init(int M, int N, int G_, int c_) { nM = M / BM; nN = N / BM; nwg = nM * nN; G = G_; c = c_; }
    __host__ __device__ bool next(int i, Unit& u) const {
        const long L = (long)i * G + c; if (L >= nwg) return false;
        int wgid = (int)L; { const int q = nwg / NXCD, r = nwg % NXCD, xcd = wgid % NXCD, off = wgid / NXCD; wgid = (xcd < r ? xcd * (q + 1) : r * (q + 1) + (xcd - r) * q) + off; }
        const int nig = WGM * nN, gid = wgid / nig, fm = gid * WGM, gsz = (nM - fm) < WGM ? (nM - fm) : WGM;
        u.pm = fm + ((wgid % nig) % gsz); u.pn = (wgid % nig) / gsz; return true;
    }
    __device__ __forceinline__ void a_ready(const Unit&) const {}
    __device__ __forceinline__ void done(const Unit&) const {}
};

__device__ __forceinline__ unsigned cvt_pk_bf16(float lo, float hi) { unsigned r; asm volatile("v_cvt_pk_bf16_f32 %0, %1, %2" : "=v"(r) : "v"(lo), "v"(hi)); return r; }
typedef float f32x2 __attribute__((ext_vector_type(2)));
constexpr float RMS_EPS_F = 1e-6f;
typedef unsigned u32x2 __attribute__((ext_vector_type(2)));
__device__ __forceinline__ float row_rstd4(const float* sq4, int row) {
    const f32x4 a = *(const f32x4*)(sq4 + (size_t)row * 4);
    return __builtin_amdgcn_rsqf(((a[0] + a[1]) + (a[2] + a[3])) * (1.0f / 1024.0f) + RMS_EPS_F);
}
__device__ __forceinline__ float row_rstd16(const float* sq16, int row) {
    const f32x4* p = (const f32x4*)(sq16 + (size_t)row * 16);
    const f32x4 a = p[0], b = p[1], c = p[2], d = p[3];
    const float s = ((a[0] + a[1]) + (a[2] + a[3])) + ((b[0] + b[1]) + (b[2] + b[3])) + ((c[0] + c[1]) + (c[2] + c[3])) + ((d[0] + d[1]) + (d[2] + d[3]));
    return __builtin_amdgcn_rsqf(s * (1.0f / 1024.0f) + RMS_EPS_F);
}
__device__ __forceinline__ float bf_lo(unsigned w) { return __builtin_bit_cast(float, w << 16); }
__device__ __forceinline__ float bf_hi(unsigned w) { return __builtin_bit_cast(float, w & 0xffff0000u); }
#ifndef PG8_WT
#define PG8_WT 1
#endif
__device__ __forceinline__ void st16(bf16_t* base, size_t elem_off, u32x4 v) {
#if PG8_WT
    __builtin_amdgcn_raw_buffer_store_b128(v, __builtin_amdgcn_make_buffer_rsrc((void*)base, (short)0, 0x7fffffff, 0x00020000), (unsigned)(elem_off * 2), 0, 16);
#else
    *(u32x4*)(base + elem_off) = v;
#endif
}
__device__ __forceinline__ float fast_sigmoid(float x) { return __builtin_amdgcn_rcpf(1.0f + __expf(-x)); }
struct EpiEvenIn {
    static constexpr bool PERM = true, AFTER_DRAIN = false;
    bf16_t* O; const float* sq16; float* gates; const float* bgate;
    __device__ __forceinline__ void operator()(const f32x4 (&acc)[2][2][4][2], const Unit& u, int wr, int wc, int fr, int fq) const {
        const int row0 = u.pm * BM + wr * 64 + fr;
        if (u.pn < 14) {
            const int col0 = u.pn * BM + wc * 32 + 8 * fq;
#pragma unroll
            for (int ai = 0; ai < 2; ++ai)
#pragma unroll
                for (int m = 0; m < 4; ++m) { const int row = row0 + ai * HALF + m * 16; const float r = row_rstd4(sq16, row); const size_t ro = (size_t)row * 3584 + col0;
#pragma unroll
                    for (int bj = 0; bj < 2; ++bj) { const f32x4 v0 = acc[ai][bj][m][0] * r, v1 = acc[ai][bj][m][1] * r;
                        u32x4 w; w.x = cvt_pk_bf16(v0[0], v0[1]); w.y = cvt_pk_bf16(v0[2], v0[3]); w.z = cvt_pk_bf16(v1[0], v1[1]); w.w = cvt_pk_bf16(v1[2], v1[3]);
                        st16(O, ro + bj * HALF, w); } }
        } else if (wc == 0 && fq == 0) {
            const f32x4 b0 = *(const f32x4*)(bgate), b1 = *(const f32x4*)(bgate + 4);
#pragma unroll
            for (int ai = 0; ai < 2; ++ai)
#pragma unroll
                for (int m = 0; m < 4; ++m) { const int row = row0 + ai * HALF + m * 16; const float r = row_rstd4(sq16, row);
                    *(f32x4*)(gates + (size_t)row * 8) = acc[ai][0][m][0] * r + b0; *(f32x4*)(gates + (size_t)row * 8 + 4) = acc[ai][0][m][1] * r + b1; }
        }
    }
};
struct EpiResid {
    static constexpr bool PERM = true, AFTER_DRAIN = false;
    bf16_t* xb; PG8_LAS float* sqs;
    __device__ __forceinline__ void operator()(const f32x4 (&acc)[2][2][4][2], const Unit& u, int wr, int wc, int fr, int fq) const {
        const int rl0 = wr * 64 + fr, col0 = u.pn * BM + wc * 32 + 8 * fq;
        const bf16_t* base = xb + (size_t)(u.pm * BM + rl0) * 1024 + col0;
        u32x4 o[2][4][2];
#pragma unroll
        for (int ai = 0; ai < 2; ++ai)
#pragma unroll
            for (int m = 0; m < 4; ++m)
#pragma unroll
                for (int bj = 0; bj < 2; ++bj) o[ai][m][bj] = *(const u32x4*)(base + (size_t)(ai * HALF + m * 16) * 1024 + bj * HALF);
#pragma unroll
        for (int ai = 0; ai < 2; ++ai)
#pragma unroll
            for (int m = 0; m < 4; ++m) { const int rl = rl0 + ai * HALF + m * 16; float ss = 0.f;
#pragma unroll
                for (int bj = 0; bj < 2; ++bj) { const u32x4 ov = o[ai][m][bj];
                    const f32x4 v0 = acc[ai][bj][m][0] + (f32x4){bf_lo(ov.x), bf_hi(ov.x), bf_lo(ov.y), bf_hi(ov.y)}, v1 = acc[ai][bj][m][1] + (f32x4){bf_lo(ov.z), bf_hi(ov.z), bf_lo(ov.w), bf_hi(ov.w)};
                    u32x4 w; w.x = cvt_pk_bf16(v0[0], v0[1]); w.y = cvt_pk_bf16(v0[2], v0[3]); w.z = cvt_pk_bf16(v1[0], v1[1]); w.w = cvt_pk_bf16(v1[2], v1[3]);
                    st16(xb, (size_t)(u.pm * BM + rl) * 1024 + col0 + bj * HALF, w);
                    ss += ((v0[0] * v0[0] + v0[1] * v0[1]) + (v0[2] * v0[2] + v0[3] * v0[3])) + ((v1[0] * v1[0] + v1[1] * v1[1]) + (v1[2] * v1[2] + v1[3] * v1[3])); }
                ss += __shfl_xor(ss, 16); ss += __shfl_xor(ss, 32);
                if (fq == 0) sqs[rl * 4 + wc] = ss; }
    }
};
struct EpiSwiGLU {
    static constexpr bool PERM = true, AFTER_DRAIN = false;
    bf16_t* O; const float* sq16;
    __device__ __forceinline__ void operator()(const f32x4 (&acc)[2][2][4][2], const Unit& u, int wr, int wc, int fr, int fq) const {
        const int row0 = u.pm * BM + wr * 64 + fr, col0 = u.pn * HALF + wc * 32 + 8 * fq;
#pragma unroll
        for (int ai = 0; ai < 2; ++ai)
#pragma unroll
            for (int m = 0; m < 4; ++m) { const int row = row0 + ai * HALF + m * 16; const float r = row_rstd4(sq16, row);
                float h[8];
#pragma unroll
                for (int n = 0; n < 2; ++n)
#pragma unroll
                    for (int j = 0; j < 4; ++j) { const float g = acc[ai][0][m][n][j] * r, up = acc[ai][1][m][n][j] * r; h[4 * n + j] = g * fast_sigmoid(g) * up; }
                u32x4 w; w.x = cvt_pk_bf16(h[0], h[1]); w.y = cvt_pk_bf16(h[2], h[3]); w.z = cvt_pk_bf16(h[4], h[5]); w.w = cvt_pk_bf16(h[6], h[7]);
                st16(O, (size_t)row * 2816 + col0, w); }
    }
};
struct EpiGeluZ {
    static constexpr bool PERM = true, AFTER_DRAIN = false;
    bf16_t* O; const float* sq16; float* vsq16;
    __device__ __forceinline__ void operator()(const f32x4 (&acc)[2][2][4][2], const Unit& u, int wr, int wc, int fr, int fq) const {
        const int row0 = u.pm * BM + wr * 64 + fr, col0 = u.pn * BM + wc * 32 + 8 * fq;
#pragma unroll
        for (int ai = 0; ai < 2; ++ai)
#pragma unroll
            for (int m = 0; m < 4; ++m) { const int row = row0 + ai * HALF + m * 16; const float r = row_rstd4(sq16, row); float ss = 0.f;
#pragma unroll
                for (int bj = 0; bj < 2; ++bj) { float z[8];
#pragma unroll
                    for (int n = 0; n < 2; ++n)
#pragma unroll
                        for (int j = 0; j < 4; ++j) { const float v = acc[ai][bj][m][n][j] * r; const float t = 1.5957691216057308f * (v + 0.044715f * v * v * v); const float zz = v * fast_sigmoid(t); z[4 * n + j] = zz; ss += zz * zz; }
                    u32x4 w; w.x = cvt_pk_bf16(z[0], z[1]); w.y = cvt_pk_bf16(z[2], z[3]); w.z = cvt_pk_bf16(z[4], z[5]); w.w = cvt_pk_bf16(z[6], z[7]);
                    st16(O, (size_t)row * 2048 + col0 + bj * HALF, w); }
                if (u.pn >= 4) { ss += __shfl_xor(ss, 16); ss += __shfl_xor(ss, 32); if (fq == 0) vsq16[(size_t)row * 16 + (u.pn - 4) * 4 + wc] = ss; } }
    }
};
template <class Epi, class Sched, bool ALIGN_EPI = false, bool SP2 = false>
__device__ __forceinline__ void gemm_phase(PG8_LAS unsigned char* lds, const Gemm g, const Sched& S, const Epi& E) {
    int tid_ = threadIdx.x; asm volatile("" : "+v"(tid_)); const int tid = tid_, wid = __builtin_amdgcn_readfirstlane(tid >> 6), lane = tid & 63, wr = wid >> 2, wc = wid & 3, fr = lane & 15, fq = lane >> 4;
    const int K = g.K, nt = K / BK;
    unsigned voffA[2], voffB[2];
#pragma unroll
    for (int i = 0; i < 2; ++i) { int R, C; stage_rc(tid * 16 + i * 8192, R, C); const int Rb = Epi::PERM ? ((R & ~31) + perm32(R & 31)) : R;
        voffA[i] = (unsigned)(R * K + C) * 2u; voffB[i] = (unsigned)(Rb * K + C) * 2u; }
    const size_t kstep = (size_t)(BK * 2);
    const size_t hstep = (size_t)HALF * K * 2;
    const size_t tstep = 2 * hstep;
    const unsigned ldsw = (unsigned)wid * 1024u;
    const int aoff = lds_byte(wr * 64 + fr, fq * 8), boff = lds_byte(wc * 32 + fr, fq * 8);
#define PG8_SA(b, h) (((b) * 2 + (h)) * HTB)
#define PG8_SB(b, h) ((4 + (b) * 2 + (h)) * HTB)
#define PG8_STAGE(bufoff, gbase, voff) do { _Pragma("unroll") for (int _i = 0; _i < 2; ++_i) \
        __builtin_amdgcn_global_load_lds((const unsigned*)((const char*)(gbase) + (voff)[_i]), (PG8_LAS unsigned*)(lds + (bufoff) + ldsw + _i * 8192), 16, 0, 0); } while (0)
#define PG8_LDA(dst, b, h) do { _Pragma("unroll") for (int m = 0; m < 4; ++m) _Pragma("unroll") for (int k = 0; k < 2; ++k) dst[m][k] = *(const PG8_LAS bf16x8*)(lds + PG8_SA(b, h) + aoff + m * 2048 + k * 1024); } while (0)
#define PG8_LDB(dst, b, h) do { _Pragma("unroll") for (int n = 0; n < 2; ++n) _Pragma("unroll") for (int k = 0; k < 2; ++k) dst[n][k] = *(const PG8_LAS bf16x8*)(lds + PG8_SB(b, h) + boff + n * 2048 + k * 1024); } while (0)
#define PG8_MMA(ai, bj, At, Bt) do { __builtin_amdgcn_s_setprio(1); _Pragma("unroll") for (int m = 0; m < 4; ++m) _Pragma("unroll") for (int n = 0; n < 2; ++n) _Pragma("unroll") for (int k = 0; k < 2; ++k) \
        acc[ai][bj][m][n] = __builtin_amdgcn_mfma_f32_16x16x32_bf16(Bt[n][k], At[m][k], acc[ai][bj][m][n], 0, 0, 0); __builtin_amdgcn_s_setprio(0); } while (0)
#define PG8_WAIT_V(n) asm volatile("s_waitcnt vmcnt(" #n ")" ::: "memory")
#define PG8_WAIT_L(n) asm volatile("s_waitcnt lgkmcnt(" #n ")" ::: "memory")
#define PG8_BAR __builtin_amdgcn_s_barrier()
#define PG8_SCHED __builtin_amdgcn_sched_barrier(0)
    Unit cur, nxt; int ui = 0;
    if (!S.next(0, cur)) return;
    f32x4 acc[2][2][4][2];
#pragma unroll
    for (int a = 0; a < 2; ++a)
#pragma unroll
        for (int b = 0; b < 2; ++b)
#pragma unroll
            for (int m = 0; m < 4; ++m)
#pragma unroll
                for (int n = 0; n < 2; ++n) acc[a][b][m][n] = (f32x4){0.f, 0.f, 0.f, 0.f};
    bf16x8 At[4][2], B0[2][2], B1[2][2];
    const char* cA = (const char*)g.A + (size_t)cur.pm * tstep; const char* cB = (const char*)g.Bt + (size_t)cur.pn * tstep;
    S.a_ready(cur);
    if constexpr (SP2) {
        PG8_STAGE(PG8_SB(0, 0), cB, voffB); PG8_STAGE(PG8_SB(0, 1), cB + hstep, voffB); PG8_STAGE(PG8_SA(0, 0), cA, voffA); PG8_STAGE(PG8_SA(0, 1), cA + hstep, voffA);
        if (wr == 1) PG8_BAR;
        PG8_WAIT_V(2); PG8_BAR;
        PG8_STAGE(PG8_SB(1, 0), cB + kstep, voffB); PG8_STAGE(PG8_SA(1, 0), cA + kstep, voffA); PG8_STAGE(PG8_SB(1, 1), cB + hstep + kstep, voffB);
        PG8_WAIT_V(6); PG8_BAR;
    } else {
        PG8_STAGE(PG8_SB(0, 0), cB, voffB); PG8_STAGE(PG8_SA(0, 0), cA, voffA); PG8_STAGE(PG8_SB(0, 1), cB + hstep, voffB); PG8_STAGE(PG8_SA(0, 1), cA + hstep, voffA);
        if (wr == 1) PG8_BAR;
        PG8_WAIT_V(4); PG8_BAR;
        PG8_STAGE(PG8_SB(1, 0), cB + kstep, voffB); PG8_STAGE(PG8_SA(1, 0), cA + kstep, voffA); PG8_STAGE(PG8_SB(1, 1), cB + hstep + kstep, voffB);
        PG8_WAIT_V(6); PG8_BAR;
    }
    for (;;) {
        const bool has_next = S.next(ui + 1, nxt);
        const char* nA = has_next ? (const char*)g.A + (size_t)nxt.pm * tstep : cA; const char* nB = has_next ? (const char*)g.Bt + (size_t)nxt.pn * tstep : cB;
        for (int t = 0; t < nt; t += 2) {
            const bool last = (t == nt - 2);
            const char* a1 = cA + (size_t)(t + 1) * kstep;
            const char* a2 = last ? nA : cA + (size_t)(t + 2) * kstep; const char* b2 = last ? nB : cB + (size_t)(t + 2) * kstep;
            const char* a3 = a2 + kstep; const char* b3 = b2 + kstep;
            if (last && has_next) S.a_ready(nxt);
            if constexpr (SP2) {
            PG8_LDB(B0, 0, 0); PG8_LDB(B1, 0, 1); PG8_SCHED; PG8_LDA(At, 0, 0); PG8_STAGE(PG8_SA(1, 1), a1 + hstep, voffA);
            PG8_WAIT_V(8); PG8_WAIT_L(0); PG8_BAR; PG8_MMA(0, 0, At, B0); PG8_MMA(0, 1, At, B1); PG8_BAR; PG8_SCHED;
            PG8_LDA(At, 0, 1); PG8_STAGE(PG8_SB(0, 0), b2, voffB); PG8_STAGE(PG8_SB(0, 1), b2 + hstep, voffB); PG8_STAGE(PG8_SA(0, 0), a2, voffA);
            PG8_WAIT_V(8); PG8_WAIT_L(0); PG8_BAR; PG8_MMA(1, 0, At, B0); PG8_MMA(1, 1, At, B1); PG8_BAR; PG8_SCHED;
            PG8_LDB(B0, 1, 0); PG8_LDB(B1, 1, 1); PG8_SCHED; PG8_LDA(At, 1, 0); PG8_STAGE(PG8_SA(0, 1), a2 + hstep, voffA);
            PG8_WAIT_V(8); PG8_WAIT_L(0); PG8_BAR; PG8_MMA(0, 0, At, B0); PG8_MMA(0, 1, At, B1); PG8_BAR; PG8_SCHED;
            PG8_LDA(At, 1, 1); PG8_STAGE(PG8_SB(1, 0), b3, voffB); PG8_STAGE(PG8_SB(1, 1), b3 + hstep, voffB); PG8_STAGE(PG8_SA(1, 0), a3, voffA);
            PG8_WAIT_V(8); PG8_WAIT_L(0); PG8_BAR; PG8_MMA(1, 0, At, B0); PG8_MMA(1, 1, At, B1); PG8_BAR; PG8_SCHED;
            } else {
            PG8_LDB(B0, 0, 0); PG8_SCHED; PG8_LDA(At, 0, 0); PG8_STAGE(PG8_SA(1, 1), a1 + hstep, voffA);
            PG8_WAIT_L(8); PG8_BAR; PG8_WAIT_L(0); PG8_MMA(0, 0, At, B0); PG8_BAR; PG8_SCHED;
            PG8_LDB(B1, 0, 1); PG8_STAGE(PG8_SB(0, 0), b2, voffB);
            PG8_BAR; PG8_WAIT_L(0); PG8_MMA(0, 1, At, B1); PG8_BAR;
            PG8_LDA(At, 0, 1); PG8_STAGE(PG8_SA(0, 0), a2, voffA);
            PG8_BAR; PG8_WAIT_L(0); PG8_MMA(1, 0, At, B0); PG8_BAR; PG8_SCHED;
            PG8_STAGE(PG8_SB(0, 1), b2 + hstep, voffB);
            PG8_WAIT_V(6); PG8_BAR; PG8_MMA(1, 1, At, B1); PG8_BAR;
            PG8_LDB(B0, 1, 0); PG8_SCHED; PG8_LDA(At, 1, 0); PG8_STAGE(PG8_SA(0, 1), a2 + hstep, voffA);
            PG8_WAIT_L(8); PG8_BAR; PG8_WAIT_L(0); PG8_MMA(0, 0, At, B0); PG8_BAR; PG8_SCHED;
            PG8_LDB(B1, 1, 1); PG8_STAGE(PG8_SB(1, 0), b3, voffB);
            PG8_BAR; PG8_WAIT_L(0); PG8_MMA(0, 1, At, B1); PG8_BAR;
            PG8_LDA(At, 1, 1); PG8_STAGE(PG8_SA(1, 0), a3, voffA);
            PG8_BAR; PG8_WAIT_L(0); PG8_MMA(1, 0, At, B0); PG8_BAR; PG8_SCHED;
            PG8_STAGE(PG8_SB(1, 1), b3 + hstep, voffB);
            PG8_WAIT_V(6); PG8_BAR; PG8_MMA(1, 1, At, B1); PG8_BAR;
            }
        }
        if constexpr (ALIGN_EPI) { if (wr == 0) PG8_BAR; }
        if constexpr (!Epi::AFTER_DRAIN) { E(acc, cur, wr, wc, fr, fq); S.done(cur); }
        if (!has_next) break;
#pragma unroll
        for (int a = 0; a < 2; ++a)
#pragma unroll
            for (int b = 0; b < 2; ++b)
#pragma unroll
                for (int m = 0; m < 4; ++m)
#pragma unroll
                    for (int n = 0; n < 2; ++n) acc[a][b][m][n] = (f32x4){0.f, 0.f, 0.f, 0.f};
        cur = nxt; cA = nA; cB = nB; ++ui;
        if constexpr (ALIGN_EPI) { if (wr == 1) PG8_BAR; }
    }
    PG8_WAIT_V(0);
    if constexpr (!ALIGN_EPI) { if (wr == 0) PG8_BAR; }
    PG8_BAR;
    if constexpr (Epi::AFTER_DRAIN) { E.fused(acc, cur, wr, wc, fr, fq, lds, wid, lane); S.done(cur); }
#undef PG8_SA
#undef PG8_SB
#undef PG8_STAGE
#undef PG8_LDA
#undef PG8_LDB
#undef PG8_MMA
#undef PG8_WAIT_V
#undef PG8_WAIT_L
#undef PG8_BAR
#undef PG8_SCHED
}
}
constexpr int NWAVES = 8;
#ifndef MK_PER_PHASE
#define MK_PER_PHASE 0
#endif
constexpr int DM = 1024, NB = 2, SEQ = 8192, M = NB * SEQ, DEPTH = 4;
constexpr int CD = 512, HEADS = 4, HD = 128, MD = 512, EVEN_IN = 3592, EVEN_NP = 3840, EVEN_W = 3584, DFF = 2816, CHUNK = 128, NCH = SEQ / CHUNK, NUNIT = NB * HEADS * NCH;
constexpr float RMS_EPS = 1e-6f;
constexpr size_t MiB = 1u << 20;
constexpr size_t WS_CTL = 0, CTL_ZERO_BYTES = 1 * MiB;
constexpr size_t WS_SQ = 1 * MiB;
constexpr size_t WS_VSQ = 2 * MiB;
constexpr size_t WS_GATES = 3 * MiB;
constexpr size_t WS_NLOC = 4 * MiB;
constexpr size_t WS_NIN = 4 * MiB + 256 * 1024;
constexpr size_t WS_MLOC = 4 * MiB + 512 * 1024;
constexpr size_t WS_BL = WS_MLOC + 4096;
constexpr size_t WS_MIN = WS_BL + 4096;
constexpr size_t WS_WEI = 5 * MiB;
constexpr size_t WS_WEO = 20 * MiB;
constexpr size_t WS_WOI = 24 * MiB;
constexpr size_t WS_WOO = 32 * MiB;
constexpr size_t WS_WFI = 36 * MiB;
constexpr size_t WS_WFO = 80 * MiB;
constexpr size_t WS_XB = 102 * MiB;
constexpr size_t WS_Y = 134 * MiB;
constexpr size_t WS_BIG = 166 * MiB;
constexpr size_t WS_CLOC = 278 * MiB;
constexpr size_t WS_CIN = 310 * MiB;
constexpr size_t WS_END = 326 * MiB;
constexpr int CW_BAR = 4096;
constexpr int RING_BYTES = 131072;
constexpr int SQS_OFF = RING_BYTES;
constexpr int LDS_BYTES = 163840;
constexpr int LDSCTL_OFF = LDS_BYTES - 512, MISC_OFF = LDSCTL_OFF + 320;
constexpr int TSTR = 272;
constexpr int TILE_B = 128 * TSTR;
#define GAS __attribute__((address_space(1)))
#define LAS __attribute__((address_space(3)))
typedef unsigned short bf16;
typedef unsigned v4u __attribute__((ext_vector_type(4)));
typedef float f32x4 __attribute__((ext_vector_type(4)));
typedef short bf16x8 __attribute__((ext_vector_type(8)));
typedef GAS unsigned gu32;
typedef GAS unsigned long long gu64;
#define RLX_AGENT __ATOMIC_RELAXED, __HIP_MEMORY_SCOPE_AGENT
#define LDS_WAIT() asm volatile("s_waitcnt lgkmcnt(0)" ::: "memory")
#define VM_WAIT() asm volatile("s_waitcnt vmcnt(0)" ::: "memory")
__device__ __forceinline__ unsigned long long rt() { return __builtin_amdgcn_s_memrealtime(); }
__device__ __forceinline__ unsigned f2bf(float f) { unsigned u = __builtin_bit_cast(unsigned, f); return (u + 0x7fffu + ((u >> 16) & 1u)) >> 16; }
__device__ __forceinline__ unsigned pk2(float lo, float hi) { return f2bf(lo) | (f2bf(hi) << 16); }

#define XB_TMO      128
#define XB_XCNT(j)  (256  + 64 * (j))
#define XB_XSUB(j)  (1280 + 64 * (j))
#define XB_XGEN(j)  (2304 + 64 * (j))
#define XB_TOP      3328
#define XB_TOPGEN   3392
#define XCD_BAR_WORDS 3456
#define XB_SPIN_CAP (1u << 18)

__device__ __forceinline__ unsigned xb_ld(unsigned* p)              { return __hip_atomic_load(p, __ATOMIC_RELAXED, __HIP_MEMORY_SCOPE_AGENT); }
__device__ __forceinline__ unsigned xb_add(unsigned* p, unsigned v) { return __hip_atomic_fetch_add(p, v, __ATOMIC_RELAXED, __HIP_MEMORY_SCOPE_AGENT); }
__device__ __forceinline__ unsigned xb_xcc_id() { return (unsigned)__builtin_amdgcn_s_getreg((3 << 11) | 20) & 0xFu; }
#define XB_SPIN(cond, bar) do { unsigned _sp = 0; while (cond) { __builtin_amdgcn_s_sleep(1); \
    if ((++_sp & 255u) == 0u) { if (xb_ld(&(bar)[XB_TMO])) break; if (_sp > XB_SPIN_CAP) { atomicAdd(&(bar)[XB_TMO], 1u); break; } } } } while (0)

struct XcdBarrier {
    unsigned* bar; unsigned x;
    volatile LAS unsigned* st;
};

__device__ __forceinline__ XcdBarrier xcd_barrier_post(unsigned* bar, volatile LAS unsigned* st) {
    XcdBarrier b; b.bar = bar; b.x = xb_xcc_id(); b.st = st;
    if (threadIdx.x == 0) (void)xb_add(&bar[XB_XCNT(b.x)], 1u);
    return b;
}
__device__ __forceinline__ void xcd_barrier_complete(unsigned* bar, unsigned x, unsigned& nloc, unsigned& nx) {
    const unsigned G = gridDim.x * gridDim.y * gridDim.z;
    unsigned sum, cnt, mine, sp = 0u;
    for (;;) {
        sum = 0u; cnt = 0u; mine = 0u;
#pragma unroll
        for (unsigned j = 0; j < 16; ++j) { const unsigned c = xb_ld(&bar[XB_XCNT(j)]); sum += c; cnt += (c > 0u) ? 1u : 0u; mine = (j == x) ? c : mine; }
        if (sum == G) break;
        __builtin_amdgcn_s_sleep(1);
        if ((++sp & 255u) == 0u) { if (xb_ld(&bar[XB_TMO])) break; if (sp > XB_SPIN_CAP) { atomicAdd(&bar[XB_TMO], 1u); break; } }
    }
    nloc = mine > 0u ? mine : 1u; nx = cnt > 0u ? cnt : 1u;
}

__device__ __forceinline__ void xcd_barrier(const XcdBarrier& b) {
    asm volatile("s_waitcnt vmcnt(0)" ::: "memory");
    __syncthreads();
    if (threadIdx.x == 0) {
        unsigned* bar = b.bar;
        __builtin_amdgcn_s_waitcnt(0);
        unsigned nloc = b.st[0], nx = b.st[1];
        if (nloc == 0u) { xcd_barrier_complete(bar, b.x, nloc, nx); b.st[0] = nloc; b.st[1] = nx; }
        const unsigned old = xb_add(&bar[XB_XSUB(b.x)], 1u);
        const unsigned gen = old / nloc;
        if (old + 1u == (gen + 1u) * nloc) {
            __builtin_amdgcn_fence(__ATOMIC_RELEASE, "agent");
            asm volatile("s_waitcnt vmcnt(0)" ::: "memory");
            const unsigned og = xb_add(&bar[XB_TOP], 1u);
            const unsigned tg = og / nx;
            if (og + 1u == (tg + 1u) * nx) xb_add(&bar[XB_TOPGEN], 1u);
            else XB_SPIN(xb_ld(&bar[XB_TOPGEN]) == tg, bar);
            __builtin_amdgcn_fence(__ATOMIC_ACQUIRE, "agent");
            xb_add(&bar[XB_XGEN(b.x)], 1u);
            asm volatile("s_waitcnt vmcnt(0)" ::: "memory");
        } else {
            XB_SPIN(xb_ld(&bar[XB_XGEN(b.x)]) == gen, bar);
            __builtin_amdgcn_fence(__ATOMIC_ACQUIRE, "agent");
            asm volatile("s_waitcnt vmcnt(0)" ::: "memory");
        }
    }
    __syncthreads();
}
typedef unsigned u32x2 __attribute__((ext_vector_type(2)));
struct Frame {
    LAS unsigned char* lds;
    volatile LAS unsigned* MISC;
    gu32* ctl;
    int vcu, G;
    unsigned char* ws;
    const float* in[16];
    float* x;
};
#define OPQ_TID() int tid = threadIdx.x; asm volatile("" : "+v"(tid)); const int lane = tid & 63, w = __builtin_amdgcn_readfirstlane(tid >> 6), fr = lane & 15, fq = lane >> 4; (void)w; (void)fr; (void)fq
__device__ __forceinline__ float wave_sum(float v) {
#pragma unroll
    for (int o = 1; o < 64; o <<= 1) v += __shfl_xor(v, o);
    return v;
}
__device__ __forceinline__ float wave_max(float v) {
#pragma unroll
    for (int o = 1; o < 64; o <<= 1) v = fmaxf(v, __shfl_xor(v, o));
    return v;
}
__device__ __forceinline__ float bf2f(unsigned short h) { return __builtin_bit_cast(float, (unsigned)h << 16); }
__device__ __forceinline__ float logsig(float x) { return fminf(x, 0.f) - log1pf(expf(-fabsf(x))); }

__device__ __forceinline__ void cv_item(const float* W, int ldw, int K, int sc0, bf16* Bt, int dr0, int k0, const float* gain, float cs, LAS float* scr, int lane) {
    float v[32];
    const float* wp = W + (size_t)(k0 + (lane >> 5)) * ldw + sc0 + (lane & 31);
#pragma unroll
    for (int i = 0; i < 32; ++i) v[i] = wp[(size_t)(2 * i) * ldw];
#pragma unroll
    for (int i = 0; i < 32; ++i) scr[(2 * i + (lane >> 5)) * 33 + (lane & 31)] = v[i];
    LDS_WAIT(); asm volatile("" ::: "memory");
    const int c = lane & 7;
    f32x4 g0 = {cs, cs, cs, cs}, g1 = g0;
    if (gain) { g0 = *(const f32x4*)(gain + k0 + 8 * c) * cs; g1 = *(const f32x4*)(gain + k0 + 8 * c + 4) * cs; }
#pragma unroll
    for (int j = 0; j < 4; ++j) { const int n = (lane >> 3) + 8 * j; const LAS float* s = scr + (8 * c) * 33 + n;
        v4u o; o.x = pk2(s[0 * 33] * g0[0], s[1 * 33] * g0[1]); o.y = pk2(s[2 * 33] * g0[2], s[3 * 33] * g0[3]); o.z = pk2(s[4 * 33] * g1[0], s[5 * 33] * g1[1]); o.w = pk2(s[6 * 33] * g1[2], s[7 * 33] * g1[3]);
        *(GAS v4u*)(Bt + (size_t)(dr0 + n) * K + k0 + 8 * c) = o; }
    LDS_WAIT(); asm volatile("" ::: "memory");
}
__device__ __forceinline__ void convert_layer(Frame& F, int l, int wbase, int nw) {
    OPQ_TID();
    const int wi = wbase + w;
    LAS float* scr = (LAS float*)(F.lds + w * 16384);
    const int j = l >> 1; const bool odd = l & 1;
    const float* norm_mix = F.in[1] + (size_t)l * DM; const float* norm_ffn = F.in[2] + (size_t)l * DM;
    const int nbi = odd ? 64 : 112, I_MI = nbi * 16, I_MO = 32 * 16, I_FI = 176 * 16, I_FO = 32 * 44;
    const int N0 = I_MI, N1 = N0 + I_MO, N2 = N1 + I_FI, N3 = N2 + I_FO, NT = N3 + (odd ? 0 : 16);
    for (int it = wi; it < NT; it += nw) {
        if (it < N0) { const int kb = it / nbi, nb = it % nbi, c0 = 32 * nb;
            if (odd) cv_item(F.in[8] + (size_t)j * DM * 2048, 2048, DM, c0, (bf16*)(F.ws + WS_WOI) + (size_t)j * 2048 * DM, c0, 64 * kb, norm_mix, 1.0f, scr, lane);
            else cv_item(F.in[3] + (size_t)j * DM * EVEN_IN, EVEN_IN, DM, c0, (bf16*)(F.ws + WS_WEI) + (size_t)j * EVEN_NP * DM, c0, 64 * kb, norm_mix, (c0 >= 2048 && c0 < 2560) ? 0.08838834764831845f : 1.0f, scr, lane);
        } else if (it < N1) { const int r = it - N0, kb = r / 32, nb = r % 32;
            cv_item((odd ? F.in[12] : F.in[7]) + (size_t)j * DM * DM, DM, DM, 32 * nb, (bf16*)(F.ws + (odd ? WS_WOO : WS_WEO)) + (size_t)j * DM * DM, 32 * nb, 64 * kb, nullptr, 1.0f, scr, lane);
        } else if (it < N2) { const int r = it - N1, kb = r / 176, nb = r % 176, c0 = 32 * nb;
            const int up = c0 >= DFF, cc = up ? c0 - DFF : c0, dr = 256 * (cc >> 7) + (up ? 128 : 0) + (cc & 127);
            cv_item(F.in[13] + (size_t)l * DM * 2 * DFF, 2 * DFF, DM, c0, (bf16*)(F.ws + WS_WFI) + (size_t)l * 2 * DFF * DM, dr, 64 * kb, norm_ffn, 1.0f, scr, lane);
        } else if (it < N3) { const int r = it - N2, kb = r / 32, nb = r % 32;
            cv_item(F.in[14] + (size_t)l * DFF * DM, DM, DFF, 32 * nb, (bf16*)(F.ws + WS_WFO) + (size_t)l * DM * DFF, 32 * nb, 64 * kb, nullptr, 1.0f, scr, lane);
        } else { const int k0 = 64 * (it - N3);
            const float* W = F.in[3] + (size_t)j * DM * EVEN_IN; bf16* Bt = (bf16*)(F.ws + WS_WEI) + (size_t)j * EVEN_NP * DM;
#pragma unroll
            for (int e = 0; e < 8; ++e) { const int id = lane + 64 * e, col = id & 7, kk = k0 + (id >> 3);
                Bt[(size_t)(EVEN_W + col) * DM + kk] = (bf16)f2bf(W[(size_t)kk * EVEN_IN + EVEN_W + col] * norm_mix[kk]); }
        }
    }
}
__device__ __forceinline__ void p0_prologue(Frame& F, const float* xin) {
    OPQ_TID();
    const int gw = F.vcu * NWAVES + w, NGW = F.G * NWAVES;
    float* sq4 = (float*)(F.ws + WS_SQ); bf16* xb = (bf16*)(F.ws + WS_XB);
    for (int m = gw; m < M; m += 2 * NGW) {
        const int m1 = m + NGW;
        const GAS f32x4* xr0 = (const GAS f32x4*)(xin + (size_t)m * DM) + lane; const GAS f32x4* xr1 = (const GAS f32x4*)(xin + (size_t)m1 * DM) + lane;
        f32x4 v0[4], v1[4];
#pragma unroll
        for (int jj = 0; jj < 4; ++jj) { v0[jj] = xr0[64 * jj]; v1[jj] = xr1[64 * jj]; }
        GAS u32x2* bo0 = (GAS u32x2*)(xb + (size_t)m * DM) + lane; GAS u32x2* bo1 = (GAS u32x2*)(xb + (size_t)m1 * DM) + lane; float s0 = 0.f, s1 = 0.f;
#pragma unroll
        for (int jj = 0; jj < 4; ++jj) { u32x2 q; q.x = pk2(v0[jj].x, v0[jj].y); q.y = pk2(v0[jj].z, v0[jj].w); bo0[64 * jj] = q; s0 += (v0[jj].x * v0[jj].x + v0[jj].y * v0[jj].y) + (v0[jj].z * v0[jj].z + v0[jj].w * v0[jj].w);
            u32x2 p; p.x = pk2(v1[jj].x, v1[jj].y); p.y = pk2(v1[jj].z, v1[jj].w); bo1[64 * jj] = p; s1 += (v1[jj].x * v1[jj].x + v1[jj].y * v1[jj].y) + (v1[jj].z * v1[jj].z + v1[jj].w * v1[jj].w); }
        s0 = wave_sum(s0); s1 = wave_sum(s1);
        if (lane < 4) { sq4[(size_t)m * 4 + lane] = (lane == 0) ? s0 : 0.f; sq4[(size_t)m1 * 4 + lane] = (lane == 0) ? s1 : 0.f; }
    }
    convert_layer(F, 0, F.vcu * NWAVES, NGW);
}
__device__ __forceinline__ void final_norm(Frame& F) {
    OPQ_TID();
    const int gw = F.vcu * NWAVES + w, NGW = F.G * NWAVES;
    const float* sq4 = (const float*)(F.ws + WS_SQ); const float* gf = F.in[15]; const bf16* xb = (const bf16*)(F.ws + WS_XB);
    f32x4 g[4];
#pragma unroll
    for (int j = 0; j < 4; ++j) g[j] = ((const f32x4*)gf)[lane + 64 * j];
    for (int m = gw; m < M; m += NGW) {
        const float r = pg8::row_rstd4(sq4, m);
        GAS f32x4* xo = (GAS f32x4*)(F.x + (size_t)m * DM) + lane; const GAS u32x2* bi = (const GAS u32x2*)(xb + (size_t)m * DM) + lane;
#pragma unroll
        for (int j = 0; j < 4; ++j) { const u32x2 b = bi[64 * j]; f32x4 v = {pg8::bf_lo(b.x), pg8::bf_hi(b.x), pg8::bf_lo(b.y), pg8::bf_hi(b.y)}; v = v * r * g[j]; xo[64 * j] = v; }
    }
}
__device__ __forceinline__ void scan128_add(float& v0, float& v1, int lane) {
#pragma unroll
    for (int o = 1; o < 64; o <<= 1) { const float a = __shfl_up(v0, o), b = __shfl_up(v1, o); if (lane >= o) { v0 += a; v1 += b; } }
    v1 += __shfl(v0, 63);
}
__device__ __forceinline__ void scan128_max(float& v0, float& v1, int lane) {
#pragma unroll
    for (int o = 1; o < 64; o <<= 1) { const float a = __shfl_up(v0, o), b = __shfl_up(v1, o); if (lane >= o) { v0 = fmaxf(v0, a); v1 = fmaxf(v1, b); } }
    v1 = fmaxf(v1, __shfl(v0, 63));
}
struct Stg { v4u v[4]; };
__device__ __forceinline__ void stg_load_tr(Stg& s, const bf16* src, int ld, int tid) {
#pragma unroll
    for (int i = 0; i < 4; ++i) { const int id = tid + 512 * i, r = id & 127, dc = id >> 7; s.v[i] = *(const GAS v4u*)(src + (size_t)r * ld + 8 * dc); }
}
__device__ __forceinline__ void stg_store_tr(const Stg& s, LAS unsigned char* tile, bool scale, float f, int tid) {
#pragma unroll
    for (int i = 0; i < 4; ++i) { const int id = tid + 512 * i, r = id & 127, dc = id >> 7;
        const unsigned w[4] = {s.v[i].x, s.v[i].y, s.v[i].z, s.v[i].w};
#pragma unroll
        for (int j = 0; j < 4; ++j) { unsigned lo = w[j] & 0xffffu, hi = w[j] >> 16;
            if (scale) { lo = f2bf(bf2f((unsigned short)lo) * f); hi = f2bf(bf2f((unsigned short)hi) * f); }
            *(LAS unsigned short*)(tile + (8 * dc + 2 * j) * TSTR + 2 * r) = (unsigned short)lo; *(LAS unsigned short*)(tile + (8 * dc + 2 * j + 1) * TSTR + 2 * r) = (unsigned short)hi; } }
}
__device__ __forceinline__ void stg_load_rows(Stg& s, const bf16* src, int ld, int tid) {
#pragma unroll
    for (int i = 0; i < 4; ++i) { const int id = tid + 512 * i, r = id >> 4, dc = id & 15; s.v[i] = *(const GAS v4u*)(src + (size_t)r * ld + 8 * dc); }
}
__device__ __forceinline__ void stg_store_rows(const Stg& s, LAS unsigned char* tile, int tid) {
#pragma unroll
    for (int i = 0; i < 4; ++i) { const int id = tid + 512 * i, r = id >> 4, dc = id & 15; *(LAS v4u*)(tile + r * TSTR + 16 * dc) = s.v[i]; }
}
#define FRAG(tile, row, kk, fq) (*(const LAS bf16x8*)((tile) + (row) * TSTR + (32 * (kk) + 8 * (fq)) * 2))

__device__ __forceinline__ void mlstm_phase_a(Frame& F) {
    LAS unsigned char* TK = F.lds; LAS unsigned char* TV = F.lds + TILE_B; LAS float* aS = (LAS float*)(F.lds + 2 * TILE_B);
    const bf16* proj = (const bf16*)(F.ws + WS_BIG); const float* gates = (const float*)(F.ws + WS_GATES);
    float* Cloc = (float*)(F.ws + WS_CLOC); float* nloc = (float*)(F.ws + WS_NLOC); float* mloc = (float*)(F.ws + WS_MLOC); float* bLv = (float*)(F.ws + WS_BL);
    for (int u = F.vcu; u < NUNIT; u += F.G) {
        OPQ_TID();
        const int bh = u >> 6, c = u & 63, b = bh >> 2, h = bh & 3, row0 = b * SEQ + c * CHUNK;
        if (w == 0) {
            const float i0 = gates[(size_t)(row0 + lane) * 8 + h], i1 = gates[(size_t)(row0 + lane + 64) * 8 + h];
            float b0 = logsig(gates[(size_t)(row0 + lane) * 8 + 4 + h]), b1 = logsig(gates[(size_t)(row0 + lane + 64) * 8 + 4 + h]);
            scan128_add(b0, b1, lane);
            const float bL = __shfl(b1, 63);
            const float w0 = bL - b0 + i0, w1 = bL - b1 + i1;
            const float ml = wave_max(fmaxf(w0, w1));
            aS[lane] = __expf(w0 - ml); aS[lane + 64] = __expf(w1 - ml);
            if (lane == 0) { mloc[u] = ml; bLv[u] = bL; }
        }
        Stg sk, sv;
        stg_load_tr(sk, proj + (size_t)row0 * EVEN_W + 2048 + h * HD, EVEN_W, tid); stg_load_tr(sv, proj + (size_t)row0 * EVEN_W + 2560 + h * HD, EVEN_W, tid);
        __syncthreads();
        stg_store_tr(sk, TK, true, aS[tid & 127], tid);
        stg_store_tr(sv, TV, false, 1.0f, tid);
        __syncthreads();
        {
            const int d = tid >> 2, q = tid & 3; float s = 0.f;
#pragma unroll
            for (int i = 0; i < 4; ++i) { const bf16x8 v = *(const LAS bf16x8*)(TK + d * TSTR + (32 * q + 8 * i) * 2);
#pragma unroll
                for (int j = 0; j < 8; ++j) s += bf2f((unsigned short)v[j]); }
            s += __shfl_xor(s, 1); s += __shfl_xor(s, 2);
            if (q == 0) nloc[(size_t)u * HD + d] = s;
        }
        bf16x8 vf[4];
#pragma unroll
        for (int kk = 0; kk < 4; ++kk) vf[kk] = FRAG(TV, 16 * w + fr, kk, fq);
#pragma unroll
        for (int db = 0; db < 8; ++db) { f32x4 acc = {0.f, 0.f, 0.f, 0.f};
#pragma unroll
            for (int kk = 0; kk < 4; ++kk) acc = __builtin_amdgcn_mfma_f32_16x16x32_bf16(FRAG(TK, 16 * db + fr, kk, fq), vf[kk], acc, 0, 0, 0);
            *(GAS f32x4*)(Cloc + (size_t)u * (HD * HD) + (size_t)(16 * w + fr) * HD + 16 * db + 4 * fq) = acc; }
        __syncthreads();
    }
}
__device__ __forceinline__ void mlstm_scan_and_conv(Frame& F, const float* wconv) {
    OPQ_TID();
    const float* Cloc = (const float*)(F.ws + WS_CLOC); const float* nloc = (const float*)(F.ws + WS_NLOC); const float* mloc = (const float*)(F.ws + WS_MLOC); const float* bLv = (const float*)(F.ws + WS_BL);
    bf16* Cin = (bf16*)(F.ws + WS_CIN); float* nin = (float*)(F.ws + WS_NIN); float* minv = (float*)(F.ws + WS_MIN);
    LAS float* alS = (LAS float*)F.lds; LAS float* beS = alS + 64;
    for (int v = F.vcu; v < NB * HEADS * 32; v += F.G) {
        const int bh = v >> 5, part = v & 31, idx = part * 512 + tid;
        float cl[64];
#pragma unroll
        for (int c = 0; c < 64; ++c) cl[c] = Cloc[(size_t)(bh * NCH + c) * (HD * HD) + idx];
        if (w == 0) {
            const float ml = mloc[bh * NCH + lane], bl = bLv[bh * NCH + lane]; float m = 0.f, al = 0.f, be = 0.f, mi = 0.f;
            for (int c = 0; c < 64; ++c) { const float mlc = __shfl(ml, c), blc = __shfl(bl, c); const float mn = fmaxf(blc + m, mlc);
                if (lane == c) { al = __expf(blc + m - mn); be = __expf(mlc - mn); mi = m; } m = mn; }
            alS[lane] = al; beS[lane] = be; if (part == 0) minv[bh * NCH + lane] = mi;
        }
        __syncthreads();
        float C = 0.f;
#pragma unroll
        for (int c = 0; c < 64; ++c) { Cin[(size_t)(bh * NCH + c) * (HD * HD) + idx] = (bf16)f2bf(C); C = alS[c] * C + beS[c] * cl[c]; }
        if (part == 0 && tid < 128) { float n = 0.f;
#pragma unroll 8
            for (int c = 0; c < 64; ++c) { nin[(size_t)(bh * NCH + c) * HD + tid] = n; n = alS[c] * n + beS[c] * nloc[(size_t)(bh * NCH + c) * HD + tid]; } }
        __syncthreads();
    }
    const bf16* proj = (const bf16*)(F.ws + WS_BIG); bf16* Y = (bf16*)(F.ws + WS_Y);
    for (int g = F.vcu * 512 + tid; g < (M / 8) * (CD / 8); g += F.G * 512) {
        const int t0 = (g >> 6) * 8, c8 = (g & 63) * 8; const bool first = (t0 & (SEQ - 1)) == 0;
        v4u cg[10], xa[10], bg[8];
#pragma unroll
        for (int i = 0; i < 10; ++i) { const int t = (first && i < 2) ? t0 : t0 - 2 + i; const bf16* p = proj + (size_t)t * EVEN_W; cg[i] = *(const GAS v4u*)(p + CD + c8); xa[i] = *(const GAS v4u*)(p + 2 * CD + c8); }
#pragma unroll
        for (int i = 0; i < 8; ++i) bg[i] = *(const GAS v4u*)(proj + (size_t)(t0 + i) * EVEN_W + c8);
        float wc[3][8];
#pragma unroll
        for (int jj = 0; jj < 3; ++jj) { const f32x4 a = *(const f32x4*)(wconv + jj * CD + c8), b = *(const f32x4*)(wconv + jj * CD + c8 + 4);
            wc[jj][0] = a[0]; wc[jj][1] = a[1]; wc[jj][2] = a[2]; wc[jj][3] = a[3]; wc[jj][4] = b[0]; wc[jj][5] = b[1]; wc[jj][6] = b[2]; wc[jj][7] = b[3]; }
        float z[10][8];
#pragma unroll
        for (int i = 0; i < 10; ++i) { const unsigned cw[4] = {cg[i].x, cg[i].y, cg[i].z, cg[i].w}, xw[4] = {xa[i].x, xa[i].y, xa[i].z, xa[i].w}; const float msk = (first && i < 2) ? 0.f : 1.f;
#pragma unroll
            for (int j = 0; j < 4; ++j) { z[i][2 * j] = msk * pg8::bf_lo(cw[j]) * pg8::bf_lo(xw[j]); z[i][2 * j + 1] = msk * pg8::bf_hi(cw[j]) * pg8::bf_hi(xw[j]); } }
#pragma unroll
        for (int i = 0; i < 8; ++i) { const unsigned bw[4] = {bg[i].x, bg[i].y, bg[i].z, bg[i].w}; unsigned ow[4];
#pragma unroll
            for (int j = 0; j < 4; ++j) { const float a0 = wc[0][2 * j] * z[i][2 * j] + wc[1][2 * j] * z[i + 1][2 * j] + wc[2][2 * j] * z[i + 2][2 * j];
                const float a1 = wc[0][2 * j + 1] * z[i][2 * j + 1] + wc[1][2 * j + 1] * z[i + 1][2 * j + 1] + wc[2][2 * j + 1] * z[i + 2][2 * j + 1];
                ow[j] = pk2(pg8::bf_lo(bw[j]) * a0, pg8::bf_hi(bw[j]) * a1); }
            v4u o; o.x = ow[0]; o.y = ow[1]; o.z = ow[2]; o.w = ow[3];
            *(GAS v4u*)(Y + (size_t)(t0 + i) * DM + c8) = o; }
    }
}
__device__ __forceinline__ void mlstm_phase_c(Frame& F, const float* ghead) {
    LAS unsigned char* TK = F.lds; LAS unsigned char* TV = F.lds + TILE_B; LAS unsigned char* TC = F.lds + 2 * TILE_B; LAS unsigned char* TS = F.lds + 3 * TILE_B;
    LAS float* gS = (LAS float*)(F.lds + 4 * TILE_B); LAS float* mxS = gS + 128; LAS float* bS = gS + 256; LAS float* nS = gS + 384;
    const bf16* proj = (const bf16*)(F.ws + WS_BIG); const float* gates = (const float*)(F.ws + WS_GATES);
    const bf16* Cin = (const bf16*)(F.ws + WS_CIN); const float* nin = (const float*)(F.ws + WS_NIN); const float* minv = (const float*)(F.ws + WS_MIN);
    bf16* Y = (bf16*)(F.ws + WS_Y);
    for (int u = F.vcu; u < NUNIT; u += F.G) {
        OPQ_TID();
        const int bh = u >> 6, c = u & 63, b = bh >> 2, h = bh & 3, row0 = b * SEQ + c * CHUNK;
        const float m_in = minv[u];
        if (w == 0) {
            const float i0 = gates[(size_t)(row0 + lane) * 8 + h], i1 = gates[(size_t)(row0 + lane + 64) * 8 + h];
            float b0 = logsig(gates[(size_t)(row0 + lane) * 8 + 4 + h]), b1 = logsig(gates[(size_t)(row0 + lane + 64) * 8 + 4 + h]);
            scan128_add(b0, b1, lane);
            const float g0 = i0 - b0, g1 = i1 - b1; float p0 = g0, p1 = g1;
            scan128_max(p0, p1, lane);
            gS[lane] = g0; gS[lane + 64] = g1; mxS[lane] = fmaxf(m_in, p0); mxS[lane + 64] = fmaxf(m_in, p1); bS[lane] = b0; bS[lane + 64] = b1;
        } else if (w == 1) { nS[lane] = nin[(size_t)u * HD + lane]; nS[lane + 64] = nin[(size_t)u * HD + lane + 64]; }
        const int t = 16 * w + fr;
        bf16x8 qf[4];
#pragma unroll
        for (int kk = 0; kk < 4; ++kk) qf[kk] = *(const GAS bf16x8*)(proj + (size_t)(row0 + t) * EVEN_W + 1536 + h * HD + 32 * kk + 8 * fq);
        Stg sk, sc, sv;
        stg_load_rows(sk, proj + (size_t)row0 * EVEN_W + 2048 + h * HD, EVEN_W, tid); stg_load_rows(sc, Cin + (size_t)u * (HD * HD), HD, tid); stg_load_tr(sv, proj + (size_t)row0 * EVEN_W + 2560 + h * HD, EVEN_W, tid);
        u32x2 ovv[8];
#pragma unroll
        for (int eb = 0; eb < 8; ++eb) ovv[eb] = *(const GAS u32x2*)(proj + (size_t)(row0 + t) * EVEN_W + 3072 + h * HD + 16 * eb + 4 * fq);
        stg_store_rows(sk, TK, tid);
        stg_store_rows(sc, TC, tid);
        stg_store_tr(sv, TV, false, 1.0f, tid);
        __syncthreads();
        const float mx_t = mxS[t], b_t = bS[t], inter = __expf(m_in - mx_t);
        float den1 = 0.f;
#pragma unroll
        for (int sb = 0; sb < 8; ++sb) {
            u32x2 pk = {0u, 0u};
            if (sb <= w) { f32x4 acc = {0.f, 0.f, 0.f, 0.f};
#pragma unroll
                for (int kk = 0; kk < 4; ++kk) acc = __builtin_amdgcn_mfma_f32_16x16x32_bf16(FRAG(TK, 16 * sb + fr, kk, fq), qf[kk], acc, 0, 0, 0);
                float sv[4];
#pragma unroll
                for (int r = 0; r < 4; ++r) { const int s = 16 * sb + 4 * fq + r; const float e = __expf(gS[s] - mx_t); sv[r] = (s <= t) ? acc[r] * e : 0.f; den1 += sv[r]; }
                pk.x = pk2(sv[0], sv[1]); pk.y = pk2(sv[2], sv[3]); }
            *(LAS u32x2*)(TS + t * TSTR + (16 * sb + 4 * fq) * 2) = pk;
        }
        den1 += __shfl_xor(den1, 16); den1 += __shfl_xor(den1, 32);
        float qn = 0.f;
#pragma unroll
        for (int kk = 0; kk < 4; ++kk)
#pragma unroll
            for (int j = 0; j < 8; ++j) qn += bf2f((unsigned short)qf[kk][j]) * nS[32 * kk + 8 * fq + j];
        qn += __shfl_xor(qn, 16); qn += __shfl_xor(qn, 32);
        const float den = den1 + inter * qn, m_t = b_t + mx_t;
        const float rden = 1.0f / fmaxf(fabsf(den), __expf(-m_t));
        bf16x8 sf[4];
#pragma unroll
        for (int kk = 0; kk < 4; ++kk) sf[kk] = FRAG(TS, t, kk, fq);
        float hh[32]; float ssq = 0.f;
#pragma unroll
        for (int eb = 0; eb < 8; ++eb) { f32x4 a1 = {0.f, 0.f, 0.f, 0.f}, a2 = {0.f, 0.f, 0.f, 0.f};
#pragma unroll
            for (int kk = 0; kk < 4; ++kk) { if (2 * kk <= w) a1 = __builtin_amdgcn_mfma_f32_16x16x32_bf16(FRAG(TV, 16 * eb + fr, kk, fq), sf[kk], a1, 0, 0, 0);
                a2 = __builtin_amdgcn_mfma_f32_16x16x32_bf16(FRAG(TC, 16 * eb + fr, kk, fq), qf[kk], a2, 0, 0, 0); }
#pragma unroll
            for (int r = 0; r < 4; ++r) { const float v = (a1[r] + inter * a2[r]) * rden; hh[4 * eb + r] = v; ssq += v * v; } }
        ssq += __shfl_xor(ssq, 16); ssq += __shfl_xor(ssq, 32);
        const float rs = __builtin_amdgcn_rsqf(ssq * (1.0f / 128.0f) + RMS_EPS);
#pragma unroll
        for (int eb = 0; eb < 8; ++eb) { const int e = 16 * eb + 4 * fq;
            const u32x2 ov = ovv[eb]; const f32x4 gh = *(const f32x4*)(ghead + h * HD + e);
            const float o0 = bf2f((unsigned short)(ov.x & 0xffffu)), o1 = bf2f((unsigned short)(ov.x >> 16)), o2 = bf2f((unsigned short)(ov.y & 0xffffu)), o3 = bf2f((unsigned short)(ov.y >> 16));
            u32x2 y; y.x = pk2(pg8::fast_sigmoid(o0) * hh[4 * eb] * rs * gh[0], pg8::fast_sigmoid(o1) * hh[4 * eb + 1] * rs * gh[1]);
            y.y = pk2(pg8::fast_sigmoid(o2) * hh[4 * eb + 2] * rs * gh[2], pg8::fast_sigmoid(o3) * hh[4 * eb + 3] * rs * gh[3]);
            *(GAS u32x2*)(Y + (size_t)(row0 + t) * DM + MD + h * HD + e) = y; }
        __syncthreads();
    }
}
__device__ __forceinline__ void sgu_phase(Frame& F, const float* gv, const float* wsp, const float* bsp) {
    LAS unsigned char* TW = F.lds; LAS unsigned char* TV = F.lds + TILE_B;
    const bf16* Z = (const bf16*)(F.ws + WS_BIG); const float* vsq16 = (const float*)(F.ws + WS_VSQ); bf16* Y = (bf16*)(F.ws + WS_Y);
    for (int v = F.vcu; v < 256; v += F.G) {
        OPQ_TID();
        const int g = v & 7, cb0 = (v >> 3) * 4;
#pragma unroll
        for (int i = 0; i < 8; ++i) { const int id = tid + 512 * i, t = id >> 5, s4 = (id & 31) * 4;
            const f32x4 wv = *(const f32x4*)(wsp + ((size_t)g * CHUNK + t) * CHUNK + s4);
            u32x2 pk; pk.x = pk2(s4 <= t ? wv[0] : 0.f, s4 + 1 <= t ? wv[1] : 0.f); pk.y = pk2(s4 + 2 <= t ? wv[2] : 0.f, s4 + 3 <= t ? wv[3] : 0.f);
            *(LAS u32x2*)(TW + t * TSTR + s4 * 2) = pk; }
        const int t = 16 * w + fr;
        const float bst = bsp[g * CHUNK + t];
        f32x4 gvv[8];
#pragma unroll
        for (int db = 0; db < 8; ++db) gvv[db] = *(const f32x4*)(gv + g * 128 + 16 * db + 4 * fq);
        for (int ci = 0; ci < 4; ++ci) {
            const int row0 = (cb0 + ci) * CHUNK;
            Stg sv; stg_load_tr(sv, Z + (size_t)row0 * 2048 + 1024 + g * 128, 2048, tid);
            const float rs = pg8::row_rstd16(vsq16, row0 + (tid & 127));
            u32x2 uv[8];
#pragma unroll
            for (int db = 0; db < 8; ++db) uv[db] = *(const GAS u32x2*)(Z + (size_t)(row0 + t) * 2048 + g * 128 + 16 * db + 4 * fq);
            stg_store_tr(sv, TV, true, rs, tid);
            __syncthreads();
            bf16x8 wf[4];
#pragma unroll
            for (int kk = 0; kk < 4; ++kk) wf[kk] = FRAG(TW, t, kk, fq);
#pragma unroll
            for (int db = 0; db < 8; ++db) { f32x4 acc = {0.f, 0.f, 0.f, 0.f};
#pragma unroll
                for (int kk = 0; kk < 4; ++kk) if (2 * kk <= w) acc = __builtin_amdgcn_mfma_f32_16x16x32_bf16(FRAG(TV, 16 * db + fr, kk, fq), wf[kk], acc, 0, 0, 0);
                const int col = g * 128 + 16 * db + 4 * fq;
                u32x2 y; y.x = pk2(pg8::bf_lo(uv[db].x) * (acc[0] * gvv[db][0] + bst), pg8::bf_hi(uv[db].x) * (acc[1] * gvv[db][1] + bst));
                y.y = pk2(pg8::bf_lo(uv[db].y) * (acc[2] * gvv[db][2] + bst), pg8::bf_hi(uv[db].y) * (acc[3] * gvv[db][3] + bst));
                *(GAS u32x2*)(Y + (size_t)(row0 + t) * DM + col) = y; }
            __syncthreads();
        }
    }
}
#ifndef PROBE_MASK
#define PROBE_MASK 0
#endif
#ifndef TPROBE_KIND
#define TPROBE_KIND (-1)
#endif
#ifndef TPROBE_MODE
#define TPROBE_MODE 2
#endif
struct Args { const float* in[16]; float* out; unsigned char* ws; int ph_lo, ph_hi; };
constexpr int N_PHASES = 26;
enum Kind { K_P0, K_E1, K_E2, K_E3, K_E4, K_RESMIX, K_F1, K_RESFFN, K_O1, K_O2, K_FINAL };
__device__ __forceinline__ void decode_phase(int p, int& kind, int& layer) {
    if (p == 0) { kind = K_P0; layer = 0; return; }
    if (p == 25) { kind = K_FINAL; layer = 0; return; }
    int q = p - 1; const int pair = q / 12; q -= pair * 12;
    if (q < 7) { layer = 2 * pair; kind = q == 0 ? K_E1 : q == 1 ? K_E2 : q == 2 ? K_E3 : q == 3 ? K_E4 : q == 4 ? K_RESMIX : q == 5 ? K_F1 : K_RESFFN; }
    else { layer = 2 * pair + 1; q -= 7; kind = q == 0 ? K_O1 : q == 1 ? K_O2 : q == 2 ? K_RESMIX : q == 3 ? K_F1 : K_RESFFN; }
}
__global__ void __launch_bounds__(NWAVES * 64, 2) trunk_fwd(Args args) {
    extern __shared__ __attribute__((aligned(16))) unsigned char lds[];
    Frame F;
    F.lds = (LAS unsigned char*)lds;
    F.MISC = (volatile LAS unsigned*)(F.lds + MISC_OFF);
    F.G = gridDim.x; { const int bx = blockIdx.x; F.vcu = (F.G % 8 == 0) ? (bx % 8) * (F.G / 8) + bx / 8 : bx; }
    F.ws = args.ws; F.ctl = (gu32*)(args.ws + WS_CTL); F.x = args.out;
#pragma unroll
    for (int i = 0; i < 16; ++i) F.in[i] = args.in[i];
    for (int u = threadIdx.x; u < (LDS_BYTES - LDSCTL_OFF) / 4; u += NWAVES * 64) ((LAS unsigned*)(F.lds + LDSCTL_OFF))[u] = 0u;
    __syncthreads();
    XcdBarrier bar; bar.bar = (unsigned*)(F.ctl + CW_BAR); bar.x = 0; bar.st = nullptr;
    if (!MK_PER_PHASE) bar = xcd_barrier_post((unsigned*)(F.ctl + CW_BAR), F.MISC + 8);
    bf16* xb = (bf16*)(F.ws + WS_XB); bf16* Yb = (bf16*)(F.ws + WS_Y); bf16* big = (bf16*)(F.ws + WS_BIG);
    float* sq16 = (float*)(F.ws + WS_SQ);
    unsigned long long tpacc = 0;
    for (int p = args.ph_lo; p < args.ph_hi; ++p) {
        int kind, layer; decode_phase(p, kind, layer);
        const int j = layer >> 1;
        const int reps = ((PROBE_MASK >> kind) & 1) ? 2 : 1;
        unsigned long long tp0 = 0, tp1 = 0; if (TPROBE_KIND >= 0) tp0 = __builtin_amdgcn_s_memrealtime();
        for (int rep = 0; rep < reps; ++rep) {
        if (kind == K_P0) { p0_prologue(F, F.in[0]); }
        else if (kind == K_E1) {
            pg8::Gemm g{xb, (const bf16*)(F.ws + WS_WEI) + (size_t)j * EVEN_NP * DM, M, EVEN_NP, DM}; pg8::StaticOrder S; S.init(M, EVEN_NP, F.G, (int)blockIdx.x);
            pg8::EpiEvenIn E{big, sq16, (float*)(F.ws + WS_GATES), F.in[5] + (size_t)j * 8};
            pg8::gemm_phase<pg8::EpiEvenIn, pg8::StaticOrder, true, true>(F.lds, g, S, E);
        }
        else if (kind == K_E2) { mlstm_phase_a(F); }
        else if (kind == K_E3) { mlstm_scan_and_conv(F, F.in[4] + (size_t)j * 3 * CD); }
        else if (kind == K_E4) { mlstm_phase_c(F, F.in[6] + (size_t)j * MD); }
        else if (kind == K_RESMIX || kind == K_RESFFN) {
            const bool ffn = kind == K_RESFFN, odd = layer & 1;
            const bf16* A = ffn ? big : Yb;
            const bf16* Bt = ffn ? (const bf16*)(F.ws + WS_WFO) + (size_t)layer * DM * DFF : odd ? (const bf16*)(F.ws + WS_WOO) + (size_t)j * DM * DM : (const bf16*)(F.ws + WS_WEO) + (size_t)j * DM * DM;
            pg8::Gemm g{A, Bt, M, DM, ffn ? DFF : DM}; pg8::StaticOrder S; S.init(M, DM, F.G, (int)blockIdx.x);
            pg8::EpiResid E{xb, (LAS float*)(F.lds + SQS_OFF)};
            pg8::gemm_phase<pg8::EpiResid, pg8::StaticOrder, false, true>(F.lds, g, S, E);
            __syncthreads();
            { OPQ_TID(); (void)lane; pg8::Unit u0; if (S.next(0, u0) && tid < 256) { const f32x4 q = *(const LAS f32x4*)(F.lds + SQS_OFF + tid * 16);
                sq16[(size_t)(u0.pm * 256 + tid) * 4 + u0.pn] = (q[0] + q[1]) + (q[2] + q[3]); } }
        }
        else if (kind == K_F1) {
            pg8::Gemm g{xb, (const bf16*)(F.ws + WS_WFI) + (size_t)layer * 2 * DFF * DM, M, 2 * DFF, DM}; pg8::StaticOrder S; S.init(M, 2 * DFF, F.G, (int)blockIdx.x);
            pg8::EpiSwiGLU E{big, sq16};
            pg8::gemm_phase<pg8::EpiSwiGLU, pg8::StaticOrder, true, true>(F.lds, g, S, E);
            if (layer + 1 < DEPTH && rep == 0 && blockIdx.x >= 128) { __syncthreads(); convert_layer(F, layer + 1, ((int)blockIdx.x - 128) * NWAVES, (F.G - 128) * NWAVES); }
        }
        else if (kind == K_O1) {
            pg8::Gemm g{xb, (const bf16*)(F.ws + WS_WOI) + (size_t)j * 2048 * DM, M, 2048, DM}; pg8::StaticOrder S; S.init(M, 2048, F.G, (int)blockIdx.x);
            pg8::EpiGeluZ E{big, sq16, (float*)(F.ws + WS_VSQ)};
            pg8::gemm_phase<pg8::EpiGeluZ, pg8::StaticOrder, true, true>(F.lds, g, S, E);
        }
        else if (kind == K_O2) { sgu_phase(F, F.in[9] + (size_t)j * DM, F.in[10] + (size_t)j * 8 * CHUNK * CHUNK, F.in[11] + (size_t)j * 8 * CHUNK); }
        else { final_norm(F); }
        if (rep + 1 < reps) xcd_barrier(bar);
        }
        if (TPROBE_KIND >= 0) tp1 = __builtin_amdgcn_s_memrealtime();
        if (p + 1 < args.ph_hi) xcd_barrier(bar);
        if (TPROBE_KIND >= 0) { const unsigned long long tp2 = __builtin_amdgcn_s_memrealtime(); if (kind == TPROBE_KIND || TPROBE_KIND == 99) tpacc += (TPROBE_MODE == 0) ? (tp1 - tp0) : (TPROBE_MODE == 1) ? (tp2 - tp1) : (tp2 - tp0); }
    }
    if (TPROBE_KIND >= 0 && blockIdx.x == 0 && threadIdx.x == 0) { const unsigned long long t0 = __builtin_amdgcn_s_memrealtime(); while (__builtin_amdgcn_s_memrealtime() - t0 < 8ull * tpacc) __builtin_amdgcn_s_sleep(8); }
}

extern "C" void kernel_launch(void* const* d_in, const int* in_sizes, int n_in, void* d_out, int out_size, void* d_ws, size_t ws_size, hipStream_t stream) {
    static int grid = 0;
    if (grid == 0) {
        if (n_in != 16 || in_sizes[0] != M * DM || out_size != M * DM || ws_size < WS_END) { fprintf(stderr, "kernel_launch: unexpected shapes / workspace (n_in %d, ws %zu < %zu); nothing launched\n", n_in, ws_size, (size_t)WS_END); grid = -1; return; }
        int dev = 0, cus = 0, per_cu = 0;
        if (hipGetDevice(&dev) != hipSuccess || hipDeviceGetAttribute(&cus, hipDeviceAttributeMultiprocessorCount, dev) != hipSuccess) { grid = -1; return; }
        if (hipFuncSetAttribute((const void*)trunk_fwd, hipFuncAttributeMaxDynamicSharedMemorySize, LDS_BYTES) != hipSuccess) { fprintf(stderr, "kernel_launch: hipFuncSetAttribute failed\n"); grid = -1; return; }
        if (hipOccupancyMaxActiveBlocksPerMultiprocessor(&per_cu, (const void*)trunk_fwd, NWAVES * 64, LDS_BYTES) != hipSuccess || per_cu < 1) fprintf(stderr, "kernel_launch: note: occupancy query says %d\n", per_cu);
        (void)hipGetLastError();
        grid = cus;
    }
    if (grid < 0) return;
    if (hipMemsetAsync((char*)d_ws + WS_CTL, 0, CTL_ZERO_BYTES, stream) != hipSuccess) return;
    Args a{};
    for (int i = 0; i < 16; ++i) a.in[i] = (const float*)d_in[i];
    a.out = (float*)d_out; a.ws = (unsigned char*)d_ws;
#if MK_PER_PHASE
    for (int p = 0; p < N_PHASES; ++p) { a.ph_lo = p; a.ph_hi = p + 1; hipLaunchKernelGGL(trunk_fwd, dim3(grid), dim3(NWAVES * 64), LDS_BYTES, stream, a); }
#else
    a.ph_lo = 0; a.ph_hi = N_PHASES; hipLaunchKernelGGL(trunk_fwd, dim3(grid), dim3(NWAVES * 64), LDS_BYTES, stream, a);
#endif
}
```

```cpp
#include <hip/hip_runtime.h>
#include <cstdio>
#include <cstdint>
#define MK_PER_PHASE 0
namespace pg8 {
#define PG8_LAS __attribute__((address_space(3)))
typedef unsigned short bf16_t;
typedef short bf16x8 __attribute__((ext_vector_type(8)));
typedef float f32x4 __attribute__((ext_vector_type(4)));
typedef unsigned u32x4 __attribute__((ext_vector_type(4)));
constexpr int BM = 256, BK = 64, HALF = 128, HTB = HALF * BK * 2  , STAGE_BYTES = 8 * HTB, NXCD = 8, WGM = 8;

__host__ __device__ __forceinline__ int lds_byte(int r, int c) { const int st = (r >> 4) * 2 + (c >> 5), rr = r & 15, cc = c & 31, ob = rr * 64 + cc * 2; return st * 1024 + (ob ^ (((ob >> 9) & 1) << 5)); }
__host__ __device__ __forceinline__ void stage_rc(int b, int& R, int& C) { const int st = b / 1024, sb = b % 1024, swz = sb ^ (((sb >> 9) & 1) << 5); R = (st >> 1) * 16 + swz / 64; C = (st & 1) * 32 + (swz % 64) / 2; }
__host__ __device__ __forceinline__ int perm32(int rho) { const int n = rho >> 4, i = rho & 15; return 8 * (i >> 2) + 4 * n + (i & 3); }

struct Unit { int pm, pn; };
struct Gemm { const bf16_t* A; const bf16_t* Bt; int M, N, K; };

struct StaticOrder {
    int nM, nN, nwg, G, c;
    __host__ __device__ void init(int M, int N, int G_, int c_) { nM = M / BM; nN = N / BM; nwg = nM * nN; G = G_; c = c_; }
    __host__ __device__ bool next(int i, Unit& u) const {
        const long L = (long)i * G + c; if (L >= nwg) return false;
        int wgid = (int)L; { const int q = nwg / NXCD, r = nwg % NXCD, xcd = wgid % NXCD, off = wgid / NXCD; wgid = (xcd < r ? xcd * (q + 1) : r * (q + 1) + (xcd - r) * q) + off; }
        const int nig = WGM * nN, gid = wgid / nig, fm = gid * WGM, gsz = (nM - fm) < WGM ? (nM - fm) : WGM;
        u.pm = fm + ((wgid % nig) % gsz); u.pn = (wgid % nig) / gsz; return true;
    }
    __device__ __forceinline__ void a_ready(const Unit&) const {}
    __device__ __forceinline__ void done(const Unit&) const {}
};

__device__ __forceinline__ unsigned cvt_pk_bf16(float lo, float hi) { unsigned r; asm volatile("v_cvt_pk_bf16_f32 %0, %1, %2" : "=v"(r) : "v"(lo), "v"(hi)); return r; }
typedef float f32x2 __attribute__((ext_vector_type(2)));
constexpr float RMS_EPS_F = 1e-6f;
typedef unsigned u32x2 __attribute__((ext_vector_type(2)));
__device__ __forceinline__ float row_rstd4(const float* sq4, int row) {
    const f32x4 a = *(const f32x4*)(sq4 + (size_t)row * 4);
    return __builtin_amdgcn_rsqf(((a[0] + a[1]) + (a[2] + a[3])) * (1.0f / 1024.0f) + RMS_EPS_F);
}
__device__ __forceinline__ float row_rstd16(const float* sq16, int row) {
    const f32x4* p = (const f32x4*)(sq16 + (size_t)row * 16);
    const f32x4 a = p[0], b = p[1], c = p[2], d = p[3];
    const float s = ((a[0] + a[1]) + (a[2] + a[3])) + ((b[0] + b[1]) + (b[2] + b[3])) + ((c[0] + c[1]) + (c[2] + c[3])) + ((d[0] + d[1]) + (d[2] + d[3]));
    return __builtin_amdgcn_rsqf(s * (1.0f / 1024.0f) + RMS_EPS_F);
}
__device__ __forceinline__ float bf_lo(unsigned w) { return __builtin_bit_cast(float, w << 16); }
__device__ __forceinline__ float bf_hi(unsigned w) { return __builtin_bit_cast(float, w & 0xffff0000u); }
#ifndef PG8_WT
#define PG8_WT 1
#endif
__device__ __forceinline__ void st16(bf16_t* base, size_t elem_off, u32x4 v) {
#if PG8_WT
    __builtin_amdgcn_raw_buffer_store_b128(v, __builtin_amdgcn_make_buffer_rsrc((void*)base, (short)0, 0x7fffffff, 0x00020000), (unsigned)(elem_off * 2), 0, 16);
#else
    *(u32x4*)(base + elem_off) = v;
#endif
}
__device__ __forceinline__ float fast_sigmoid(float x) { return __builtin_amdgcn_rcpf(1.0f + __expf(-x)); }
struct EpiEvenIn {
    static constexpr bool PERM = true, AFTER_DRAIN = false;
    bf16_t* O; const float* sq16; float* gates; const float* bgate;
    __device__ __forceinline__ void operator()(const f32x4 (&acc)[2][2][4][2], const Unit& u, int wr, int wc, int fr, int fq) const {
        const int row0 = u.pm * BM + wr * 64 + fr;
        if (u.pn < 14) {
            const int col0 = u.pn * BM + wc * 32 + 8 * fq;
#pragma unroll
            for (int ai = 0; ai < 2; ++ai)
#pragma unroll
                for (int m = 0; m < 4; ++m) { const int row = row0 + ai * HALF + m * 16; const float r = row_rstd4(sq16, row); const size_t ro = (size_t)row * 3584 + col0;
#pragma unroll
                    for (int bj = 0; bj < 2; ++bj) { const f32x4 v0 = acc[ai][bj][m][0] * r, v1 = acc[ai][bj][m][1] * r;
                        u32x4 w; w.x = cvt_pk_bf16(v0[0], v0[1]); w.y = cvt_pk_bf16(v0[2], v0[3]); w.z = cvt_pk_bf16(v1[0], v1[1]); w.w = cvt_pk_bf16(v1[2], v1[3]);
                        st16(O, ro + bj * HALF, w); } }
        } else if (wc == 0 && fq == 0) {
            const f32x4 b0 = *(const f32x4*)(bgate), b1 = *(const f32x4*)(bgate + 4);
#pragma unroll
            for (int ai = 0; ai < 2; ++ai)
#pragma unroll
                for (int m = 0; m < 4; ++m) { const int row = row0 + ai * HALF + m * 16; const float r = row_rstd4(sq16, row);
                    *(f32x4*)(gates + (size_t)row * 8) = acc[ai][0][m][0] * r + b0; *(f32x4*)(gates + (size_t)row * 8 + 4) = acc[ai][0][m][1] * r + b1; }
        }
    }
};
struct EpiResid {
    static constexpr bool PERM = true, AFTER_DRAIN = false;
    bf16_t* xb; PG8_LAS float* sqs;
    __device__ __forceinline__ void operator()(const f32x4 (&acc)[2][2][4][2], const Unit& u, int wr, int wc, int fr, int fq) const {
        const int rl0 = wr * 64 + fr, col0 = u.pn * BM + wc * 32 + 8 * fq;
        const bf16_t* base = xb + (size_t)(u.pm * BM + rl0) * 1024 + col0;
        u32x4 o[2][4][2];
#pragma unroll
        for (int ai = 0; ai < 2; ++ai)
#pragma unroll
            for (int m = 0; m < 4; ++m)
#pragma unroll
                for (int bj = 0; bj < 2; ++bj) o[ai][m][bj] = *(const u32x4*)(base + (size_t)(ai * HALF + m * 16) * 1024 + bj * HALF);
#pragma unroll
        for (int ai = 0; ai < 2; ++ai)
#pragma unroll
            for (int m = 0; m < 4; ++m) { const int rl = rl0 + ai * HALF + m * 16; float ss = 0.f;
#pragma unroll
                for (int bj = 0; bj < 2; ++bj) { const u32x4 ov = o[ai][m][bj];
                    const f32x4 v0 = acc[ai][bj][m][0] + (f32x4){bf_lo(ov.x), bf_hi(ov.x), bf_lo(ov.y), bf_hi(ov.y)}, v1 = acc[ai][bj][m][1] + (f32x4){bf_lo(ov.z), bf_hi(ov.z), bf_lo(ov.w), bf_hi(ov.w)};
                    u32x4 w; w.x = cvt_pk_bf16(v0[0], v0[1]); w.y = cvt_pk_bf16(v0[2], v0[3]); w.z = cvt_pk_bf16(v1[0], v1[1]); w.w = cvt_pk_bf16(v1[2], v1[3]);
                    st16(xb, (size_t)(u.pm * BM + rl) * 1024 + col0 + bj * HALF, w);
                    ss += ((v0[0] * v0[0] + v0[1] * v0[1]) + (v0[2] * v0[2] + v0[3] * v0[3])) + ((v1[0] * v1[0] + v1[1] * v1[1]) + (v1[2] * v1[2] + v1[3] * v1[3])); }
                ss += __shfl_xor(ss, 16); ss += __shfl_xor(ss, 32);
                if (fq == 0) sqs[rl * 4 + wc] = ss; }
    }
};
struct EpiSwiGLU {
    static constexpr bool PERM = true, AFTER_DRAIN = false;
    bf16_t* O; const float* sq16;
    __device__ __forceinline__ void operator()(const f32x4 (&acc)[2][2][4][2], const Unit& u, int wr, int wc, int fr, int fq) const {
        const int row0 = u.pm * BM + wr * 64 + fr, col0 = u.pn * HALF + wc * 32 + 8 * fq;
        float rr[2][4];
#pragma unroll
        for (int ai = 0; ai < 2; ++ai)
#pragma unroll
            for (int m = 0; m < 4; ++m) rr[ai][m] = row_rstd4(sq16, row0 + ai * HALF + m * 16);
#pragma unroll
        for (int ai = 0; ai < 2; ++ai)
#pragma unroll
            for (int m = 0; m < 4; ++m) { const int row = row0 + ai * HALF + m * 16; const float r = rr[ai][m]; const float r2 = r * r, rl = r * -1.4426950408889634f;
                unsigned pk[4];
#pragma unroll
                for (int n = 0; n < 2; ++n)
#pragma unroll
                    for (int hh = 0; hh < 2; ++hh) { const f32x2 g = {acc[ai][0][m][n][2 * hh], acc[ai][0][m][n][2 * hh + 1]}, up = {acc[ai][1][m][n][2 * hh], acc[ai][1][m][n][2 * hh + 1]};
                        const f32x2 t = g * rl; f32x2 d; d.x = __builtin_amdgcn_exp2f(t.x); d.y = __builtin_amdgcn_exp2f(t.y); d = d + 1.0f;
                        f32x2 rc; rc.x = __builtin_amdgcn_rcpf(d.x); rc.y = __builtin_amdgcn_rcpf(d.y);
                        const f32x2 h = ((g * up) * r2) * rc; pk[2 * n + hh] = cvt_pk_bf16(h.x, h.y); }
                u32x4 w; w.x = pk[0]; w.y = pk[1]; w.z = pk[2]; w.w = pk[3];
                st16(O, (size_t)row * 2816 + col0, w); }
    }
};
struct EpiGeluZ {
    static constexpr bool PERM = true, AFTER_DRAIN = false;
    bf16_t* O; const float* sq16; float* vsq16;
    __device__ __forceinline__ void operator()(const f32x4 (&acc)[2][2][4][2], const Unit& u, int wr, int wc, int fr, int fq) const {
        const int row0 = u.pm * BM + wr * 64 + fr, col0 = u.pn * BM + wc * 32 + 8 * fq;
        constexpr float GA = -2.3022082f, GB = -0.10294324f;
        float rr[2][4];
#pragma unroll
        for (int ai = 0; ai < 2; ++ai)
#pragma unroll
            for (int m = 0; m < 4; ++m) rr[ai][m] = row_rstd4(sq16, row0 + ai * HALF + m * 16);
#pragma unroll
        for (int ai = 0; ai < 2; ++ai)
#pragma unroll
            for (int m = 0; m < 4; ++m) { const int row = row0 + ai * HALF + m * 16; const float r = rr[ai][m]; f32x2 ss = {0.f, 0.f};
#pragma unroll
                for (int bj = 0; bj < 2; ++bj) { unsigned pk[4];
#pragma unroll
                    for (int n = 0; n < 2; ++n)
#pragma unroll
                        for (int hh = 0; hh < 2; ++hh) { const f32x2 v = (f32x2){acc[ai][bj][m][n][2 * hh], acc[ai][bj][m][n][2 * hh + 1]} * r;
                            const f32x2 p = v * ((v * v) * GB + GA); f32x2 d; d.x = __builtin_amdgcn_exp2f(p.x); d.y = __builtin_amdgcn_exp2f(p.y); d = d + 1.0f;
                            f32x2 rc; rc.x = __builtin_amdgcn_rcpf(d.x); rc.y = __builtin_amdgcn_rcpf(d.y);
                            const f32x2 z = v * rc; ss = z * z + ss; pk[2 * n + hh] = cvt_pk_bf16(z.x, z.y); }
                    u32x4 w; w.x = pk[0]; w.y = pk[1]; w.z = pk[2]; w.w = pk[3];
                    st16(O, (size_t)row * 2048 + col0 + bj * HALF, w); }
                if (u.pn >= 4) { float s1 = ss.x + ss.y; s1 += __shfl_xor(s1, 16); s1 += __shfl_xor(s1, 32); if (fq == 0) vsq16[(size_t)row * 16 + (u.pn - 4) * 4 + wc] = s1; } }
    }
};
template <class Epi, class Sched, bool ALIGN_EPI = false, bool SP2 = false>
__device__ __forceinline__ void gemm_phase(PG8_LAS unsigned char* lds, const Gemm g, const Sched& S, const Epi& E) {
    int tid_ = threadIdx.x; asm volatile("" : "+v"(tid_)); const int tid = tid_, wid = __builtin_amdgcn_readfirstlane(tid >> 6), lane = tid & 63, wr = wid >> 2, wc = wid & 3, fr = lane & 15, fq = lane >> 4;
    const int K = g.K, nt = K / BK;
    unsigned voffA[2], voffB[2];
#pragma unroll
    for (int i = 0; i < 2; ++i) { int R, C; stage_rc(tid * 16 + i * 8192, R, C); const int Rb = Epi::PERM ? ((R & ~31) + perm32(R & 31)) : R;
        voffA[i] = (unsigned)(R * K + C) * 2u; voffB[i] = (unsigned)(Rb * K + C) * 2u; }
    const size_t kstep = (size_t)(BK * 2);
    const size_t hstep = (size_t)HALF * K * 2;
    const size_t tstep = 2 * hstep;
    const unsigned ldsw = (unsigned)wid * 1024u;
    const int aoff = lds_byte(wr * 64 + fr, fq * 8), boff = lds_byte(wc * 32 + fr, fq * 8);
#define PG8_SA(b, h) (((b) * 2 + (h)) * HTB)
#define PG8_SB(b, h) ((4 + (b) * 2 + (h)) * HTB)
#define PG8_STAGE(bufoff, gbase, voff) do { _Pragma("unroll") for (int _i = 0; _i < 2; ++_i) \
        __builtin_amdgcn_global_load_lds((const unsigned*)((const char*)(gbase) + (voff)[_i]), (PG8_LAS unsigned*)(lds + (bufoff) + ldsw + _i * 8192), 16, 0, 0); } while (0)
#define PG8_LDA(dst, b, h) do { _Pragma("unroll") for (int m = 0; m < 4; ++m) _Pragma("unroll") for (int k = 0; k < 2; ++k) dst[m][k] = *(const PG8_LAS bf16x8*)(lds + PG8_SA(b, h) + aoff + m * 2048 + k * 1024); } while (0)
#define PG8_LDB(dst, b, h) do { _Pragma("unroll") for (int n = 0; n < 2; ++n) _Pragma("unroll") for (int k = 0; k < 2; ++k) dst[n][k] = *(const PG8_LAS bf16x8*)(lds + PG8_SB(b, h) + boff + n * 2048 + k * 1024); } while (0)
#define PG8_MMA(ai, bj, At, Bt) do { __builtin_amdgcn_s_setprio(1); _Pragma("unroll") for (int m = 0; m < 4; ++m) _Pragma("unroll") for (int n = 0; n < 2; ++n) _Pragma("unroll") for (int k = 0; k < 2; ++k) \
        acc[ai][bj][m][n] = __builtin_amdgcn_mfma_f32_16x16x32_bf16(Bt[n][k], At[m][k], acc[ai][bj][m][n], 0, 0, 0); __builtin_amdgcn_s_setprio(0); } while (0)
#define PG8_WAIT_V(n) asm volatile("s_waitcnt vmcnt(" #n ")" ::: "memory")
#define PG8_WAIT_L(n) asm volatile("s_waitcnt lgkmcnt(" #n ")" ::: "memory")
#define PG8_BAR __builtin_amdgcn_s_barrier()
#define PG8_SCHED __builtin_amdgcn_sched_barrier(0)
    Unit cur, nxt; int ui = 0;
    if (!S.next(0, cur)) return;
    f32x4 acc[2][2][4][2];
#pragma unroll
    for (int a = 0; a < 2; ++a)
#pragma unroll
        for (int b = 0; b < 2; ++b)
#pragma unroll
            for (int m = 0; m < 4; ++m)
#pragma unroll
                for (int n = 0; n < 2; ++n) acc[a][b][m][n] = (f32x4){0.f, 0.f, 0.f, 0.f};
    bf16x8 At[4][2], B0[2][2], B1[2][2];
    const char* cA = (const char*)g.A + (size_t)cur.pm * tstep; const char* cB = (const char*)g.Bt + (size_t)cur.pn * tstep;
    S.a_ready(cur);
    if constexpr (SP2) {
        PG8_STAGE(PG8_SB(0, 0), cB, voffB); PG8_STAGE(PG8_SB(0, 1), cB + hstep, voffB); PG8_STAGE(PG8_SA(0, 0), cA, voffA); PG8_STAGE(PG8_SA(0, 1), cA + hstep, voffA);
        if (wr == 1) PG8_BAR;
        PG8_WAIT_V(2); PG8_BAR;
        PG8_STAGE(PG8_SB(1, 0), cB + kstep, voffB); PG8_STAGE(PG8_SA(1, 0), cA + kstep, voffA); PG8_STAGE(PG8_SB(1, 1), cB + hstep + kstep, voffB);
        PG8_WAIT_V(6); PG8_BAR;
    } else {
        PG8_STAGE(PG8_SB(0, 0), cB, voffB); PG8_STAGE(PG8_SA(0, 0), cA, voffA); PG8_STAGE(PG8_SB(0, 1), cB + hstep, voffB); PG8_STAGE(PG8_SA(0, 1), cA + hstep, voffA);
        if (wr == 1) PG8_BAR;
        PG8_WAIT_V(4); PG8_BAR;
        PG8_STAGE(PG8_SB(1, 0), cB + kstep, voffB); PG8_STAGE(PG8_SA(1, 0), cA + kstep, voffA); PG8_STAGE(PG8_SB(1, 1), cB + hstep + kstep, voffB);
        PG8_WAIT_V(6); PG8_BAR;
    }
    for (;;) {
        const bool has_next = S.next(ui + 1, nxt);
        const char* nA = has_next ? (const char*)g.A + (size_t)nxt.pm * tstep : cA; const char* nB = has_next ? (const char*)g.Bt + (size_t)nxt.pn * tstep : cB;
        for (int t = 0; t < nt; t += 2) {
            const bool last = (t == nt - 2);
            const char* a1 = cA + (size_t)(t + 1) * kstep;
            const char* a2 = last ? nA : cA + (size_t)(t + 2) * kstep; const char* b2 = last ? nB : cB + (size_t)(t + 2) * kstep;
            const char* a3 = a2 + kstep; const char* b3 = b2 + kstep;
            if (last && has_next) S.a_ready(nxt);
            if constexpr (SP2) {
            PG8_LDB(B0, 0, 0); PG8_LDB(B1, 0, 1); PG8_SCHED; PG8_LDA(At, 0, 0); PG8_STAGE(PG8_SA(1, 1), a1 + hstep, voffA);
            PG8_WAIT_V(8); PG8_WAIT_L(0); PG8_BAR; PG8_MMA(0, 0, At, B0); PG8_MMA(0, 1, At, B1); PG8_BAR; PG8_SCHED;
            PG8_LDA(At, 0, 1); PG8_STAGE(PG8_SB(0, 0), b2, voffB); PG8_STAGE(PG8_SB(0, 1), b2 + hstep, voffB); PG8_STAGE(PG8_SA(0, 0), a2, voffA);
            PG8_WAIT_V(8); PG8_WAIT_L(0); PG8_BAR; PG8_MMA(1, 0, At, B0); PG8_MMA(1, 1, At, B1); PG8_BAR; PG8_SCHED;
            PG8_LDB(B0, 1, 0); PG8_LDB(B1, 1, 1); PG8_SCHED; PG8_LDA(At, 1, 0); PG8_STAGE(PG8_SA(0, 1), a2 + hstep, voffA);
            PG8_WAIT_V(8); PG8_WAIT_L(0); PG8_BAR; PG8_MMA(0, 0, At, B0); PG8_MMA(0, 1, At, B1); PG8_BAR; PG8_SCHED;
            PG8_LDA(At, 1, 1); PG8_STAGE(PG8_SB(1, 0), b3, voffB); PG8_STAGE(PG8_SB(1, 1), b3 + hstep, voffB); PG8_STAGE(PG8_SA(1, 0), a3, voffA);
            PG8_WAIT_V(8); PG8_WAIT_L(0); PG8_BAR; PG8_MMA(1, 0, At, B0); PG8_MMA(1, 1, At, B1); PG8_BAR; PG8_SCHED;
            } else {
            PG8_LDB(B0, 0, 0); PG8_SCHED; PG8_LDA(At, 0, 0); PG8_STAGE(PG8_SA(1, 1), a1 + hstep, voffA);
            PG8_WAIT_L(8); PG8_BAR; PG8_WAIT_L(0); PG8_MMA(0, 0, At, B0); PG8_BAR; PG8_SCHED;
            PG8_LDB(B1, 0, 1); PG8_STAGE(PG8_SB(0, 0), b2, voffB);
            PG8_BAR; PG8_WAIT_L(0); PG8_MMA(0, 1, At, B1); PG8_BAR;
            PG8_LDA(At, 0, 1); PG8_STAGE(PG8_SA(0, 0), a2, voffA);
            PG8_BAR; PG8_WAIT_L(0); PG8_MMA(1, 0, At, B0); PG8_BAR; PG8_SCHED;
            PG8_STAGE(PG8_SB(0, 1), b2 + hstep, voffB);
            PG8_WAIT_V(6); PG8_BAR; PG8_MMA(1, 1, At, B1); PG8_BAR;
            PG8_LDB(B0, 1, 0); PG8_SCHED; PG8_LDA(At, 1, 0); PG8_STAGE(PG8_SA(0, 1), a2 + hstep, voffA);
            PG8_WAIT_L(8); PG8_BAR; PG8_WAIT_L(0); PG8_MMA(0, 0, At, B0); PG8_BAR; PG8_SCHED;
            PG8_LDB(B1, 1, 1); PG8_STAGE(PG8_SB(1, 0), b3, voffB);
            PG8_BAR; PG8_WAIT_L(0); PG8_MMA(0, 1, At, B1); PG8_BAR;
            PG8_LDA(At, 1, 1); PG8_STAGE(PG8_SA(1, 0), a3, voffA);
            PG8_BAR; PG8_WAIT_L(0); PG8_MMA(1, 0, At, B0); PG8_BAR; PG8_SCHED;
            PG8_STAGE(PG8_SB(1, 1), b3 + hstep, voffB);
            PG8_WAIT_V(6); PG8_BAR; PG8_MMA(1, 1, At, B1); PG8_BAR;
            }
        }
        if constexpr (ALIGN_EPI) { if (wr == 0) PG8_BAR; }
        if constexpr (!Epi::AFTER_DRAIN) { E(acc, cur, wr, wc, fr, fq); S.done(cur); }
        if (!has_next) break;
#pragma unroll
        for (int a = 0; a < 2; ++a)
#pragma unroll
            for (int b = 0; b < 2; ++b)
#pragma unroll
                for (int m = 0; m < 4; ++m)
#pragma unroll
                    for (int n = 0; n < 2; ++n) acc[a][b][m][n] = (f32x4){0.f, 0.f, 0.f, 0.f};
        cur = nxt; cA = nA; cB = nB; ++ui;
        if constexpr (ALIGN_EPI) { if (wr == 1) PG8_BAR; }
    }
    PG8_WAIT_V(0);
    if constexpr (!ALIGN_EPI) { if (wr == 0) PG8_BAR; }
    PG8_BAR;
    if constexpr (Epi::AFTER_DRAIN) { E.fused(acc, cur, wr, wc, fr, fq, lds, wid, lane); S.done(cur); }
#undef PG8_SA
#undef PG8_SB
#undef PG8_STAGE
#undef PG8_LDA
#undef PG8_LDB
#undef PG8_MMA
#undef PG8_WAIT_V
#undef PG8_WAIT_L
#undef PG8_BAR
#undef PG8_SCHED
}
}
constexpr int NWAVES = 8;
#ifndef MK_PER_PHASE
#define MK_PER_PHASE 0
#endif
constexpr int DM = 1024, NB = 2, SEQ = 8192, M = NB * SEQ, DEPTH = 4;
constexpr int CD = 512, HEADS = 4, HD = 128, MD = 512, EVEN_IN = 3592, EVEN_NP = 3840, EVEN_W = 3584, DFF = 2816, CHUNK = 128, NCH = SEQ / CHUNK, NUNIT = NB * HEADS * NCH;
constexpr float RMS_EPS = 1e-6f;
constexpr size_t MiB = 1u << 20;
constexpr size_t WS_CTL = 0, CTL_ZERO_BYTES = 1 * MiB;
constexpr size_t WS_SQ = 1 * MiB;
constexpr size_t WS_VSQ = 2 * MiB;
constexpr size_t WS_GATES = 3 * MiB;
constexpr size_t WS_NLOC = 4 * MiB;
constexpr size_t WS_NIN = 4 * MiB + 256 * 1024;
constexpr size_t WS_MLOC = 4 * MiB + 512 * 1024;
constexpr size_t WS_BL = WS_MLOC + 4096;
constexpr size_t WS_MIN = WS_BL + 4096;
constexpr size_t WS_WEI = 5 * MiB;
constexpr size_t WS_WEO = 20 * MiB;
constexpr size_t WS_WOI = 24 * MiB;
constexpr size_t WS_WOO = 32 * MiB;
constexpr size_t WS_WFI = 36 * MiB;
constexpr size_t WS_WFO = 80 * MiB;
constexpr size_t WS_XB = 102 * MiB;
constexpr size_t WS_Y = 134 * MiB;
constexpr size_t WS_BIG = 166 * MiB;
constexpr size_t WS_CLOC = 278 * MiB;
constexpr size_t WS_CIN = 310 * MiB;
constexpr size_t WS_END = 326 * MiB;
constexpr int CW_BAR = 4096;
constexpr int RING_BYTES = 131072;
constexpr int SQS_OFF = RING_BYTES;
constexpr int LDS_BYTES = 163840;
constexpr int LDSCTL_OFF = LDS_BYTES - 512, MISC_OFF = LDSCTL_OFF + 320;
constexpr int TSTR = 272;
constexpr int TILE_B = 128 * TSTR;
#define GAS __attribute__((address_space(1)))
#define LAS __attribute__((address_space(3)))
typedef unsigned short bf16;
typedef unsigned v4u __attribute__((ext_vector_type(4)));
typedef float f32x4 __attribute__((ext_vector_type(4)));
typedef short bf16x8 __attribute__((ext_vector_type(8)));
typedef GAS unsigned gu32;
typedef GAS unsigned long long gu64;
#define RLX_AGENT __ATOMIC_RELAXED, __HIP_MEMORY_SCOPE_AGENT
#define LDS_WAIT() asm volatile("s_waitcnt lgkmcnt(0)" ::: "memory")
#define VM_WAIT() asm volatile("s_waitcnt vmcnt(0)" ::: "memory")
__device__ __forceinline__ unsigned long long rt() { return __builtin_amdgcn_s_memrealtime(); }
__device__ __forceinline__ unsigned f2bf(float f) { unsigned u = __builtin_bit_cast(unsigned, f); return (u + 0x7fffu + ((u >> 16) & 1u)) >> 16; }
__device__ __forceinline__ unsigned pk2(float lo, float hi) { return f2bf(lo) | (f2bf(hi) << 16); }

#define XB_TMO      128
#define XB_XCNT(j)  (256  + 64 * (j))
#define XB_XSUB(j)  (1280 + 64 * (j))
#define XB_XGEN(j)  (2304 + 64 * (j))
#define XB_TOP      3328
#define XB_TOPGEN   3392
#define XCD_BAR_WORDS 3456
#define XB_SPIN_CAP (1u << 18)

__device__ __forceinline__ unsigned xb_ld(unsigned* p)              { return __hip_atomic_load(p, __ATOMIC_RELAXED, __HIP_MEMORY_SCOPE_AGENT); }
__device__ __forceinline__ unsigned xb_add(unsigned* p, unsigned v) { return __hip_atomic_fetch_add(p, v, __ATOMIC_RELAXED, __HIP_MEMORY_SCOPE_AGENT); }
__device__ __forceinline__ unsigned xb_xcc_id() { return (unsigned)__builtin_amdgcn_s_getreg((3 << 11) | 20) & 0xFu; }
#define XB_SPIN(cond, bar) do { unsigned _sp = 0; while (cond) { __builtin_amdgcn_s_sleep(1); \
    if ((++_sp & 255u) == 0u) { if (xb_ld(&(bar)[XB_TMO])) break; if (_sp > XB_SPIN_CAP) { atomicAdd(&(bar)[XB_TMO], 1u); break; } } } } while (0)

struct XcdBarrier {
    unsigned* bar; unsigned x;
    volatile LAS unsigned* st;
};

__device__ __forceinline__ XcdBarrier xcd_barrier_post(unsigned* bar, volatile LAS unsigned* st) {
    XcdBarrier b; b.bar = bar; b.x = xb_xcc_id(); b.st = st;
    if (threadIdx.x == 0) (void)xb_add(&bar[XB_XCNT(b.x)], 1u);
    return b;
}
__device__ __forceinline__ void xcd_barrier_complete(unsigned* bar, unsigned x, unsigned& nloc, unsigned& nx) {
    const unsigned G = gridDim.x * gridDim.y * gridDim.z;
    unsigned sum, cnt, mine, sp = 0u;
    for (;;) {
        sum = 0u; cnt = 0u; mine = 0u;
#pragma unroll
        for (unsigned j = 0; j < 16; ++j) { const unsigned c = xb_ld(&bar[XB_XCNT(j)]); sum += c; cnt += (c > 0u) ? 1u : 0u; mine = (j == x) ? c : mine; }
        if (sum == G) break;
        __builtin_amdgcn_s_sleep(1);
        if ((++sp & 255u) == 0u) { if (xb_ld(&bar[XB_TMO])) break; if (sp > XB_SPIN_CAP) { atomicAdd(&bar[XB_TMO], 1u); break; } }
    }
    nloc = mine > 0u ? mine : 1u; nx = cnt > 0u ? cnt : 1u;
}

__device__ __forceinline__ void xcd_barrier(const XcdBarrier& b) {
    asm volatile("s_waitcnt vmcnt(0)" ::: "memory");
    __syncthreads();
    if (threadIdx.x == 0) {
        unsigned* bar = b.bar;
        __builtin_amdgcn_s_waitcnt(0);
        unsigned nloc = b.st[0], nx = b.st[1];
        if (nloc == 0u) { xcd_barrier_complete(bar, b.x, nloc, nx); b.st[0] = nloc; b.st[1] = nx; }
        const unsigned old = xb_add(&bar[XB_XSUB(b.x)], 1u);
        const unsigned gen = old / nloc;
        if (old + 1u == (gen + 1u) * nloc) {
            __builtin_amdgcn_fence(__ATOMIC_RELEASE, "agent");
            asm volatile("s_waitcnt vmcnt(0)" ::: "memory");
            const unsigned og = xb_add(&bar[XB_TOP], 1u);
            const unsigned tg = og / nx;
            if (og + 1u == (tg + 1u) * nx) xb_add(&bar[XB_TOPGEN], 1u);
            else XB_SPIN(xb_ld(&bar[XB_TOPGEN]) == tg, bar);
            __builtin_amdgcn_fence(__ATOMIC_ACQUIRE, "agent");
            xb_add(&bar[XB_XGEN(b.x)], 1u);
            asm volatile("s_waitcnt vmcnt(0)" ::: "memory");
        } else {
            XB_SPIN(xb_ld(&bar[XB_XGEN(b.x)]) == gen, bar);
            __builtin_amdgcn_fence(__ATOMIC_ACQUIRE, "agent");
            asm volatile("s_waitcnt vmcnt(0)" ::: "memory");
        }
    }
    __syncthreads();
}
typedef unsigned u32x2 __attribute__((ext_vector_type(2)));
struct Frame {
    LAS unsigned char* lds;
    volatile LAS unsigned* MISC;
    gu32* ctl;
    int vcu, G;
    unsigned char* ws;
    const float* in[16];
    float* x;
};
#define OPQ_TID() int tid = threadIdx.x; asm volatile("" : "+v"(tid)); const int lane = tid & 63, w = __builtin_amdgcn_readfirstlane(tid >> 6), fr = lane & 15, fq = lane >> 4; (void)w; (void)fr; (void)fq
__device__ __forceinline__ float wave_sum(float v) {
#pragma unroll
    for (int o = 1; o < 64; o <<= 1) v += __shfl_xor(v, o);
    return v;
}
__device__ __forceinline__ float wave_max(float v) {
#pragma unroll
    for (int o = 1; o < 64; o <<= 1) v = fmaxf(v, __shfl_xor(v, o));
    return v;
}
__device__ __forceinline__ float bf2f(unsigned short h) { return __builtin_bit_cast(float, (unsigned)h << 16); }
__device__ __forceinline__ float logsig(float x) { return fminf(x, 0.f) - log1pf(expf(-fabsf(x))); }

__device__ __forceinline__ void cv_item(const float* W, int ldw, int K, int sc0, bf16* Bt, int dr0, int k0, const float* gain, float cs, LAS float* scr, int lane) {
    float v[32];
    const float* wp = W + (size_t)(k0 + (lane >> 5)) * ldw + sc0 + (lane & 31);
#pragma unroll
    for (int i = 0; i < 32; ++i) v[i] = wp[(size_t)(2 * i) * ldw];
#pragma unroll
    for (int i = 0; i < 32; ++i) scr[(2 * i + (lane >> 5)) * 33 + (lane & 31)] = v[i];
    LDS_WAIT(); asm volatile("" ::: "memory");
    const int c = lane & 7;
    f32x4 g0 = {cs, cs, cs, cs}, g1 = g0;
    if (gain) { g0 = *(const f32x4*)(gain + k0 + 8 * c) * cs; g1 = *(const f32x4*)(gain + k0 + 8 * c + 4) * cs; }
#pragma unroll
    for (int j = 0; j < 4; ++j) { const int n = (lane >> 3) + 8 * j; const LAS float* s = scr + (8 * c) * 33 + n;
        v4u o; o.x = pk2(s[0 * 33] * g0[0], s[1 * 33] * g0[1]); o.y = pk2(s[2 * 33] * g0[2], s[3 * 33] * g0[3]); o.z = pk2(s[4 * 33] * g1[0], s[5 * 33] * g1[1]); o.w = pk2(s[6 * 33] * g1[2], s[7 * 33] * g1[3]);
        *(GAS v4u*)(Bt + (size_t)(dr0 + n) * K + k0 + 8 * c) = o; }
    LDS_WAIT(); asm volatile("" ::: "memory");
}
__device__ __forceinline__ void convert_layer(Frame& F, int l, int wbase, int nw) {
    OPQ_TID();
    const int wi = wbase + w;
    LAS float* scr = (LAS float*)(F.lds + w * 16384);
    const int j = l >> 1; const bool odd = l & 1;
    const float* norm_mix = F.in[1] + (size_t)l * DM; const float* norm_ffn = F.in[2] + (size_t)l * DM;
    const int nbi = odd ? 64 : 112, I_MI = nbi * 16, I_MO = 32 * 16, I_FI = 176 * 16, I_FO = 32 * 44;
    const int N0 = I_MI, N1 = N0 + I_MO, N2 = N1 + I_FI, N3 = N2 + I_FO, NT = N3 + (odd ? 0 : 16);
    for (int it = wi; it < NT; it += nw) {
        if (it < N0) { const int kb = it / nbi, nb = it % nbi, c0 = 32 * nb;
            if (odd) cv_item(F.in[8] + (size_t)j * DM * 2048, 2048, DM, c0, (bf16*)(F.ws + WS_WOI) + (size_t)j * 2048 * DM, c0, 64 * kb, norm_mix, 1.0f, scr, lane);
            else cv_item(F.in[3] + (size_t)j * DM * EVEN_IN, EVEN_IN, DM, c0, (bf16*)(F.ws + WS_WEI) + (size_t)j * EVEN_NP * DM, c0, 64 * kb, norm_mix, (c0 >= 2048 && c0 < 2560) ? 0.08838834764831845f : 1.0f, scr, lane);
        } else if (it < N1) { const int r = it - N0, kb = r / 32, nb = r % 32;
            cv_item((odd ? F.in[12] : F.in[7]) + (size_t)j * DM * DM, DM, DM, 32 * nb, (bf16*)(F.ws + (odd ? WS_WOO : WS_WEO)) + (size_t)j * DM * DM, 32 * nb, 64 * kb, nullptr, 1.0f, scr, lane);
        } else if (it < N2) { const int r = it - N1, kb = r / 176, nb = r % 176, c0 = 32 * nb;
            const int up = c0 >= DFF, cc = up ? c0 - DFF : c0, dr = 256 * (cc >> 7) + (up ? 128 : 0) + (cc & 127);
            cv_item(F.in[13] + (size_t)l * DM * 2 * DFF, 2 * DFF, DM, c0, (bf16*)(F.ws + WS_WFI) + (size_t)l * 2 * DFF * DM, dr, 64 * kb, norm_ffn, 1.0f, scr, lane);
        } else if (it < N3) { const int r = it - N2, kb = r / 32, nb = r % 32;
            cv_item(F.in[14] + (size_t)l * DFF * DM, DM, DFF, 32 * nb, (bf16*)(F.ws + WS_WFO) + (size_t)l * DM * DFF, 32 * nb, 64 * kb, nullptr, 1.0f, scr, lane);
        } else { const int k0 = 64 * (it - N3);
            const float* W = F.in[3] + (size_t)j * DM * EVEN_IN; bf16* Bt = (bf16*)(F.ws + WS_WEI) + (size_t)j * EVEN_NP * DM;
#pragma unroll
            for (int e = 0; e < 8; ++e) { const int id = lane + 64 * e, col = id & 7, kk = k0 + (id >> 3);
                Bt[(size_t)(EVEN_W + col) * DM + kk] = (bf16)f2bf(W[(size_t)kk * EVEN_IN + EVEN_W + col] * norm_mix[kk]); }
        }
    }
}
__device__ __forceinline__ void p0_prologue(Frame& F, const float* xin) {
    OPQ_TID();
    const int gw = F.vcu * NWAVES + w, NGW = F.G * NWAVES;
    float* sq4 = (float*)(F.ws + WS_SQ); bf16* xb = (bf16*)(F.ws + WS_XB);
    for (int m = gw; m < M; m += 2 * NGW) {
        const int m1 = m + NGW;
        const GAS f32x4* xr0 = (const GAS f32x4*)(xin + (size_t)m * DM) + lane; const GAS f32x4* xr1 = (const GAS f32x4*)(xin + (size_t)m1 * DM) + lane;
        f32x4 v0[4], v1[4];
#pragma unroll
        for (int jj = 0; jj < 4; ++jj) { v0[jj] = xr0[64 * jj]; v1[jj] = xr1[64 * jj]; }
        GAS u32x2* bo0 = (GAS u32x2*)(xb + (size_t)m * DM) + lane; GAS u32x2* bo1 = (GAS u32x2*)(xb + (size_t)m1 * DM) + lane; float s0 = 0.f, s1 = 0.f;
#pragma unroll
        for (int jj = 0; jj < 4; ++jj) { u32x2 q; q.x = pk2(v0[jj].x, v0[jj].y); q.y = pk2(v0[jj].z, v0[jj].w); bo0[64 * jj] = q; s0 += (v0[jj].x * v0[jj].x + v0[jj].y * v0[jj].y) + (v0[jj].z * v0[jj].z + v0[jj].w * v0[jj].w);
            u32x2 p; p.x = pk2(v1[jj].x, v1[jj].y); p.y = pk2(v1[jj].z, v1[jj].w); bo1[64 * jj] = p; s1 += (v1[jj].x * v1[jj].x + v1[jj].y * v1[jj].y) + (v1[jj].z * v1[jj].z + v1[jj].w * v1[jj].w); }
        s0 = wave_sum(s0); s1 = wave_sum(s1);
        if (lane < 4) { sq4[(size_t)m * 4 + lane] = (lane == 0) ? s0 : 0.f; sq4[(size_t)m1 * 4 + lane] = (lane == 0) ? s1 : 0.f; }
    }
    convert_layer(F, 0, F.vcu * NWAVES, NGW);
}
__device__ __forceinline__ void final_norm(Frame& F) {
    OPQ_TID();
    const int gw = F.vcu * NWAVES + w, NGW = F.G * NWAVES;
    const float* sq4 = (const float*)(F.ws + WS_SQ); const float* gf = F.in[15]; const bf16* xb = (const bf16*)(F.ws + WS_XB);
    f32x4 g[4];
#pragma unroll
    for (int j = 0; j < 4; ++j) g[j] = ((const f32x4*)gf)[lane + 64 * j];
    for (int m = gw; m < M; m += NGW) {
        const float r = pg8::row_rstd4(sq4, m);
        GAS f32x4* xo = (GAS f32x4*)(F.x + (size_t)m * DM) + lane; const GAS u32x2* bi = (const GAS u32x2*)(xb + (size_t)m * DM) + lane;
#pragma unroll
        for (int j = 0; j < 4; ++j) { const u32x2 b = bi[64 * j]; f32x4 v = {pg8::bf_lo(b.x), pg8::bf_hi(b.x), pg8::bf_lo(b.y), pg8::bf_hi(b.y)}; v = v * r * g[j]; xo[64 * j] = v; }
    }
}
__device__ __forceinline__ void scan128_add(float& v0, float& v1, int lane) {
#pragma unroll
    for (int o = 1; o < 64; o <<= 1) { const float a = __shfl_up(v0, o), b = __shfl_up(v1, o); if (lane >= o) { v0 += a; v1 += b; } }
    v1 += __shfl(v0, 63);
}
__device__ __forceinline__ void scan128_max(float& v0, float& v1, int lane) {
#pragma unroll
    for (int o = 1; o < 64; o <<= 1) { const float a = __shfl_up(v0, o), b = __shfl_up(v1, o); if (lane >= o) { v0 = fmaxf(v0, a); v1 = fmaxf(v1, b); } }
    v1 = fmaxf(v1, __shfl(v0, 63));
}
struct Stg { v4u v[4]; };
__device__ __forceinline__ void stg_load_rows(Stg& s, const bf16* src, int ld, int tid) {
#pragma unroll
    for (int i = 0; i < 4; ++i) { const int id = tid + 512 * i, r = id >> 4, dc = id & 15; s.v[i] = *(const GAS v4u*)(src + (size_t)r * ld + 8 * dc); }
}
__device__ __forceinline__ void stg_store_rows(const Stg& s, LAS unsigned char* tile, int tid) {
#pragma unroll
    for (int i = 0; i < 4; ++i) { const int id = tid + 512 * i, r = id >> 4, dc = id & 15; *(LAS v4u*)(tile + r * TSTR + 16 * dc) = s.v[i]; }
}
__device__ __forceinline__ unsigned scale2(unsigned w, float f) { return pk2(pg8::bf_lo(w) * f, pg8::bf_hi(w) * f); }
__device__ __forceinline__ void stg_store_rows_scaled(const Stg& s, LAS unsigned char* tile, const float (&f)[4], int tid) {
#pragma unroll
    for (int i = 0; i < 4; ++i) { const int id = tid + 512 * i, r = id >> 4, dc = id & 15; v4u o; o.x = scale2(s.v[i].x, f[i]); o.y = scale2(s.v[i].y, f[i]); o.z = scale2(s.v[i].z, f[i]); o.w = scale2(s.v[i].w, f[i]);
        *(LAS v4u*)(tile + r * TSTR + 16 * dc) = o; }
}
typedef short s16x4 __attribute__((ext_vector_type(4)));
__device__ __forceinline__ bf16x8 tr_frag(LAS unsigned char* tile, int trb, int cb, int ks) {
    const s16x4 lo = __builtin_amdgcn_ds_read_tr16_b64_v4i16((LAS s16x4*)(tile + trb + ks * 32 * TSTR + cb * 32));
    const s16x4 hi = __builtin_amdgcn_ds_read_tr16_b64_v4i16((LAS s16x4*)(tile + trb + ks * 32 * TSTR + 4 * TSTR + cb * 32));
    return (bf16x8){lo[0], lo[1], lo[2], lo[3], hi[0], hi[1], hi[2], hi[3]};
}
#define TRB(lane) ((8 * ((lane) >> 4) + (((lane) & 15) >> 2)) * TSTR + 8 * ((lane) & 3))
#define FRAG(tile, row, kk, fq) (*(const LAS bf16x8*)((tile) + (row) * TSTR + (32 * (kk) + 8 * (fq)) * 2))

__device__ __forceinline__ void mlstm_phase_a(Frame& F) {
    LAS unsigned char* TK = F.lds; LAS unsigned char* TV = F.lds + TILE_B; LAS float* aS = (LAS float*)(F.lds + 2 * TILE_B); LAS float* nP = aS + 128;
    const bf16* proj = (const bf16*)(F.ws + WS_BIG); const float* gates = (const float*)(F.ws + WS_GATES);
    float* Cloc = (float*)(F.ws + WS_CLOC); float* nloc = (float*)(F.ws + WS_NLOC); float* mloc = (float*)(F.ws + WS_MLOC); float* bLv = (float*)(F.ws + WS_BL);
    for (int u = F.vcu; u < NUNIT; u += F.G) {
        OPQ_TID();
        const int bh = u >> 6, c = u & 63, b = bh >> 2, h = bh & 3, row0 = b * SEQ + c * CHUNK;
        if (w == 0) {
            const float i0 = gates[(size_t)(row0 + lane) * 8 + h], i1 = gates[(size_t)(row0 + lane + 64) * 8 + h];
            float b0 = logsig(gates[(size_t)(row0 + lane) * 8 + 4 + h]), b1 = logsig(gates[(size_t)(row0 + lane + 64) * 8 + 4 + h]);
            scan128_add(b0, b1, lane);
            const float bL = __shfl(b1, 63);
            const float w0 = bL - b0 + i0, w1 = bL - b1 + i1;
            const float ml = wave_max(fmaxf(w0, w1));
            aS[lane] = __expf(w0 - ml); aS[lane + 64] = __expf(w1 - ml);
            if (lane == 0) { mloc[u] = ml; bLv[u] = bL; }
        }
        Stg sk, sv;
        stg_load_rows(sk, proj + (size_t)row0 * EVEN_W + 2048 + h * HD, EVEN_W, tid); stg_load_rows(sv, proj + (size_t)row0 * EVEN_W + 2560 + h * HD, EVEN_W, tid);
        __syncthreads();
        { float fa[4];
#pragma unroll
          for (int i = 0; i < 4; ++i) fa[i] = aS[(tid >> 4) + 32 * i];
          stg_store_rows_scaled(sk, TK, fa, tid); }
        stg_store_rows(sv, TV, tid);
        __syncthreads();
        {
            const int d = tid & 127, q = tid >> 7; float s = 0.f;
#pragma unroll 8
            for (int i = 0; i < 32; ++i) s += bf2f(*(const LAS unsigned short*)(TK + (32 * q + i) * TSTR + 2 * d));
            nP[q * 128 + d] = s;
        }
        const int trb = TRB(lane);
        bf16x8 vf[4];
#pragma unroll
        for (int kk = 0; kk < 4; ++kk) vf[kk] = tr_frag(TV, trb, w, kk);
#pragma unroll
        for (int db = 0; db < 8; ++db) { f32x4 acc = {0.f, 0.f, 0.f, 0.f};
#pragma unroll
            for (int kk = 0; kk < 4; ++kk) acc = __builtin_amdgcn_mfma_f32_16x16x32_bf16(tr_frag(TK, trb, db, kk), vf[kk], acc, 0, 0, 0);
            *(GAS f32x4*)(Cloc + (size_t)u * (HD * HD) + (size_t)(16 * w + fr) * HD + 16 * db + 4 * fq) = acc; }
        __syncthreads();
        if (tid < 128) nloc[(size_t)u * HD + tid] = (nP[tid] + nP[128 + tid]) + (nP[256 + tid] + nP[384 + tid]);
    }
}
__device__ __forceinline__ void mlstm_scan_and_conv(Frame& F, const float* wconv) {
    OPQ_TID();
    const float* Cloc = (const float*)(F.ws + WS_CLOC); const float* nloc = (const float*)(F.ws + WS_NLOC); const float* mloc = (const float*)(F.ws + WS_MLOC); const float* bLv = (const float*)(F.ws + WS_BL);
    bf16* Cin = (bf16*)(F.ws + WS_CIN); float* nin = (float*)(F.ws + WS_NIN); float* minv = (float*)(F.ws + WS_MIN);
    LAS float* alS = (LAS float*)F.lds; LAS float* beS = alS + 64;
    for (int v = F.vcu; v < NB * HEADS * 32; v += F.G) {
        const int bh = v >> 5, part = v & 31, idx = part * 512 + tid;
        float cl[64];
#pragma unroll
        for (int c = 0; c < 64; ++c) cl[c] = Cloc[(size_t)(bh * NCH + c) * (HD * HD) + idx];
        if (w == 0) {
            const float ml = mloc[bh * NCH + lane], bl = bLv[bh * NCH + lane]; float m = 0.f, al = 0.f, be = 0.f, mi = 0.f;
            for (int c = 0; c < 64; ++c) { const float mlc = __shfl(ml, c), blc = __shfl(bl, c); const float mn = fmaxf(blc + m, mlc);
                if (lane == c) { al = __expf(blc + m - mn); be = __expf(mlc - mn); mi = m; } m = mn; }
            alS[lane] = al; beS[lane] = be; if (part == 0) minv[bh * NCH + lane] = mi;
        }
        __syncthreads();
        float C = 0.f;
#pragma unroll
        for (int c = 0; c < 64; ++c) { Cin[(size_t)(bh * NCH + c) * (HD * HD) + idx] = (bf16)f2bf(C); C = alS[c] * C + beS[c] * cl[c]; }
        if (part == 0 && tid < 128) { float n = 0.f;
#pragma unroll 8
            for (int c = 0; c < 64; ++c) { nin[(size_t)(bh * NCH + c) * HD + tid] = n; n = alS[c] * n + beS[c] * nloc[(size_t)(bh * NCH + c) * HD + tid]; } }
        __syncthreads();
    }
    const bf16* proj = (const bf16*)(F.ws + WS_BIG); bf16* Y = (bf16*)(F.ws + WS_Y);
    for (int g = F.vcu * 512 + tid; g < (M / 8) * (CD / 8); g += F.G * 512) {
        const int t0 = (g >> 6) * 8, c8 = (g & 63) * 8; const bool first = (t0 & (SEQ - 1)) == 0;
        v4u cg[10], xa[10], bg[8];
#pragma unroll
        for (int i = 0; i < 10; ++i) { const int t = (first && i < 2) ? t0 : t0 - 2 + i; const bf16* p = proj + (size_t)t * EVEN_W; cg[i] = *(const GAS v4u*)(p + CD + c8); xa[i] = *(const GAS v4u*)(p + 2 * CD + c8); }
#pragma unroll
        for (int i = 0; i < 8; ++i) bg[i] = *(const GAS v4u*)(proj + (size_t)(t0 + i) * EVEN_W + c8);
        float wc[3][8];
#pragma unroll
        for (int jj = 0; jj < 3; ++jj) { const f32x4 a = *(const f32x4*)(wconv + jj * CD + c8), b = *(const f32x4*)(wconv + jj * CD + c8 + 4);
            wc[jj][0] = a[0]; wc[jj][1] = a[1]; wc[jj][2] = a[2]; wc[jj][3] = a[3]; wc[jj][4] = b[0]; wc[jj][5] = b[1]; wc[jj][6] = b[2]; wc[jj][7] = b[3]; }
        float z[10][8];
#pragma unroll
        for (int i = 0; i < 10; ++i) { const unsigned cw[4] = {cg[i].x, cg[i].y, cg[i].z, cg[i].w}, xw[4] = {xa[i].x, xa[i].y, xa[i].z, xa[i].w}; const float msk = (first && i < 2) ? 0.f : 1.f;
#pragma unroll
            for (int j = 0; j < 4; ++j) { z[i][2 * j] = msk * pg8::bf_lo(cw[j]) * pg8::bf_lo(xw[j]); z[i][2 * j + 1] = msk * pg8::bf_hi(cw[j]) * pg8::bf_hi(xw[j]); } }
#pragma unroll
        for (int i = 0; i < 8; ++i) { const unsigned bw[4] = {bg[i].x, bg[i].y, bg[i].z, bg[i].w}; unsigned ow[4];
#pragma unroll
            for (int j = 0; j < 4; ++j) { const float a0 = wc[0][2 * j] * z[i][2 * j] + wc[1][2 * j] * z[i + 1][2 * j] + wc[2][2 * j] * z[i + 2][2 * j];
                const float a1 = wc[0][2 * j + 1] * z[i][2 * j + 1] + wc[1][2 * j + 1] * z[i + 1][2 * j + 1] + wc[2][2 * j + 1] * z[i + 2][2 * j + 1];
                ow[j] = pk2(pg8::bf_lo(bw[j]) * a0, pg8::bf_hi(bw[j]) * a1); }
            v4u o; o.x = ow[0]; o.y = ow[1]; o.z = ow[2]; o.w = ow[3];
            *(GAS v4u*)(Y + (size_t)(t0 + i) * DM + c8) = o; }
    }
}
__device__ __forceinline__ void mlstm_phase_c(Frame& F, const float* ghead) {
    LAS unsigned char* TK = F.lds; LAS unsigned char* TV = F.lds + TILE_B; LAS unsigned char* TC = F.lds + 2 * TILE_B; LAS unsigned char* TS = F.lds + 3 * TILE_B;
    LAS float* gS = (LAS float*)(F.lds + 4 * TILE_B); LAS float* mxS = gS + 128; LAS float* bS = gS + 256; LAS float* nS = gS + 384;
    const bf16* proj = (const bf16*)(F.ws + WS_BIG); const float* gates = (const float*)(F.ws + WS_GATES);
    const bf16* Cin = (const bf16*)(F.ws + WS_CIN); const float* nin = (const float*)(F.ws + WS_NIN); const float* minv = (const float*)(F.ws + WS_MIN);
    bf16* Y = (bf16*)(F.ws + WS_Y);
    for (int u = F.vcu; u < NUNIT; u += F.G) {
        OPQ_TID();
        const int bh = u >> 6, c = u & 63, b = bh >> 2, h = bh & 3, row0 = b * SEQ + c * CHUNK;
        const float m_in = minv[u];
        if (w == 0) {
            const float i0 = gates[(size_t)(row0 + lane) * 8 + h], i1 = gates[(size_t)(row0 + lane + 64) * 8 + h];
            float b0 = logsig(gates[(size_t)(row0 + lane) * 8 + 4 + h]), b1 = logsig(gates[(size_t)(row0 + lane + 64) * 8 + 4 + h]);
            scan128_add(b0, b1, lane);
            const float g0 = i0 - b0, g1 = i1 - b1; float p0 = g0, p1 = g1;
            scan128_max(p0, p1, lane);
            gS[lane] = g0; gS[lane + 64] = g1; mxS[lane] = fmaxf(m_in, p0); mxS[lane + 64] = fmaxf(m_in, p1); bS[lane] = b0; bS[lane + 64] = b1;
        } else if (w == 1) { nS[lane] = nin[(size_t)u * HD + lane]; nS[lane + 64] = nin[(size_t)u * HD + lane + 64]; }
        const int t = 16 * w + fr;
        bf16x8 qf[4];
#pragma unroll
        for (int kk = 0; kk < 4; ++kk) qf[kk] = *(const GAS bf16x8*)(proj + (size_t)(row0 + t) * EVEN_W + 1536 + h * HD + 32 * kk + 8 * fq);
        Stg sk, sc, sv;
        stg_load_rows(sk, proj + (size_t)row0 * EVEN_W + 2048 + h * HD, EVEN_W, tid); stg_load_rows(sc, Cin + (size_t)u * (HD * HD), HD, tid); stg_load_rows(sv, proj + (size_t)row0 * EVEN_W + 2560 + h * HD, EVEN_W, tid);
        u32x2 ovv[8];
#pragma unroll
        for (int eb = 0; eb < 8; ++eb) ovv[eb] = *(const GAS u32x2*)(proj + (size_t)(row0 + t) * EVEN_W + 3072 + h * HD + 16 * eb + 4 * fq);
        stg_store_rows(sk, TK, tid);
        stg_store_rows(sc, TC, tid);
        stg_store_rows(sv, TV, tid);
        const int trb = TRB(lane);
        __syncthreads();
        const float mx_t = mxS[t], b_t = bS[t], inter = __expf(m_in - mx_t);
        float den1 = 0.f;
#pragma unroll
        for (int sb = 0; sb < 8; ++sb) {
            u32x2 pk = {0u, 0u};
            if (sb <= w) { f32x4 acc = {0.f, 0.f, 0.f, 0.f};
#pragma unroll
                for (int kk = 0; kk < 4; ++kk) acc = __builtin_amdgcn_mfma_f32_16x16x32_bf16(FRAG(TK, 16 * sb + fr, kk, fq), qf[kk], acc, 0, 0, 0);
                float sv[4];
#pragma unroll
                for (int r = 0; r < 4; ++r) { const int s = 16 * sb + 4 * fq + r; const float e = __expf(gS[s] - mx_t); sv[r] = (s <= t) ? acc[r] * e : 0.f; den1 += sv[r]; }
                pk.x = pk2(sv[0], sv[1]); pk.y = pk2(sv[2], sv[3]); }
            *(LAS u32x2*)(TS + t * TSTR + (16 * sb + 4 * fq) * 2) = pk;
        }
        den1 += __shfl_xor(den1, 16); den1 += __shfl_xor(den1, 32);
        float qn = 0.f;
#pragma unroll
        for (int kk = 0; kk < 4; ++kk)
#pragma unroll
            for (int j = 0; j < 8; ++j) qn += bf2f((unsigned short)qf[kk][j]) * nS[32 * kk + 8 * fq + j];
        qn += __shfl_xor(qn, 16); qn += __shfl_xor(qn, 32);
        const float den = den1 + inter * qn, m_t = b_t + mx_t;
        const float rden = 1.0f / fmaxf(fabsf(den), __expf(-m_t));
        bf16x8 sf[4];
#pragma unroll
        for (int kk = 0; kk < 4; ++kk) sf[kk] = FRAG(TS, t, kk, fq);
        float hh[32]; float ssq = 0.f;
#pragma unroll
        for (int eb = 0; eb < 8; ++eb) { f32x4 a1 = {0.f, 0.f, 0.f, 0.f}, a2 = {0.f, 0.f, 0.f, 0.f};
#pragma unroll
            for (int kk = 0; kk < 4; ++kk) { if (2 * kk <= w) a1 = __builtin_amdgcn_mfma_f32_16x16x32_bf16(tr_frag(TV, trb, eb, kk), sf[kk], a1, 0, 0, 0);
                a2 = __builtin_amdgcn_mfma_f32_16x16x32_bf16(FRAG(TC, 16 * eb + fr, kk, fq), qf[kk], a2, 0, 0, 0); }
#pragma unroll
            for (int r = 0; r < 4; ++r) { const float v = (a1[r] + inter * a2[r]) * rden; hh[4 * eb + r] = v; ssq += v * v; } }
        ssq += __shfl_xor(ssq, 16); ssq += __shfl_xor(ssq, 32);
        const float rs = __builtin_amdgcn_rsqf(ssq * (1.0f / 128.0f) + RMS_EPS);
#pragma unroll
        for (int eb = 0; eb < 8; ++eb) { const int e = 16 * eb + 4 * fq;
            const u32x2 ov = ovv[eb]; const f32x4 gh = *(const f32x4*)(ghead + h * HD + e);
            const float o0 = bf2f((unsigned short)(ov.x & 0xffffu)), o1 = bf2f((unsigned short)(ov.x >> 16)), o2 = bf2f((unsigned short)(ov.y & 0xffffu)), o3 = bf2f((unsigned short)(ov.y >> 16));
            u32x2 y; y.x = pk2(pg8::fast_sigmoid(o0) * hh[4 * eb] * rs * gh[0], pg8::fast_sigmoid(o1) * hh[4 * eb + 1] * rs * gh[1]);
            y.y = pk2(pg8::fast_sigmoid(o2) * hh[4 * eb + 2] * rs * gh[2], pg8::fast_sigmoid(o3) * hh[4 * eb + 3] * rs * gh[3]);
            *(GAS u32x2*)(Y + (size_t)(row0 + t) * DM + MD + h * HD + e) = y; }
        __syncthreads();
    }
}
__device__ __forceinline__ void sgu_phase(Frame& F, const float* gv, const float* wsp, const float* bsp) {
    LAS unsigned char* TW = F.lds; LAS unsigned char* TV = F.lds + TILE_B;
    const bf16* Z = (const bf16*)(F.ws + WS_BIG); const float* vsq16 = (const float*)(F.ws + WS_VSQ); bf16* Y = (bf16*)(F.ws + WS_Y);
    for (int v = F.vcu; v < 256; v += F.G) {
        OPQ_TID();
        const int g = v & 7, cb0 = (v >> 3) * 4;
#pragma unroll
        for (int i = 0; i < 8; ++i) { const int id = tid + 512 * i, t = id >> 5, s4 = (id & 31) * 4;
            const f32x4 wv = *(const f32x4*)(wsp + ((size_t)g * CHUNK + t) * CHUNK + s4);
            u32x2 pk; pk.x = pk2(s4 <= t ? wv[0] : 0.f, s4 + 1 <= t ? wv[1] : 0.f); pk.y = pk2(s4 + 2 <= t ? wv[2] : 0.f, s4 + 3 <= t ? wv[3] : 0.f);
            *(LAS u32x2*)(TW + t * TSTR + s4 * 2) = pk; }
        const int t = 16 * w + fr, trb = TRB(lane);
        const float bst = bsp[g * CHUNK + t];
        f32x4 gvv[8];
#pragma unroll
        for (int db = 0; db < 8; ++db) gvv[db] = *(const f32x4*)(gv + g * 128 + 16 * db + 4 * fq);
        for (int ci = 0; ci < 4; ++ci) {
            const int row0 = (cb0 + ci) * CHUNK;
            Stg sv; stg_load_rows(sv, Z + (size_t)row0 * 2048 + 1024 + g * 128, 2048, tid);
            float rs[4];
#pragma unroll
            for (int i = 0; i < 4; ++i) rs[i] = pg8::row_rstd16(vsq16, row0 + (tid >> 4) + 32 * i);
            u32x2 uv[8];
#pragma unroll
            for (int db = 0; db < 8; ++db) uv[db] = *(const GAS u32x2*)(Z + (size_t)(row0 + t) * 2048 + g * 128 + 16 * db + 4 * fq);
            stg_store_rows_scaled(sv, TV, rs, tid);
            __syncthreads();
            bf16x8 wf[4];
#pragma unroll
            for (int kk = 0; kk < 4; ++kk) wf[kk] = FRAG(TW, t, kk, fq);
#pragma unroll
            for (int db = 0; db < 8; ++db) { f32x4 acc = {0.f, 0.f, 0.f, 0.f};
#pragma unroll
                for (int kk = 0; kk < 4; ++kk) if (2 * kk <= w) acc = __builtin_amdgcn_mfma_f32_16x16x32_bf16(tr_frag(TV, trb, db, kk), wf[kk], acc, 0, 0, 0);
                const int col = g * 128 + 16 * db + 4 * fq;
                u32x2 y; y.x = pk2(pg8::bf_lo(uv[db].x) * (acc[0] * gvv[db][0] + bst), pg8::bf_hi(uv[db].x) * (acc[1] * gvv[db][1] + bst));
                y.y = pk2(pg8::bf_lo(uv[db].y) * (acc[2] * gvv[db][2] + bst), pg8::bf_hi(uv[db].y) * (acc[3] * gvv[db][3] + bst));
                *(GAS u32x2*)(Y + (size_t)(row0 + t) * DM + col) = y; }
            __syncthreads();
        }
    }
}
#ifndef PROBE_MASK
#define PROBE_MASK 0
#endif
#ifndef TPROBE_KIND
#define TPROBE_KIND (-1)
#endif
#ifndef TPROBE_MODE
#define TPROBE_MODE 2
#endif
struct Args { const float* in[16]; float* out; unsigned char* ws; int ph_lo, ph_hi; };
constexpr int N_PHASES = 26;
enum Kind { K_P0, K_E1, K_E2, K_E3, K_E4, K_RESMIX, K_F1, K_RESFFN, K_O1, K_O2, K_FINAL };
__device__ __forceinline__ void decode_phase(int p, int& kind, int& layer) {
    if (p == 0) { kind = K_P0; layer = 0; return; }
    if (p == 25) { kind = K_FINAL; layer = 0; return; }
    int q = p - 1; const int pair = q / 12; q -= pair * 12;
    if (q < 7) { layer = 2 * pair; kind = q == 0 ? K_E1 : q == 1 ? K_E2 : q == 2 ? K_E3 : q == 3 ? K_E4 : q == 4 ? K_RESMIX : q == 5 ? K_F1 : K_RESFFN; }
    else { layer = 2 * pair + 1; q -= 7; kind = q == 0 ? K_O1 : q == 1 ? K_O2 : q == 2 ? K_RESMIX : q == 3 ? K_F1 : K_RESFFN; }
}
__global__ void __launch_bounds__(NWAVES * 64, 2) trunk_fwd(Args args) {
    extern __shared__ __attribute__((aligned(16))) unsigned char lds[];
    Frame F;
    F.lds = (LAS unsigned char*)lds;
    F.MISC = (volatile LAS unsigned*)(F.lds + MISC_OFF);
    F.G = gridDim.x; { const int bx = blockIdx.x; F.vcu = (F.G % 8 == 0) ? (bx % 8) * (F.G / 8) + bx / 8 : bx; }
    F.ws = args.ws; F.ctl = (gu32*)(args.ws + WS_CTL); F.x = args.out;
#pragma unroll
    for (int i = 0; i < 16; ++i) F.in[i] = args.in[i];
    for (int u = threadIdx.x; u < (LDS_BYTES - LDSCTL_OFF) / 4; u += NWAVES * 64) ((LAS unsigned*)(F.lds + LDSCTL_OFF))[u] = 0u;
    __syncthreads();
    XcdBarrier bar; bar.bar = (unsigned*)(F.ctl + CW_BAR); bar.x = 0; bar.st = nullptr;
    if (!MK_PER_PHASE) bar = xcd_barrier_post((unsigned*)(F.ctl + CW_BAR), F.MISC + 8);
    bf16* xb = (bf16*)(F.ws + WS_XB); bf16* Yb = (bf16*)(F.ws + WS_Y); bf16* big = (bf16*)(F.ws + WS_BIG);
    float* sq16 = (float*)(F.ws + WS_SQ);
    unsigned long long tpacc = 0;
    for (int p = args.ph_lo; p < args.ph_hi; ++p) {
        int kind, layer; decode_phase(p, kind, layer);
        const int j = layer >> 1;
        const int reps = ((PROBE_MASK >> kind) & 1) ? 2 : 1;
        unsigned long long tp0 = 0, tp1 = 0; if (TPROBE_KIND >= 0) tp0 = (TPROBE_MODE == 3) ? __builtin_amdgcn_s_memtime() : __builtin_amdgcn_s_memrealtime();
        for (int rep = 0; rep < reps; ++rep) {
        if (kind == K_P0) { p0_prologue(F, F.in[0]); }
        else if (kind == K_E1) {
            pg8::Gemm g{xb, (const bf16*)(F.ws + WS_WEI) + (size_t)j * EVEN_NP * DM, M, EVEN_NP, DM}; pg8::StaticOrder S; S.init(M, EVEN_NP, F.G, (int)blockIdx.x);
            pg8::EpiEvenIn E{big, sq16, (float*)(F.ws + WS_GATES), F.in[5] + (size_t)j * 8};
            pg8::gemm_phase<pg8::EpiEvenIn, pg8::StaticOrder, true, true>(F.lds, g, S, E);
        }
        else if (kind == K_E2) { mlstm_phase_a(F); }
        else if (kind == K_E3) { mlstm_scan_and_conv(F, F.in[4] + (size_t)j * 3 * CD); }
        else if (kind == K_E4) { mlstm_phase_c(F, F.in[6] + (size_t)j * MD); }
        else if (kind == K_RESMIX || kind == K_RESFFN) {
            const bool ffn = kind == K_RESFFN, odd = layer & 1;
            const bf16* A = ffn ? big : Yb;
            const bf16* Bt = ffn ? (const bf16*)(F.ws + WS_WFO) + (size_t)layer * DM * DFF : odd ? (const bf16*)(F.ws + WS_WOO) + (size_t)j * DM * DM : (const bf16*)(F.ws + WS_WEO) + (size_t)j * DM * DM;
            pg8::Gemm g{A, Bt, M, DM, ffn ? DFF : DM}; pg8::StaticOrder S; S.init(M, DM, F.G, (int)blockIdx.x);
            pg8::EpiResid E{xb, (LAS float*)(F.lds + SQS_OFF)};
            pg8::gemm_phase<pg8::EpiResid, pg8::StaticOrder, false, true>(F.lds, g, S, E);
            __syncthreads();
            { OPQ_TID(); (void)lane; pg8::Unit u0; if (S.next(0, u0) && tid < 256) { const f32x4 q = *(const LAS f32x4*)(F.lds + SQS_OFF + tid * 16);
                sq16[(size_t)(u0.pm * 256 + tid) * 4 + u0.pn] = (q[0] + q[1]) + (q[2] + q[3]); } }
        }
        else if (kind == K_F1) {
            pg8::Gemm g{xb, (const bf16*)(F.ws + WS_WFI) + (size_t)layer * 2 * DFF * DM, M, 2 * DFF, DM}; pg8::StaticOrder S; S.init(M, 2 * DFF, F.G, (int)blockIdx.x);
            pg8::EpiSwiGLU E{big, sq16};
            pg8::gemm_phase<pg8::EpiSwiGLU, pg8::StaticOrder, true, true>(F.lds, g, S, E);
            if (layer + 1 < DEPTH && rep == 0 && blockIdx.x >= 128) { __syncthreads(); convert_layer(F, layer + 1, ((int)blockIdx.x - 128) * NWAVES, (F.G - 128) * NWAVES); }
        }
        else if (kind == K_O1) {
            pg8::Gemm g{xb, (const bf16*)(F.ws + WS_WOI) + (size_t)j * 2048 * DM, M, 2048, DM}; pg8::StaticOrder S; S.init(M, 2048, F.G, (int)blockIdx.x);
            pg8::EpiGeluZ E{big, sq16, (float*)(F.ws + WS_VSQ)};
            pg8::gemm_phase<pg8::EpiGeluZ, pg8::StaticOrder, true, true>(F.lds, g, S, E);
        }
        else if (kind == K_O2) { sgu_phase(F, F.in[9] + (size_t)j * DM, F.in[10] + (size_t)j * 8 * CHUNK * CHUNK, F.in[11] + (size_t)j * 8 * CHUNK); }
        else { final_norm(F); }
        if (rep + 1 < reps) xcd_barrier(bar);
        }
        if (TPROBE_KIND >= 0) tp1 = (TPROBE_MODE == 3) ? __builtin_amdgcn_s_memtime() : __builtin_amdgcn_s_memrealtime();
        if (p + 1 < args.ph_hi) xcd_barrier(bar);
        if (TPROBE_KIND >= 0) { const unsigned long long tp2 = __builtin_amdgcn_s_memrealtime(); if (kind == TPROBE_KIND || TPROBE_KIND == 99) tpacc += (TPROBE_MODE == 0) ? (tp1 - tp0) : (TPROBE_MODE == 1) ? (tp2 - tp1) : (TPROBE_MODE == 3) ? ((tp1 - tp0) >> 7) : (tp2 - tp0); }
    }
    if (TPROBE_KIND >= 0 && blockIdx.x == 0 && threadIdx.x == 0) { const unsigned long long t0 = __builtin_amdgcn_s_memrealtime(); while (__builtin_amdgcn_s_memrealtime() - t0 < 8ull * tpacc) __builtin_amdgcn_s_sleep(8); }
}

extern "C" void kernel_launch(void* const* d_in, const int* in_sizes, int n_in, void* d_out, int out_size, void* d_ws, size_t ws_size, hipStream_t stream) {
    static int grid = 0;
    if (grid == 0) {
        if (n_in != 16 || in_sizes[0] != M * DM || out_size != M * DM || ws_size < WS_END) { fprintf(stderr, "kernel_launch: unexpected shapes / workspace (n_in %d, ws %zu < %zu); nothing launched\n", n_in, ws_size, (size_t)WS_END); grid = -1; return; }
        int dev = 0, cus = 0, per_cu = 0;
        if (hipGetDevice(&dev) != hipSuccess || hipDeviceGetAttribute(&cus, hipDeviceAttributeMultiprocessorCount, dev) != hipSuccess) { grid = -1; return; }
        if (hipFuncSetAttribute((const void*)trunk_fwd, hipFuncAttributeMaxDynamicSharedMemorySize, LDS_BYTES) != hipSuccess) { fprintf(stderr, "kernel_launch: hipFuncSetAttribute failed\n"); grid = -1; return; }
        if (hipOccupancyMaxActiveBlocksPerMultiprocessor(&per_cu, (const void*)trunk_fwd, NWAVES * 64, LDS_BYTES) != hipSuccess || per_cu < 1) fprintf(stderr, "kernel_launch: note: occupancy query says %d\n", per_cu);
        (void)hipGetLastError();
        grid = cus;
    }
    if (grid < 0) return;
    if (hipMemsetAsync((char*)d_ws + WS_CTL, 0, CTL_ZERO_BYTES, stream) != hipSuccess) return;
    Args a{};
    for (int i = 0; i < 16; ++i) a.in[i] = (const float*)d_in[i];
    a.out = (float*)d_out; a.ws = (unsigned char*)d_ws;
#if MK_PER_PHASE
    for (int p = 0; p < N_PHASES; ++p) { a.ph_lo = p; a.ph_hi = p + 1; hipLaunchKernelGGL(trunk_fwd, dim3(grid), dim3(NWAVES * 64), LDS_BYTES, stream, a); }
#else
    a.ph_lo = 0; a.ph_hi = N_PHASES; hipLaunchKernelGGL(trunk_fwd, dim3(grid), dim3(NWAVES * 64), LDS_BYTES, stream, a);
#endif
}
```

```cpp
#include <hip/hip_runtime.h>
#include <cstdio>
#include <cstdint>
#define MK_PER_PHASE 0
#define PG8_WT 2
namespace pg8 {
#define PG8_LAS __attribute__((address_space(3)))
typedef unsigned short bf16_t;
typedef short bf16x8 __attribute__((ext_vector_type(8)));
typedef float f32x4 __attribute__((ext_vector_type(4)));
typedef unsigned u32x4 __attribute__((ext_vector_type(4)));
constexpr int BM = 256, BK = 64, HALF = 128, HTB = HALF * BK * 2  , STAGE_BYTES = 8 * HTB, NXCD = 8, WGM = 8;

__host__ __device__ __forceinline__ int lds_byte(int r, int c) { const int st = (r >> 4) * 2 + (c >> 5), rr = r & 15, cc = c & 31, ob = rr * 64 + cc * 2; return st * 1024 + (ob ^ (((ob >> 9) & 1) << 5)); }
__host__ __device__ __forceinline__ void stage_rc(int b, int& R, int& C) { const int st = b / 1024, sb = b % 1024, swz = sb ^ (((sb >> 9) & 1) << 5); R = (st >> 1) * 16 + swz / 64; C = (st & 1) * 32 + (swz % 64) / 2; }
__host__ __device__ __forceinline__ int perm32(int rho) { const int n = rho >> 4, i = rho & 15; return 8 * (i >> 2) + 4 * n + (i & 3); }

struct Unit { int pm, pn; int wt; };
struct Gemm { const bf16_t* A; const bf16_t* Bt; int M, N, K; };

struct StaticOrder {
    int nM, nN, nwg, G, c;
    __host__ __device__ void init(int M, int N, int G_, int c_) { nM = M / BM; nN = N / BM; nwg = nM * nN; G = G_; c = c_; }
    __host__ __device__ bool next(int i, Unit& u) const {
        const long L = (long)i * G + c; if (L >= nwg) return false;
        int wgid = (int)L; { const int q = nwg / NXCD, r = nwg % NXCD, xcd = wgid % NXCD, off = wgid / NXCD; wgid = (xcd < r ? xcd * (q + 1) : r * (q + 1) + (xcd - r) * q) + off; }
        const int nig = WGM * nN, gid = wgid / nig, fm = gid * WGM, gsz = (nM - fm) < WGM ? (nM - fm) : WGM;
        u.pm = fm + ((wgid % nig) % gsz); u.pn = (wgid % nig) / gsz; return true;
    }
    __device__ __forceinline__ void a_ready(const Unit&) const {}
    __device__ __forceinline__ void done(const Unit&) const {}
};

__device__ __forceinline__ unsigned cvt_pk_bf16(float lo, float hi) { unsigned r; asm volatile("v_cvt_pk_bf16_f32 %0, %1, %2" : "=v"(r) : "v"(lo), "v"(hi)); return r; }
typedef float f32x2 __attribute__((ext_vector_type(2)));
constexpr float RMS_EPS_F = 1e-6f;
typedef unsigned u32x2 __attribute__((ext_vector_type(2)));
__device__ __forceinline__ float row_rstd4(const float* sq4, int row) {
    const f32x4 a = *(const f32x4*)(sq4 + (size_t)row * 4);
    return __builtin_amdgcn_rsqf(((a[0] + a[1]) + (a[2] + a[3])) * (1.0f / 1024.0f) + RMS_EPS_F);
}
__device__ __forceinline__ float row_rstd16(const float* sq16, int row) {
    const f32x4* p = (const f32x4*)(sq16 + (size_t)row * 16);
    const f32x4 a = p[0], b = p[1], c = p[2], d = p[3];
    const float s = ((a[0] + a[1]) + (a[2] + a[3])) + ((b[0] + b[1]) + (b[2] + b[3])) + ((c[0] + c[1]) + (c[2] + c[3])) + ((d[0] + d[1]) + (d[2] + d[3]));
    return __builtin_amdgcn_rsqf(s * (1.0f / 1024.0f) + RMS_EPS_F);
}
__device__ __forceinline__ float bf_lo(unsigned w) { return __builtin_bit_cast(float, w << 16); }
__device__ __forceinline__ float bf_hi(unsigned w) { return __builtin_bit_cast(float, w & 0xffff0000u); }
#ifndef PG8_WT
#define PG8_WT 1
#endif
__device__ __forceinline__ void st16(bf16_t* base, size_t elem_off, u32x4 v, int wt) {
#if PG8_WT == 1
    __builtin_amdgcn_raw_buffer_store_b128(v, __builtin_amdgcn_make_buffer_rsrc((void*)base, (short)0, 0x7fffffff, 0x00020000), (unsigned)(elem_off * 2), 0, 16);
#elif PG8_WT == 2
    if (wt) __builtin_amdgcn_raw_buffer_store_b128(v, __builtin_amdgcn_make_buffer_rsrc((void*)base, (short)0, 0x7fffffff, 0x00020000), (unsigned)(elem_off * 2), 0, 16);
    else __builtin_amdgcn_raw_buffer_store_b128(v, __builtin_amdgcn_make_buffer_rsrc((void*)base, (short)0, 0x7fffffff, 0x00020000), (unsigned)(elem_off * 2), 0, 0);
#else
    *(u32x4*)(base + elem_off) = v;
#endif
}
__device__ __forceinline__ float fast_sigmoid(float x) { return __builtin_amdgcn_rcpf(1.0f + __expf(-x)); }
struct EpiEvenIn {
    static constexpr bool PERM = true, AFTER_DRAIN = false;
    bf16_t* O; const float* sq16; float* gates; const float* bgate;
    __device__ __forceinline__ void operator()(const f32x4 (&acc)[2][2][4][2], const Unit& u, int wr, int wc, int fr, int fq) const {
        const int row0 = u.pm * BM + wr * 64 + fr;
        if (u.pn < 14) {
            const int col0 = u.pn * BM + wc * 32 + 8 * fq;
#pragma unroll
            for (int ai = 0; ai < 2; ++ai)
#pragma unroll
                for (int m = 0; m < 4; ++m) { const int row = row0 + ai * HALF + m * 16; const float r = row_rstd4(sq16, row); const size_t ro = (size_t)row * 3584 + col0;
#pragma unroll
                    for (int bj = 0; bj < 2; ++bj) { const f32x4 v0 = acc[ai][bj][m][0] * r, v1 = acc[ai][bj][m][1] * r;
                        u32x4 w; w.x = cvt_pk_bf16(v0[0], v0[1]); w.y = cvt_pk_bf16(v0[2], v0[3]); w.z = cvt_pk_bf16(v1[0], v1[1]); w.w = cvt_pk_bf16(v1[2], v1[3]);
                        st16(O, ro + bj * HALF, w, u.wt); } }
        } else if (wc == 0 && fq == 0) {
            const f32x4 b0 = *(const f32x4*)(bgate), b1 = *(const f32x4*)(bgate + 4);
#pragma unroll
            for (int ai = 0; ai < 2; ++ai)
#pragma unroll
                for (int m = 0; m < 4; ++m) { const int row = row0 + ai * HALF + m * 16; const float r = row_rstd4(sq16, row);
                    *(f32x4*)(gates + (size_t)row * 8) = acc[ai][0][m][0] * r + b0; *(f32x4*)(gates + (size_t)row * 8 + 4) = acc[ai][0][m][1] * r + b1; }
        }
    }
};
struct EpiResid {
    static constexpr bool PERM = true, AFTER_DRAIN = false;
    bf16_t* xb; PG8_LAS float* sqs;
    __device__ __forceinline__ void operator()(const f32x4 (&acc)[2][2][4][2], const Unit& u, int wr, int wc, int fr, int fq) const {
        const int rl0 = wr * 64 + fr, col0 = u.pn * BM + wc * 32 + 8 * fq;
        const bf16_t* base = xb + (size_t)(u.pm * BM + rl0) * 1024 + col0;
        u32x4 o[2][4][2];
#pragma unroll
        for (int ai = 0; ai < 2; ++ai)
#pragma unroll
            for (int m = 0; m < 4; ++m)
#pragma unroll
                for (int bj = 0; bj < 2; ++bj) o[ai][m][bj] = *(const u32x4*)(base + (size_t)(ai * HALF + m * 16) * 1024 + bj * HALF);
#pragma unroll
        for (int ai = 0; ai < 2; ++ai)
#pragma unroll
            for (int m = 0; m < 4; ++m) { const int rl = rl0 + ai * HALF + m * 16; float ss = 0.f;
#pragma unroll
                for (int bj = 0; bj < 2; ++bj) { const u32x4 ov = o[ai][m][bj];
                    const f32x4 v0 = acc[ai][bj][m][0] + (f32x4){bf_lo(ov.x), bf_hi(ov.x), bf_lo(ov.y), bf_hi(ov.y)}, v1 = acc[ai][bj][m][1] + (f32x4){bf_lo(ov.z), bf_hi(ov.z), bf_lo(ov.w), bf_hi(ov.w)};
                    u32x4 w; w.x = cvt_pk_bf16(v0[0], v0[1]); w.y = cvt_pk_bf16(v0[2], v0[3]); w.z = cvt_pk_bf16(v1[0], v1[1]); w.w = cvt_pk_bf16(v1[2], v1[3]);
                    st16(xb, (size_t)(u.pm * BM + rl) * 1024 + col0 + bj * HALF, w, u.wt);
                    ss += ((v0[0] * v0[0] + v0[1] * v0[1]) + (v0[2] * v0[2] + v0[3] * v0[3])) + ((v1[0] * v1[0] + v1[1] * v1[1]) + (v1[2] * v1[2] + v1[3] * v1[3])); }
                ss += __shfl_xor(ss, 16); ss += __shfl_xor(ss, 32);
                if (fq == 0) sqs[rl * 4 + wc] = ss; }
    }
};
struct EpiSwiGLU {
    static constexpr bool PERM = true, AFTER_DRAIN = false;
    bf16_t* O; const float* sq16;
    __device__ __forceinline__ void operator()(const f32x4 (&acc)[2][2][4][2], const Unit& u, int wr, int wc, int fr, int fq) const {
        const int row0 = u.pm * BM + wr * 64 + fr, col0 = u.pn * HALF + wc * 32 + 8 * fq;
        float rr[2][4];
#pragma unroll
        for (int ai = 0; ai < 2; ++ai)
#pragma unroll
            for (int m = 0; m < 4; ++m) rr[ai][m] = row_rstd4(sq16, row0 + ai * HALF + m * 16);
#pragma unroll
        for (int ai = 0; ai < 2; ++ai)
#pragma unroll
            for (int m = 0; m < 4; ++m) { const int row = row0 + ai * HALF + m * 16; const float r = rr[ai][m]; const float r2 = r * r, rl = r * -1.4426950408889634f;
                unsigned pk[4];
#pragma unroll
                for (int n = 0; n < 2; ++n)
#pragma unroll
                    for (int hh = 0; hh < 2; ++hh) { const f32x2 g = {acc[ai][0][m][n][2 * hh], acc[ai][0][m][n][2 * hh + 1]}, up = {acc[ai][1][m][n][2 * hh], acc[ai][1][m][n][2 * hh + 1]};
                        const f32x2 t = g * rl; f32x2 d; d.x = __builtin_amdgcn_exp2f(t.x); d.y = __builtin_amdgcn_exp2f(t.y); d = d + 1.0f;
                        f32x2 rc; rc.x = __builtin_amdgcn_rcpf(d.x); rc.y = __builtin_amdgcn_rcpf(d.y);
                        const f32x2 h = ((g * up) * r2) * rc; pk[2 * n + hh] = cvt_pk_bf16(h.x, h.y); }
                u32x4 w; w.x = pk[0]; w.y = pk[1]; w.z = pk[2]; w.w = pk[3];
                st16(O, (size_t)row * 2816 + col0, w, u.wt); }
    }
};
struct EpiGeluZ {
    static constexpr bool PERM = true, AFTER_DRAIN = false;
    bf16_t* O; const float* sq16; float* vsq16;
    __device__ __forceinline__ void operator()(const f32x4 (&acc)[2][2][4][2], const Unit& u, int wr, int wc, int fr, int fq) const {
        const int row0 = u.pm * BM + wr * 64 + fr, col0 = u.pn * BM + wc * 32 + 8 * fq;
        constexpr float GA = -2.3022082f, GB = -0.10294324f;
        float rr[2][4];
#pragma unroll
        for (int ai = 0; ai < 2; ++ai)
#pragma unroll
            for (int m = 0; m < 4; ++m) rr[ai][m] = row_rstd4(sq16, row0 + ai * HALF + m * 16);
#pragma unroll
        for (int ai = 0; ai < 2; ++ai)
#pragma unroll
            for (int m = 0; m < 4; ++m) { const int row = row0 + ai * HALF + m * 16; const float r = rr[ai][m]; f32x2 ss = {0.f, 0.f};
#pragma unroll
                for (int bj = 0; bj < 2; ++bj) { unsigned pk[4];
#pragma unroll
                    for (int n = 0; n < 2; ++n)
#pragma unroll
                        for (int hh = 0; hh < 2; ++hh) { const f32x2 v = (f32x2){acc[ai][bj][m][n][2 * hh], acc[ai][bj][m][n][2 * hh + 1]} * r;
                            const f32x2 p = v * ((v * v) * GB + GA); f32x2 d; d.x = __builtin_amdgcn_exp2f(p.x); d.y = __builtin_amdgcn_exp2f(p.y); d = d + 1.0f;
                            f32x2 rc; rc.x = __builtin_amdgcn_rcpf(d.x); rc.y = __builtin_amdgcn_rcpf(d.y);
                            const f32x2 z = v * rc; ss = z * z + ss; pk[2 * n + hh] = cvt_pk_bf16(z.x, z.y); }
                    u32x4 w; w.x = pk[0]; w.y = pk[1]; w.z = pk[2]; w.w = pk[3];
                    st16(O, (size_t)row * 2048 + col0 + bj * HALF, w, u.wt); }
                if (u.pn >= 4) { float s1 = ss.x + ss.y; s1 += __shfl_xor(s1, 16); s1 += __shfl_xor(s1, 32); if (fq == 0) vsq16[(size_t)row * 16 + (u.pn - 4) * 4 + wc] = s1; } }
    }
};
template <class Epi, class Sched, bool ALIGN_EPI = false, bool SP2 = false>
__device__ __forceinline__ void gemm_phase(PG8_LAS unsigned char* lds, const Gemm g, const Sched& S, const Epi& E) {
    int tid_ = threadIdx.x; asm volatile("" : "+v"(tid_)); const int tid = tid_, wid = __builtin_amdgcn_readfirstlane(tid >> 6), lane = tid & 63, wr = wid >> 2, wc = wid & 3, fr = lane & 15, fq = lane >> 4;
    const int K = g.K, nt = K / BK;
    unsigned voffA[2], voffB[2];
#pragma unroll
    for (int i = 0; i < 2; ++i) { int R, C; stage_rc(tid * 16 + i * 8192, R, C); const int Rb = Epi::PERM ? ((R & ~31) + perm32(R & 31)) : R;
        voffA[i] = (unsigned)(R * K + C) * 2u; voffB[i] = (unsigned)(Rb * K + C) * 2u; }
    const size_t kstep = (size_t)(BK * 2);
    const size_t hstep = (size_t)HALF * K * 2;
    const size_t tstep = 2 * hstep;
    const unsigned ldsw = (unsigned)wid * 1024u;
    const int aoff = lds_byte(wr * 64 + fr, fq * 8), boff = lds_byte(wc * 32 + fr, fq * 8);
#define PG8_SA(b, h) (((b) * 2 + (h)) * HTB)
#define PG8_SB(b, h) ((4 + (b) * 2 + (h)) * HTB)
#define PG8_STAGE(bufoff, gbase, voff) do { _Pragma("unroll") for (int _i = 0; _i < 2; ++_i) \
        __builtin_amdgcn_global_load_lds((const unsigned*)((const char*)(gbase) + (voff)[_i]), (PG8_LAS unsigned*)(lds + (bufoff) + ldsw + _i * 8192), 16, 0, 0); } while (0)
#define PG8_LDA(dst, b, h) do { _Pragma("unroll") for (int m = 0; m < 4; ++m) _Pragma("unroll") for (int k = 0; k < 2; ++k) dst[m][k] = *(const PG8_LAS bf16x8*)(lds + PG8_SA(b, h) + aoff + m * 2048 + k * 1024); } while (0)
#define PG8_LDB(dst, b, h) do { _Pragma("unroll") for (int n = 0; n < 2; ++n) _Pragma("unroll") for (int k = 0; k < 2; ++k) dst[n][k] = *(const PG8_LAS bf16x8*)(lds + PG8_SB(b, h) + boff + n * 2048 + k * 1024); } while (0)
#define PG8_MMA(ai, bj, At, Bt) do { __builtin_amdgcn_s_setprio(1); _Pragma("unroll") for (int m = 0; m < 4; ++m) _Pragma("unroll") for (int n = 0; n < 2; ++n) _Pragma("unroll") for (int k = 0; k < 2; ++k) \
        acc[ai][bj][m][n] = __builtin_amdgcn_mfma_f32_16x16x32_bf16(Bt[n][k], At[m][k], acc[ai][bj][m][n], 0, 0, 0); __builtin_amdgcn_s_setprio(0); } while (0)
#define PG8_WAIT_V(n) asm volatile("s_waitcnt vmcnt(" #n ")" ::: "memory")
#define PG8_WAIT_L(n) asm volatile("s_waitcnt lgkmcnt(" #n ")" ::: "memory")
#define PG8_BAR __builtin_amdgcn_s_barrier()
#define PG8_SCHED __builtin_amdgcn_sched_barrier(0)
    Unit cur, nxt; int ui = 0;
    if (!S.next(0, cur)) return;
    f32x4 acc[2][2][4][2];
#pragma unroll
    for (int a = 0; a < 2; ++a)
#pragma unroll
        for (int b = 0; b < 2; ++b)
#pragma unroll
            for (int m = 0; m < 4; ++m)
#pragma unroll
                for (int n = 0; n < 2; ++n) acc[a][b][m][n] = (f32x4){0.f, 0.f, 0.f, 0.f};
    bf16x8 At[4][2], B0[2][2], B1[2][2];
    const char* cA = (const char*)g.A + (size_t)cur.pm * tstep; const char* cB = (const char*)g.Bt + (size_t)cur.pn * tstep;
    S.a_ready(cur);
    if constexpr (SP2) {
        PG8_STAGE(PG8_SB(0, 0), cB, voffB); PG8_STAGE(PG8_SB(0, 1), cB + hstep, voffB); PG8_STAGE(PG8_SA(0, 0), cA, voffA); PG8_STAGE(PG8_SA(0, 1), cA + hstep, voffA);
        if (wr == 1) PG8_BAR;
        PG8_WAIT_V(2); PG8_BAR;
        PG8_STAGE(PG8_SB(1, 0), cB + kstep, voffB); PG8_STAGE(PG8_SA(1, 0), cA + kstep, voffA); PG8_STAGE(PG8_SB(1, 1), cB + hstep + kstep, voffB);
        PG8_WAIT_V(6); PG8_BAR;
    } else {
        PG8_STAGE(PG8_SB(0, 0), cB, voffB); PG8_STAGE(PG8_SA(0, 0), cA, voffA); PG8_STAGE(PG8_SB(0, 1), cB + hstep, voffB); PG8_STAGE(PG8_SA(0, 1), cA + hstep, voffA);
        if (wr == 1) PG8_BAR;
        PG8_WAIT_V(4); PG8_BAR;
        PG8_STAGE(PG8_SB(1, 0), cB + kstep, voffB); PG8_STAGE(PG8_SA(1, 0), cA + kstep, voffA); PG8_STAGE(PG8_SB(1, 1), cB + hstep + kstep, voffB);
        PG8_WAIT_V(6); PG8_BAR;
    }
    for (;;) {
        const bool has_next = S.next(ui + 1, nxt); cur.wt = has_next ? 0 : 1;
        const char* nA = has_next ? (const char*)g.A + (size_t)nxt.pm * tstep : cA; const char* nB = has_next ? (const char*)g.Bt + (size_t)nxt.pn * tstep : cB;
        for (int t = 0; t < nt; t += 2) {
            const bool last = (t == nt - 2);
            const char* a1 = cA + (size_t)(t + 1) * kstep;
            const char* a2 = last ? nA : cA + (size_t)(t + 2) * kstep; const char* b2 = last ? nB : cB + (size_t)(t + 2) * kstep;
            const char* a3 = a2 + kstep; const char* b3 = b2 + kstep;
            if (last && has_next) S.a_ready(nxt);
            if constexpr (SP2) {
            PG8_LDB(B0, 0, 0); PG8_LDB(B1, 0, 1); PG8_SCHED; PG8_LDA(At, 0, 0); PG8_STAGE(PG8_SA(1, 1), a1 + hstep, voffA);
            PG8_WAIT_V(8); PG8_WAIT_L(0); PG8_BAR; PG8_MMA(0, 0, At, B0); PG8_MMA(0, 1, At, B1); PG8_BAR; PG8_SCHED;
            PG8_LDA(At, 0, 1); PG8_STAGE(PG8_SB(0, 0), b2, voffB); PG8_STAGE(PG8_SB(0, 1), b2 + hstep, voffB); PG8_STAGE(PG8_SA(0, 0), a2, voffA);
            PG8_WAIT_V(8); PG8_WAIT_L(0); PG8_BAR; PG8_MMA(1, 0, At, B0); PG8_MMA(1, 1, At, B1); PG8_BAR; PG8_SCHED;
            PG8_LDB(B0, 1, 0); PG8_LDB(B1, 1, 1); PG8_SCHED; PG8_LDA(At, 1, 0); PG8_STAGE(PG8_SA(0, 1), a2 + hstep, voffA);
            PG8_WAIT_V(8); PG8_WAIT_L(0); PG8_BAR; PG8_MMA(0, 0, At, B0); PG8_MMA(0, 1, At, B1); PG8_BAR; PG8_SCHED;
            PG8_LDA(At, 1, 1); PG8_STAGE(PG8_SB(1, 0), b3, voffB); PG8_STAGE(PG8_SB(1, 1), b3 + hstep, voffB); PG8_STAGE(PG8_SA(1, 0), a3, voffA);
            PG8_WAIT_V(8); PG8_WAIT_L(0); PG8_BAR; PG8_MMA(1, 0, At, B0); PG8_MMA(1, 1, At, B1); PG8_BAR; PG8_SCHED;
            } else {
            PG8_LDB(B0, 0, 0); PG8_SCHED; PG8_LDA(At, 0, 0); PG8_STAGE(PG8_SA(1, 1), a1 + hstep, voffA);
            PG8_WAIT_L(8); PG8_BAR; PG8_WAIT_L(0); PG8_MMA(0, 0, At, B0); PG8_BAR; PG8_SCHED;
            PG8_LDB(B1, 0, 1); PG8_STAGE(PG8_SB(0, 0), b2, voffB);
            PG8_BAR; PG8_WAIT_L(0); PG8_MMA(0, 1, At, B1); PG8_BAR;
            PG8_LDA(At, 0, 1); PG8_STAGE(PG8_SA(0, 0), a2, voffA);
            PG8_BAR; PG8_WAIT_L(0); PG8_MMA(1, 0, At, B0); PG8_BAR; PG8_SCHED;
            PG8_STAGE(PG8_SB(0, 1), b2 + hstep, voffB);
            PG8_WAIT_V(6); PG8_BAR; PG8_MMA(1, 1, At, B1); PG8_BAR;
            PG8_LDB(B0, 1, 0); PG8_SCHED; PG8_LDA(At, 1, 0); PG8_STAGE(PG8_SA(0, 1), a2 + hstep, voffA);
            PG8_WAIT_L(8); PG8_BAR; PG8_WAIT_L(0); PG8_MMA(0, 0, At, B0); PG8_BAR; PG8_SCHED;
            PG8_LDB(B1, 1, 1); PG8_STAGE(PG8_SB(1, 0), b3, voffB);
            PG8_BAR; PG8_WAIT_L(0); PG8_MMA(0, 1, At, B1); PG8_BAR;
            PG8_LDA(At, 1, 1); PG8_STAGE(PG8_SA(1, 0), a3, voffA);
            PG8_BAR; PG8_WAIT_L(0); PG8_MMA(1, 0, At, B0); PG8_BAR; PG8_SCHED;
            PG8_STAGE(PG8_SB(1, 1), b3 + hstep, voffB);
            PG8_WAIT_V(6); PG8_BAR; PG8_MMA(1, 1, At, B1); PG8_BAR;
            }
        }
        if constexpr (ALIGN_EPI) { if (wr == 0) PG8_BAR; }
        if constexpr (!Epi::AFTER_DRAIN) { E(acc, cur, wr, wc, fr, fq); S.done(cur); }
        if (!has_next) break;
#pragma unroll
        for (int a = 0; a < 2; ++a)
#pragma unroll
            for (int b = 0; b < 2; ++b)
#pragma unroll
                for (int m = 0; m < 4; ++m)
#pragma unroll
                    for (int n = 0; n < 2; ++n) acc[a][b][m][n] = (f32x4){0.f, 0.f, 0.f, 0.f};
        cur = nxt; cA = nA; cB = nB; ++ui;
        if constexpr (ALIGN_EPI) { if (wr == 1) PG8_BAR; }
    }
    PG8_WAIT_V(0);
    if constexpr (!ALIGN_EPI) { if (wr == 0) PG8_BAR; }
    PG8_BAR;
    if constexpr (Epi::AFTER_DRAIN) { E.fused(acc, cur, wr, wc, fr, fq, lds, wid, lane); S.done(cur); }
#undef PG8_SA
#undef PG8_SB
#undef PG8_STAGE
#undef PG8_LDA
#undef PG8_LDB
#undef PG8_MMA
#undef PG8_WAIT_V
#undef PG8_WAIT_L
#undef PG8_BAR
#undef PG8_SCHED
}
}
constexpr int NWAVES = 8;
#ifndef MK_PER_PHASE
#define MK_PER_PHASE 0
#endif
constexpr int DM = 1024, NB = 2, SEQ = 8192, M = NB * SEQ, DEPTH = 4;
constexpr int CD = 512, HEADS = 4, HD = 128, MD = 512, EVEN_IN = 3592, EVEN_NP = 3840, EVEN_W = 3584, DFF = 2816, CHUNK = 128, NCH = SEQ / CHUNK, NUNIT = NB * HEADS * NCH;
constexpr float RMS_EPS = 1e-6f;
constexpr size_t MiB = 1u << 20;
constexpr size_t WS_CTL = 0, CTL_ZERO_BYTES = 1 * MiB;
constexpr size_t WS_SQ = 1 * MiB;
constexpr size_t WS_VSQ = 2 * MiB;
constexpr size_t WS_GATES = 3 * MiB;
constexpr size_t WS_NLOC = 4 * MiB;
constexpr size_t WS_NIN = 4 * MiB + 256 * 1024;
constexpr size_t WS_MLOC = 4 * MiB + 512 * 1024;
constexpr size_t WS_BL = WS_MLOC + 4096;
constexpr size_t WS_MIN = WS_BL + 4096;
constexpr size_t WS_WEI = 5 * MiB;
constexpr size_t WS_WEO = 20 * MiB;
constexpr size_t WS_WOI = 24 * MiB;
constexpr size_t WS_WOO = 32 * MiB;
constexpr size_t WS_WFI = 36 * MiB;
constexpr size_t WS_WFO = 80 * MiB;
constexpr size_t WS_XB = 102 * MiB;
constexpr size_t WS_Y = 134 * MiB;
constexpr size_t WS_BIG = 166 * MiB;
constexpr size_t WS_CLOC = 278 * MiB;
constexpr size_t WS_CIN = 310 * MiB;
constexpr size_t WS_END = 326 * MiB;
constexpr int CW_BAR = 4096;
constexpr int RING_BYTES = 131072;
constexpr int SQS_OFF = RING_BYTES;
constexpr int LDS_BYTES = 163840;
constexpr int LDSCTL_OFF = LDS_BYTES - 512, MISC_OFF = LDSCTL_OFF + 320;
constexpr int TSTR = 272;
constexpr int TILE_B = 128 * TSTR;
#define GAS __attribute__((address_space(1)))
#define LAS __attribute__((address_space(3)))
typedef unsigned short bf16;
typedef unsigned v4u __attribute__((ext_vector_type(4)));
typedef float f32x4 __attribute__((ext_vector_type(4)));
typedef short bf16x8 __attribute__((ext_vector_type(8)));
typedef GAS unsigned gu32;
typedef GAS unsigned long long gu64;
#define RLX_AGENT __ATOMIC_RELAXED, __HIP_MEMORY_SCOPE_AGENT
#define LDS_WAIT() asm volatile("s_waitcnt lgkmcnt(0)" ::: "memory")
#define VM_WAIT() asm volatile("s_waitcnt vmcnt(0)" ::: "memory")
__device__ __forceinline__ unsigned long long rt() { return __builtin_amdgcn_s_memrealtime(); }
__device__ __forceinline__ unsigned f2bf(float f) { unsigned u = __builtin_bit_cast(unsigned, f); return (u + 0x7fffu + ((u >> 16) & 1u)) >> 16; }
__device__ __forceinline__ unsigned pk2(float lo, float hi) { return f2bf(lo) | (f2bf(hi) << 16); }

#define XB_TMO      128
#define XB_XCNT(j)  (256  + 64 * (j))
#define XB_XSUB(j)  (1280 + 64 * (j))
#define XB_XGEN(j)  (2304 + 64 * (j))
#define XB_TOP      3328
#define XB_TOPGEN   3392
#define XCD_BAR_WORDS 3456
#define XB_SPIN_CAP (1u << 18)

__device__ __forceinline__ unsigned xb_ld(unsigned* p)              { return __hip_atomic_load(p, __ATOMIC_RELAXED, __HIP_MEMORY_SCOPE_AGENT); }
__device__ __forceinline__ unsigned xb_add(unsigned* p, unsigned v) { return __hip_atomic_fetch_add(p, v, __ATOMIC_RELAXED, __HIP_MEMORY_SCOPE_AGENT); }
__device__ __forceinline__ unsigned xb_xcc_id() { return (unsigned)__builtin_amdgcn_s_getreg((3 << 11) | 20) & 0xFu; }
#define XB_SPIN(cond, bar) do { unsigned _sp = 0; while (cond) { __builtin_amdgcn_s_sleep(1); \
    if ((++_sp & 255u) == 0u) { if (xb_ld(&(bar)[XB_TMO])) break; if (_sp > XB_SPIN_CAP) { atomicAdd(&(bar)[XB_TMO], 1u); break; } } } } while (0)

struct XcdBarrier {
    unsigned* bar; unsigned x;
    volatile LAS unsigned* st;
};

__device__ __forceinline__ XcdBarrier xcd_barrier_post(unsigned* bar, volatile LAS unsigned* st) {
    XcdBarrier b; b.bar = bar; b.x = xb_xcc_id(); b.st = st;
    if (threadIdx.x == 0) (void)xb_add(&bar[XB_XCNT(b.x)], 1u);
    return b;
}
__device__ __forceinline__ void xcd_barrier_complete(unsigned* bar, unsigned x, unsigned& nloc, unsigned& nx) {
    const unsigned G = gridDim.x * gridDim.y * gridDim.z;
    unsigned sum, cnt, mine, sp = 0u;
    for (;;) {
        sum = 0u; cnt = 0u; mine = 0u;
#pragma unroll
        for (unsigned j = 0; j < 16; ++j) { const unsigned c = xb_ld(&bar[XB_XCNT(j)]); sum += c; cnt += (c > 0u) ? 1u : 0u; mine = (j == x) ? c : mine; }
        if (sum == G) break;
        __builtin_amdgcn_s_sleep(1);
        if ((++sp & 255u) == 0u) { if (xb_ld(&bar[XB_TMO])) break; if (sp > XB_SPIN_CAP) { atomicAdd(&bar[XB_TMO], 1u); break; } }
    }
    nloc = mine > 0u ? mine : 1u; nx = cnt > 0u ? cnt : 1u;
}

__device__ __forceinline__ void xcd_barrier(const XcdBarrier& b) {
    asm volatile("s_waitcnt vmcnt(0)" ::: "memory");
    __syncthreads();
    if (threadIdx.x == 0) {
        unsigned* bar = b.bar;
        __builtin_amdgcn_s_waitcnt(0);
        unsigned nloc = b.st[0], nx = b.st[1];
        if (nloc == 0u) { xcd_barrier_complete(bar, b.x, nloc, nx); b.st[0] = nloc; b.st[1] = nx; }
        const unsigned old = xb_add(&bar[XB_XSUB(b.x)], 1u);
        const unsigned gen = old / nloc;
        if (old + 1u == (gen + 1u) * nloc) {
            __builtin_amdgcn_fence(__ATOMIC_RELEASE, "agent");
            asm volatile("s_waitcnt vmcnt(0)" ::: "memory");
            const unsigned og = xb_add(&bar[XB_TOP], 1u);
            const unsigned tg = og / nx;
            if (og + 1u == (tg + 1u) * nx) xb_add(&bar[XB_TOPGEN], 1u);
            else XB_SPIN(xb_ld(&bar[XB_TOPGEN]) == tg, bar);
            __builtin_amdgcn_fence(__ATOMIC_ACQUIRE, "agent");
            xb_add(&bar[XB_XGEN(b.x)], 1u);
            asm volatile("s_waitcnt vmcnt(0)" ::: "memory");
        } else {
            XB_SPIN(xb_ld(&bar[XB_XGEN(b.x)]) == gen, bar);
            __builtin_amdgcn_fence(__ATOMIC_ACQUIRE, "agent");
            asm volatile("s_waitcnt vmcnt(0)" ::: "memory");
        }
    }
    __syncthreads();
}
typedef unsigned u32x2 __attribute__((ext_vector_type(2)));
struct Frame {
    LAS unsigned char* lds;
    volatile LAS unsigned* MISC;
    gu32* ctl;
    int vcu, G;
    unsigned char* ws;
    const float* in[16];
    float* x;
};
#define OPQ_TID() int tid = threadIdx.x; asm volatile("" : "+v"(tid)); const int lane = tid & 63, w = __builtin_amdgcn_readfirstlane(tid >> 6), fr = lane & 15, fq = lane >> 4; (void)w; (void)fr; (void)fq
__device__ __forceinline__ float wave_sum(float v) {
#pragma unroll
    for (int o = 1; o < 64; o <<= 1) v += __shfl_xor(v, o);
    return v;
}
__device__ __forceinline__ float wave_max(float v) {
#pragma unroll
    for (int o = 1; o < 64; o <<= 1) v = fmaxf(v, __shfl_xor(v, o));
    return v;
}
__device__ __forceinline__ float bf2f(unsigned short h) { return __builtin_bit_cast(float, (unsigned)h << 16); }
__device__ __forceinline__ float logsig(float x) { return fminf(x, 0.f) - log1pf(expf(-fabsf(x))); }

__device__ __forceinline__ void cv_item(const float* W, int ldw, int K, int sc0, bf16* Bt, int dr0, int k0, const float* gain, float cs, LAS float* scr, int lane) {
    float v[32];
    const float* wp = W + (size_t)(k0 + (lane >> 5)) * ldw + sc0 + (lane & 31);
#pragma unroll
    for (int i = 0; i < 32; ++i) v[i] = wp[(size_t)(2 * i) * ldw];
#pragma unroll
    for (int i = 0; i < 32; ++i) scr[(2 * i + (lane >> 5)) * 33 + (lane & 31)] = v[i];
    LDS_WAIT(); asm volatile("" ::: "memory");
    const int c = lane & 7;
    f32x4 g0 = {cs, cs, cs, cs}, g1 = g0;
    if (gain) { g0 = *(const f32x4*)(gain + k0 + 8 * c) * cs; g1 = *(const f32x4*)(gain + k0 + 8 * c + 4) * cs; }
#pragma unroll
    for (int j = 0; j < 4; ++j) { const int n = (lane >> 3) + 8 * j; const LAS float* s = scr + (8 * c) * 33 + n;
        v4u o; o.x = pk2(s[0 * 33] * g0[0], s[1 * 33] * g0[1]); o.y = pk2(s[2 * 33] * g0[2], s[3 * 33] * g0[3]); o.z = pk2(s[4 * 33] * g1[0], s[5 * 33] * g1[1]); o.w = pk2(s[6 * 33] * g1[2], s[7 * 33] * g1[3]);
        *(GAS v4u*)(Bt + (size_t)(dr0 + n) * K + k0 + 8 * c) = o; }
    LDS_WAIT(); asm volatile("" ::: "memory");
}
__device__ __forceinline__ void convert_layer(Frame& F, int l, int wbase, int nw) {
    OPQ_TID();
    const int wi = wbase + w;
    LAS float* scr = (LAS float*)(F.lds + w * 16384);
    const int j = l >> 1; const bool odd = l & 1;
    const float* norm_mix = F.in[1] + (size_t)l * DM; const float* norm_ffn = F.in[2] + (size_t)l * DM;
    const int nbi = odd ? 64 : 112, I_MI = nbi * 16, I_MO = 32 * 16, I_FI = 176 * 16, I_FO = 32 * 44;
    const int N0 = I_MI, N1 = N0 + I_MO, N2 = N1 + I_FI, N3 = N2 + I_FO, NT = N3 + (odd ? 0 : 16);
    for (int it = wi; it < NT; it += nw) {
        if (it < N0) { const int kb = it / nbi, nb = it % nbi, c0 = 32 * nb;
            if (odd) cv_item(F.in[8] + (size_t)j * DM * 2048, 2048, DM, c0, (bf16*)(F.ws + WS_WOI) + (size_t)j * 2048 * DM, c0, 64 * kb, norm_mix, 1.0f, scr, lane);
            else cv_item(F.in[3] + (size_t)j * DM * EVEN_IN, EVEN_IN, DM, c0, (bf16*)(F.ws + WS_WEI) + (size_t)j * EVEN_NP * DM, c0, 64 * kb, norm_mix, (c0 >= 2048 && c0 < 2560) ? 0.08838834764831845f : 1.0f, scr, lane);
        } else if (it < N1) { const int r = it - N0, kb = r / 32, nb = r % 32;
            cv_item((odd ? F.in[12] : F.in[7]) + (size_t)j * DM * DM, DM, DM, 32 * nb, (bf16*)(F.ws + (odd ? WS_WOO : WS_WEO)) + (size_t)j * DM * DM, 32 * nb, 64 * kb, nullptr, 1.0f, scr, lane);
        } else if (it < N2) { const int r = it - N1, kb = r / 176, nb = r % 176, c0 = 32 * nb;
            const int up = c0 >= DFF, cc = up ? c0 - DFF : c0, dr = 256 * (cc >> 7) + (up ? 128 : 0) + (cc & 127);
            cv_item(F.in[13] + (size_t)l * DM * 2 * DFF, 2 * DFF, DM, c0, (bf16*)(F.ws + WS_WFI) + (size_t)l * 2 * DFF * DM, dr, 64 * kb, norm_ffn, 1.0f, scr, lane);
        } else if (it < N3) { const int r = it - N2, kb = r / 32, nb = r % 32;
            cv_item(F.in[14] + (size_t)l * DFF * DM, DM, DFF, 32 * nb, (bf16*)(F.ws + WS_WFO) + (size_t)l * DM * DFF, 32 * nb, 64 * kb, nullptr, 1.0f, scr, lane);
        } else { const int k0 = 64 * (it - N3);
            const float* W = F.in[3] + (size_t)j * DM * EVEN_IN; bf16* Bt = (bf16*)(F.ws + WS_WEI) + (size_t)j * EVEN_NP * DM;
#pragma unroll
            for (int e = 0; e < 8; ++e) { const int id = lane + 64 * e, col = id & 7, kk = k0 + (id >> 3);
                Bt[(size_t)(EVEN_W + col) * DM + kk] = (bf16)f2bf(W[(size_t)kk * EVEN_IN + EVEN_W + col] * norm_mix[kk]); }
        }
    }
}
__device__ __forceinline__ void p0_prologue(Frame& F, const float* xin) {
    OPQ_TID();
    const int gw = F.vcu * NWAVES + w, NGW = F.G * NWAVES;
    float* sq4 = (float*)(F.ws + WS_SQ); bf16* xb = (bf16*)(F.ws + WS_XB);
    for (int m = gw; m < M; m += 2 * NGW) {
        const int m1 = m + NGW;
        const GAS f32x4* xr0 = (const GAS f32x4*)(xin + (size_t)m * DM) + lane; const GAS f32x4* xr1 = (const GAS f32x4*)(xin + (size_t)m1 * DM) + lane;
        f32x4 v0[4], v1[4];
#pragma unroll
        for (int jj = 0; jj < 4; ++jj) { v0[jj] = xr0[64 * jj]; v1[jj] = xr1[64 * jj]; }
        GAS u32x2* bo0 = (GAS u32x2*)(xb + (size_t)m * DM) + lane; GAS u32x2* bo1 = (GAS u32x2*)(xb + (size_t)m1 * DM) + lane; float s0 = 0.f, s1 = 0.f;
#pragma unroll
        for (int jj = 0; jj < 4; ++jj) { u32x2 q; q.x = pk2(v0[jj].x, v0[jj].y); q.y = pk2(v0[jj].z, v0[jj].w); bo0[64 * jj] = q; s0 += (v0[jj].x * v0[jj].x + v0[jj].y * v0[jj].y) + (v0[jj].z * v0[jj].z + v0[jj].w * v0[jj].w);
            u32x2 p; p.x = pk2(v1[jj].x, v1[jj].y); p.y = pk2(v1[jj].z, v1[jj].w); bo1[64 * jj] = p; s1 += (v1[jj].x * v1[jj].x + v1[jj].y * v1[jj].y) + (v1[jj].z * v1[jj].z + v1[jj].w * v1[jj].w); }
        s0 = wave_sum(s0); s1 = wave_sum(s1);
        if (lane < 4) { sq4[(size_t)m * 4 + lane] = (lane == 0) ? s0 : 0.f; sq4[(size_t)m1 * 4 + lane] = (lane == 0) ? s1 : 0.f; }
    }
    convert_layer(F, 0, F.vcu * NWAVES, NGW);
}
__device__ __forceinline__ void final_norm(Frame& F) {
    OPQ_TID();
    const int gw = F.vcu * NWAVES + w, NGW = F.G * NWAVES;
    const float* sq4 = (const float*)(F.ws + WS_SQ); const float* gf = F.in[15]; const bf16* xb = (const bf16*)(F.ws + WS_XB);
    f32x4 g[4];
#pragma unroll
    for (int j = 0; j < 4; ++j) g[j] = ((const f32x4*)gf)[lane + 64 * j];
    for (int m = gw; m < M; m += NGW) {
        const float r = pg8::row_rstd4(sq4, m);
        GAS f32x4* xo = (GAS f32x4*)(F.x + (size_t)m * DM) + lane; const GAS u32x2* bi = (const GAS u32x2*)(xb + (size_t)m * DM) + lane;
#pragma unroll
        for (int j = 0; j < 4; ++j) { const u32x2 b = bi[64 * j]; f32x4 v = {pg8::bf_lo(b.x), pg8::bf_hi(b.x), pg8::bf_lo(b.y), pg8::bf_hi(b.y)}; v = v * r * g[j]; xo[64 * j] = v; }
    }
}
__device__ __forceinline__ void scan128_add(float& v0, float& v1, int lane) {
#pragma unroll
    for (int o = 1; o < 64; o <<= 1) { const float a = __shfl_up(v0, o), b = __shfl_up(v1, o); if (lane >= o) { v0 += a; v1 += b; } }
    v1 += __shfl(v0, 63);
}
__device__ __forceinline__ void scan128_max(float& v0, float& v1, int lane) {
#pragma unroll
    for (int o = 1; o < 64; o <<= 1) { const float a = __shfl_up(v0, o), b = __shfl_up(v1, o); if (lane >= o) { v0 = fmaxf(v0, a); v1 = fmaxf(v1, b); } }
    v1 = fmaxf(v1, __shfl(v0, 63));
}
struct Stg { v4u v[4]; };
__device__ __forceinline__ void stg_load_rows(Stg& s, const bf16* src, int ld, int tid) {
#pragma unroll
    for (int i = 0; i < 4; ++i) { const int id = tid + 512 * i, r = id >> 4, dc = id & 15; s.v[i] = *(const GAS v4u*)(src + (size_t)r * ld + 8 * dc); }
}
__device__ __forceinline__ void stg_store_rows(const Stg& s, LAS unsigned char* tile, int tid) {
#pragma unroll
    for (int i = 0; i < 4; ++i) { const int id = tid + 512 * i, r = id >> 4, dc = id & 15; *(LAS v4u*)(tile + r * TSTR + 16 * dc) = s.v[i]; }
}
__device__ __forceinline__ unsigned scale2(unsigned w, float f) { return pk2(pg8::bf_lo(w) * f, pg8::bf_hi(w) * f); }
__device__ __forceinline__ void stg_store_rows_scaled(const Stg& s, LAS unsigned char* tile, const float (&f)[4], int tid) {
#pragma unroll
    for (int i = 0; i < 4; ++i) { const int id = tid + 512 * i, r = id >> 4, dc = id & 15; v4u o; o.x = scale2(s.v[i].x, f[i]); o.y = scale2(s.v[i].y, f[i]); o.z = scale2(s.v[i].z, f[i]); o.w = scale2(s.v[i].w, f[i]);
        *(LAS v4u*)(tile + r * TSTR + 16 * dc) = o; }
}
typedef short s16x4 __attribute__((ext_vector_type(4)));
__device__ __forceinline__ bf16x8 tr_frag(LAS unsigned char* tile, int trb, int cb, int ks) {
    const s16x4 lo = __builtin_amdgcn_ds_read_tr16_b64_v4i16((LAS s16x4*)(tile + trb + ks * 32 * TSTR + cb * 32));
    const s16x4 hi = __builtin_amdgcn_ds_read_tr16_b64_v4i16((LAS s16x4*)(tile + trb + ks * 32 * TSTR + 4 * TSTR + cb * 32));
    return (bf16x8){lo[0], lo[1], lo[2], lo[3], hi[0], hi[1], hi[2], hi[3]};
}
#define TRB(lane) ((8 * ((lane) >> 4) + (((lane) & 15) >> 2)) * TSTR + 8 * ((lane) & 3))
#define FRAG(tile, row, kk, fq) (*(const LAS bf16x8*)((tile) + (row) * TSTR + (32 * (kk) + 8 * (fq)) * 2))

__device__ __forceinline__ void mlstm_phase_a(Frame& F) {
    LAS unsigned char* TK = F.lds; LAS unsigned char* TV = F.lds + TILE_B; LAS float* aS = (LAS float*)(F.lds + 2 * TILE_B); LAS float* nP = aS + 128;
    const bf16* proj = (const bf16*)(F.ws + WS_BIG); const float* gates = (const float*)(F.ws + WS_GATES);
    bf16* Cloc = (bf16*)(F.ws + WS_CLOC); float* nloc = (float*)(F.ws + WS_NLOC); float* mloc = (float*)(F.ws + WS_MLOC); float* bLv = (float*)(F.ws + WS_BL);
    for (int u = F.vcu; u < NUNIT; u += F.G) {
        OPQ_TID();
        const int bh = u >> 6, c = u & 63, b = bh >> 2, h = bh & 3, row0 = b * SEQ + c * CHUNK;
        if (w == 0) {
            const float i0 = gates[(size_t)(row0 + lane) * 8 + h], i1 = gates[(size_t)(row0 + lane + 64) * 8 + h];
            float b0 = logsig(gates[(size_t)(row0 + lane) * 8 + 4 + h]), b1 = logsig(gates[(size_t)(row0 + lane + 64) * 8 + 4 + h]);
            scan128_add(b0, b1, lane);
            const float bL = __shfl(b1, 63);
            const float w0 = bL - b0 + i0, w1 = bL - b1 + i1;
            const float ml = wave_max(fmaxf(w0, w1));
            aS[lane] = __expf(w0 - ml); aS[lane + 64] = __expf(w1 - ml);
            if (lane == 0) { mloc[u] = ml; bLv[u] = bL; }
        }
        Stg sk, sv;
        stg_load_rows(sk, proj + (size_t)row0 * EVEN_W + 2048 + h * HD, EVEN_W, tid); stg_load_rows(sv, proj + (size_t)row0 * EVEN_W + 2560 + h * HD, EVEN_W, tid);
        __syncthreads();
        { float fa[4];
#pragma unroll
          for (int i = 0; i < 4; ++i) fa[i] = aS[(tid >> 4) + 32 * i];
          stg_store_rows_scaled(sk, TK, fa, tid); }
        stg_store_rows(sv, TV, tid);
        __syncthreads();
        {
            const int d = tid & 127, q = tid >> 7; float s = 0.f;
#pragma unroll 8
            for (int i = 0; i < 32; ++i) s += bf2f(*(const LAS unsigned short*)(TK + (32 * q + i) * TSTR + 2 * d));
            nP[q * 128 + d] = s;
        }
        const int trb = TRB(lane);
        bf16x8 vf[4];
#pragma unroll
        for (int kk = 0; kk < 4; ++kk) vf[kk] = tr_frag(TV, trb, w, kk);
#pragma unroll
        for (int db = 0; db < 8; ++db) { f32x4 acc = {0.f, 0.f, 0.f, 0.f};
#pragma unroll
            for (int kk = 0; kk < 4; ++kk) acc = __builtin_amdgcn_mfma_f32_16x16x32_bf16(tr_frag(TK, trb, db, kk), vf[kk], acc, 0, 0, 0);
            u32x2 cw; cw.x = pk2(acc[0], acc[1]); cw.y = pk2(acc[2], acc[3]);
            *(GAS u32x2*)(Cloc + (size_t)u * (HD * HD) + (size_t)(16 * w + fr) * HD + 16 * db + 4 * fq) = cw; }
        __syncthreads();
        if (tid < 128) nloc[(size_t)u * HD + tid] = (nP[tid] + nP[128 + tid]) + (nP[256 + tid] + nP[384 + tid]);
    }
}
struct ConvRegs { v4u cg[6], xa[6], bg[4]; };
__device__ __forceinline__ void conv_load(ConvRegs& R, const bf16* proj, int g) {
    const int t0 = (g >> 6) * 4, c8 = (g & 63) * 8; const bool first = (t0 & (SEQ - 1)) == 0;
#pragma unroll
    for (int i = 0; i < 6; ++i) { const int t = (first && i < 2) ? t0 : t0 - 2 + i; const bf16* p = proj + (size_t)t * EVEN_W; R.cg[i] = *(const GAS v4u*)(p + CD + c8); R.xa[i] = *(const GAS v4u*)(p + 2 * CD + c8); }
#pragma unroll
    for (int i = 0; i < 4; ++i) R.bg[i] = *(const GAS v4u*)(proj + (size_t)(t0 + i) * EVEN_W + c8);
}
__device__ __forceinline__ void conv_z(float (&z)[8], const v4u& c, const v4u& x, float msk) {
    const unsigned cw[4] = {c.x, c.y, c.z, c.w}, xw[4] = {x.x, x.y, x.z, x.w};
#pragma unroll
    for (int j = 0; j < 4; ++j) { z[2 * j] = msk * pg8::bf_lo(cw[j]) * pg8::bf_lo(xw[j]); z[2 * j + 1] = msk * pg8::bf_hi(cw[j]) * pg8::bf_hi(xw[j]); }
}
__device__ __forceinline__ void conv_finish(const ConvRegs& R, const float* wconv, bf16* Y, int g) {
    const int t0 = (g >> 6) * 4, c8 = (g & 63) * 8; const bool first = (t0 & (SEQ - 1)) == 0; const float msk = first ? 0.f : 1.f;
    float wc[3][8];
#pragma unroll
    for (int jj = 0; jj < 3; ++jj) { const f32x4 a = *(const f32x4*)(wconv + jj * CD + c8), b = *(const f32x4*)(wconv + jj * CD + c8 + 4);
        wc[jj][0] = a[0]; wc[jj][1] = a[1]; wc[jj][2] = a[2]; wc[jj][3] = a[3]; wc[jj][4] = b[0]; wc[jj][5] = b[1]; wc[jj][6] = b[2]; wc[jj][7] = b[3]; }
    float z0[8], z1[8], z2[8];
    conv_z(z0, R.cg[0], R.xa[0], msk); conv_z(z1, R.cg[1], R.xa[1], msk);
#pragma unroll
    for (int i = 0; i < 4; ++i) { conv_z(z2, R.cg[i + 2], R.xa[i + 2], 1.0f);
        const unsigned bw[4] = {R.bg[i].x, R.bg[i].y, R.bg[i].z, R.bg[i].w}; unsigned ow[4];
#pragma unroll
        for (int j = 0; j < 4; ++j) { const float a0 = wc[0][2 * j] * z0[2 * j] + wc[1][2 * j] * z1[2 * j] + wc[2][2 * j] * z2[2 * j];
            const float a1 = wc[0][2 * j + 1] * z0[2 * j + 1] + wc[1][2 * j + 1] * z1[2 * j + 1] + wc[2][2 * j + 1] * z2[2 * j + 1];
            ow[j] = pk2(pg8::bf_lo(bw[j]) * a0, pg8::bf_hi(bw[j]) * a1); }
        v4u o; o.x = ow[0]; o.y = ow[1]; o.z = ow[2]; o.w = ow[3];
        *(GAS v4u*)(Y + (size_t)(t0 + i) * DM + c8) = o;
#pragma unroll
        for (int j = 0; j < 8; ++j) { z0[j] = z1[j]; z1[j] = z2[j]; } }
}
__device__ __forceinline__ void mlstm_scan_and_conv(Frame& F, const float* wconv) {
    OPQ_TID();
    const bf16* Cloc = (const bf16*)(F.ws + WS_CLOC); const float* nloc = (const float*)(F.ws + WS_NLOC); const float* mloc = (const float*)(F.ws + WS_MLOC); const float* bLv = (const float*)(F.ws + WS_BL);
    bf16* Cin = (bf16*)(F.ws + WS_CIN); float* nin = (float*)(F.ws + WS_NIN); float* minv = (float*)(F.ws + WS_MIN);
    const bf16* proj = (const bf16*)(F.ws + WS_BIG); bf16* Y = (bf16*)(F.ws + WS_Y);
    LAS float* alS = (LAS float*)F.lds; LAS float* beS = alS + 64;
    const int NCONV = (M / 4) * (CD / 8), NT = F.G * 512; int g = F.vcu * 512 + tid;
    for (int v = F.vcu; v < NB * HEADS * 32; v += F.G) {
        const int bh = v >> 5, part = v & 31, idx = part * 512 + tid;
        ConvRegs R; const bool c0 = g < NCONV; if (c0) conv_load(R, proj, g);
        unsigned short cl[64];
#pragma unroll
        for (int c = 0; c < 64; ++c) cl[c] = Cloc[(size_t)(bh * NCH + c) * (HD * HD) + idx];
        if (w == 0) {
            const float ml = mloc[bh * NCH + lane], bl = bLv[bh * NCH + lane]; float m = 0.f, al = 0.f, be = 0.f, mi = 0.f;
            for (int c = 0; c < 64; ++c) { const float mlc = __shfl(ml, c), blc = __shfl(bl, c); const float mn = fmaxf(blc + m, mlc);
                if (lane == c) { al = __expf(blc + m - mn); be = __expf(mlc - mn); mi = m; } m = mn; }
            alS[lane] = al; beS[lane] = be; if (part == 0) minv[bh * NCH + lane] = mi;
        }
        if (c0) { conv_finish(R, wconv, Y, g); g += NT; }
        const bool c1 = g < NCONV; if (c1) conv_load(R, proj, g);
        __syncthreads();
        float C = 0.f;
#pragma unroll
        for (int c = 0; c < 64; ++c) { Cin[(size_t)(bh * NCH + c) * (HD * HD) + idx] = (bf16)f2bf(C); C = alS[c] * C + beS[c] * bf2f(cl[c]); }
        if (part == 0 && tid < 128) { float n = 0.f;
#pragma unroll 8
            for (int c = 0; c < 64; ++c) { nin[(size_t)(bh * NCH + c) * HD + tid] = n; n = alS[c] * n + beS[c] * nloc[(size_t)(bh * NCH + c) * HD + tid]; } }
        if (c1) { conv_finish(R, wconv, Y, g); g += NT; }
        __syncthreads();
    }
    for (; g < NCONV; g += NT) { ConvRegs R; conv_load(R, proj, g); conv_finish(R, wconv, Y, g); }
}
__device__ __forceinline__ void mlstm_phase_c(Frame& F, const float* ghead) {
    LAS unsigned char* TK = F.lds; LAS unsigned char* TV = F.lds + TILE_B; LAS unsigned char* TC = F.lds + 2 * TILE_B; LAS unsigned char* TS = F.lds + 3 * TILE_B;
    LAS float* gS = (LAS float*)(F.lds + 4 * TILE_B); LAS float* mxS = gS + 128; LAS float* bS = gS + 256; LAS float* nS = gS + 384;
    const bf16* proj = (const bf16*)(F.ws + WS_BIG); const float* gates = (const float*)(F.ws + WS_GATES);
    const bf16* Cin = (const bf16*)(F.ws + WS_CIN); const float* nin = (const float*)(F.ws + WS_NIN); const float* minv = (const float*)(F.ws + WS_MIN);
    bf16* Y = (bf16*)(F.ws + WS_Y);
    for (int u = F.vcu; u < NUNIT; u += F.G) {
        OPQ_TID();
        const int bh = u >> 6, c = u & 63, b = bh >> 2, h = bh & 3, row0 = b * SEQ + c * CHUNK;
        const float m_in = minv[u];
        if (w == 0) {
            const float i0 = gates[(size_t)(row0 + lane) * 8 + h], i1 = gates[(size_t)(row0 + lane + 64) * 8 + h];
            float b0 = logsig(gates[(size_t)(row0 + lane) * 8 + 4 + h]), b1 = logsig(gates[(size_t)(row0 + lane + 64) * 8 + 4 + h]);
            scan128_add(b0, b1, lane);
            const float g0 = i0 - b0, g1 = i1 - b1; float p0 = g0, p1 = g1;
            scan128_max(p0, p1, lane);
            gS[lane] = g0; gS[lane + 64] = g1; mxS[lane] = fmaxf(m_in, p0); mxS[lane + 64] = fmaxf(m_in, p1); bS[lane] = b0; bS[lane + 64] = b1;
        } else if (w == 1) { nS[lane] = nin[(size_t)u * HD + lane]; nS[lane + 64] = nin[(size_t)u * HD + lane + 64]; }
        const int t = 16 * w + fr;
        bf16x8 qf[4];
#pragma unroll
        for (int kk = 0; kk < 4; ++kk) qf[kk] = *(const GAS bf16x8*)(proj + (size_t)(row0 + t) * EVEN_W + 1536 + h * HD + 32 * kk + 8 * fq);
        Stg sk, sc, sv;
        stg_load_rows(sk, proj + (size_t)row0 * EVEN_W + 2048 + h * HD, EVEN_W, tid); stg_load_rows(sc, Cin + (size_t)u * (HD * HD), HD, tid); stg_load_rows(sv, proj + (size_t)row0 * EVEN_W + 2560 + h * HD, EVEN_W, tid);
        u32x2 ovv[8];
#pragma unroll
        for (int eb = 0; eb < 8; ++eb) ovv[eb] = *(const GAS u32x2*)(proj + (size_t)(row0 + t) * EVEN_W + 3072 + h * HD + 16 * eb + 4 * fq);
        stg_store_rows(sk, TK, tid);
        stg_store_rows(sc, TC, tid);
        stg_store_rows(sv, TV, tid);
        const int trb = TRB(lane);
        __syncthreads();
        const float mx_t = mxS[t], b_t = bS[t], inter = __expf(m_in - mx_t);
        float den1 = 0.f;
#pragma unroll
        for (int sb = 0; sb < 8; ++sb) {
            u32x2 pk = {0u, 0u};
            if (sb <= w) { f32x4 acc = {0.f, 0.f, 0.f, 0.f};
#pragma unroll
                for (int kk = 0; kk < 4; ++kk) acc = __builtin_amdgcn_mfma_f32_16x16x32_bf16(FRAG(TK, 16 * sb + fr, kk, fq), qf[kk], acc, 0, 0, 0);
                float sv[4];
#pragma unroll
                for (int r = 0; r < 4; ++r) { const int s = 16 * sb + 4 * fq + r; const float e = __expf(gS[s] - mx_t); sv[r] = (s <= t) ? acc[r] * e : 0.f; den1 += sv[r]; }
                pk.x = pk2(sv[0], sv[1]); pk.y = pk2(sv[2], sv[3]); }
            *(LAS u32x2*)(TS + t * TSTR + (16 * sb + 4 * fq) * 2) = pk;
        }
        den1 += __shfl_xor(den1, 16); den1 += __shfl_xor(den1, 32);
        float qn = 0.f;
#pragma unroll
        for (int kk = 0; kk < 4; ++kk)
#pragma unroll
            for (int j = 0; j < 8; ++j) qn += bf2f((unsigned short)qf[kk][j]) * nS[32 * kk + 8 * fq + j];
        qn += __shfl_xor(qn, 16); qn += __shfl_xor(qn, 32);
        const float den = den1 + inter * qn, m_t = b_t + mx_t;
        const float rden = 1.0f / fmaxf(fabsf(den), __expf(-m_t));
        bf16x8 sf[4];
#pragma unroll
        for (int kk = 0; kk < 4; ++kk) sf[kk] = FRAG(TS, t, kk, fq);
        float hh[32]; float ssq = 0.f;
#pragma unroll
        for (int eb = 0; eb < 8; ++eb) { f32x4 a1 = {0.f, 0.f, 0.f, 0.f}, a2 = {0.f, 0.f, 0.f, 0.f};
#pragma unroll
            for (int kk = 0; kk < 4; ++kk) { if (2 * kk <= w) a1 = __builtin_amdgcn_mfma_f32_16x16x32_bf16(tr_frag(TV, trb, eb, kk), sf[kk], a1, 0, 0, 0);
                a2 = __builtin_amdgcn_mfma_f32_16x16x32_bf16(FRAG(TC, 16 * eb + fr, kk, fq), qf[kk], a2, 0, 0, 0); }
#pragma unroll
            for (int r = 0; r < 4; ++r) { const float v = (a1[r] + inter * a2[r]) * rden; hh[4 * eb + r] = v; ssq += v * v; } }
        ssq += __shfl_xor(ssq, 16); ssq += __shfl_xor(ssq, 32);
        const float rs = __builtin_amdgcn_rsqf(ssq * (1.0f / 128.0f) + RMS_EPS);
#pragma unroll
        for (int eb = 0; eb < 8; ++eb) { const int e = 16 * eb + 4 * fq;
            const u32x2 ov = ovv[eb]; const f32x4 gh = *(const f32x4*)(ghead + h * HD + e);
            const float o0 = bf2f((unsigned short)(ov.x & 0xffffu)), o1 = bf2f((unsigned short)(ov.x >> 16)), o2 = bf2f((unsigned short)(ov.y & 0xffffu)), o3 = bf2f((unsigned short)(ov.y >> 16));
            u32x2 y; y.x = pk2(pg8::fast_sigmoid(o0) * hh[4 * eb] * rs * gh[0], pg8::fast_sigmoid(o1) * hh[4 * eb + 1] * rs * gh[1]);
            y.y = pk2(pg8::fast_sigmoid(o2) * hh[4 * eb + 2] * rs * gh[2], pg8::fast_sigmoid(o3) * hh[4 * eb + 3] * rs * gh[3]);
            *(GAS u32x2*)(Y + (size_t)(row0 + t) * DM + MD + h * HD + e) = y; }
        __syncthreads();
    }
}
__device__ __forceinline__ void sgu_phase(Frame& F, const float* gv, const float* wsp, const float* bsp) {
    LAS unsigned char* TW = F.lds; LAS unsigned char* TV = F.lds + TILE_B;
    const bf16* Z = (const bf16*)(F.ws + WS_BIG); const float* vsq16 = (const float*)(F.ws + WS_VSQ); bf16* Y = (bf16*)(F.ws + WS_Y);
    for (int v = F.vcu; v < 256; v += F.G) {
        OPQ_TID();
        const int g = v & 7, cb0 = (v >> 3) * 4;
#pragma unroll
        for (int i = 0; i < 8; ++i) { const int id = tid + 512 * i, t = id >> 5, s4 = (id & 31) * 4;
            const f32x4 wv = *(const f32x4*)(wsp + ((size_t)g * CHUNK + t) * CHUNK + s4);
            u32x2 pk; pk.x = pk2(s4 <= t ? wv[0] : 0.f, s4 + 1 <= t ? wv[1] : 0.f); pk.y = pk2(s4 + 2 <= t ? wv[2] : 0.f, s4 + 3 <= t ? wv[3] : 0.f);
            *(LAS u32x2*)(TW + t * TSTR + s4 * 2) = pk; }
        const int t = 16 * w + fr, trb = TRB(lane);
        const float bst = bsp[g * CHUNK + t];
        f32x4 gvv[8];
#pragma unroll
        for (int db = 0; db < 8; ++db) gvv[db] = *(const f32x4*)(gv + g * 128 + 16 * db + 4 * fq);
        for (int ci = 0; ci < 4; ++ci) {
            const int row0 = (cb0 + ci) * CHUNK;
            Stg sv; stg_load_rows(sv, Z + (size_t)row0 * 2048 + 1024 + g * 128, 2048, tid);
            float rs[4];
#pragma unroll
            for (int i = 0; i < 4; ++i) rs[i] = pg8::row_rstd16(vsq16, row0 + (tid >> 4) + 32 * i);
            u32x2 uv[8];
#pragma unroll
            for (int db = 0; db < 8; ++db) uv[db] = *(const GAS u32x2*)(Z + (size_t)(row0 + t) * 2048 + g * 128 + 16 * db + 4 * fq);
            stg_store_rows_scaled(sv, TV, rs, tid);
            __syncthreads();
            bf16x8 wf[4];
#pragma unroll
            for (int kk = 0; kk < 4; ++kk) wf[kk] = FRAG(TW, t, kk, fq);
#pragma unroll
            for (int db = 0; db < 8; ++db) { f32x4 acc = {0.f, 0.f, 0.f, 0.f};
#pragma unroll
                for (int kk = 0; kk < 4; ++kk) if (2 * kk <= w) acc = __builtin_amdgcn_mfma_f32_16x16x32_bf16(tr_frag(TV, trb, db, kk), wf[kk], acc, 0, 0, 0);
                const int col = g * 128 + 16 * db + 4 * fq;
                u32x2 y; y.x = pk2(pg8::bf_lo(uv[db].x) * (acc[0] * gvv[db][0] + bst), pg8::bf_hi(uv[db].x) * (acc[1] * gvv[db][1] + bst));
                y.y = pk2(pg8::bf_lo(uv[db].y) * (acc[2] * gvv[db][2] + bst), pg8::bf_hi(uv[db].y) * (acc[3] * gvv[db][3] + bst));
                *(GAS u32x2*)(Y + (size_t)(row0 + t) * DM + col) = y; }
            __syncthreads();
        }
    }
}
#ifndef PROBE_MASK
#define PROBE_MASK 0
#endif
#ifndef TPROBE_KIND
#define TPROBE_KIND (-1)
#endif
#ifndef TPROBE_MODE
#define TPROBE_MODE 2
#endif
struct Args { const float* in[16]; float* out; unsigned char* ws; int ph_lo, ph_hi; };
constexpr int N_PHASES = 26;
enum Kind { K_P0, K_E1, K_E2, K_E3, K_E4, K_RESMIX, K_F1, K_RESFFN, K_O1, K_O2, K_FINAL };
__device__ __forceinline__ void decode_phase(int p, int& kind, int& layer) {
    if (p == 0) { kind = K_P0; layer = 0; return; }
    if (p == 25) { kind = K_FINAL; layer = 0; return; }
    int q = p - 1; const int pair = q / 12; q -= pair * 12;
    if (q < 7) { layer = 2 * pair; kind = q == 0 ? K_E1 : q == 1 ? K_E2 : q == 2 ? K_E3 : q == 3 ? K_E4 : q == 4 ? K_RESMIX : q == 5 ? K_F1 : K_RESFFN; }
    else { layer = 2 * pair + 1; q -= 7; kind = q == 0 ? K_O1 : q == 1 ? K_O2 : q == 2 ? K_RESMIX : q == 3 ? K_F1 : K_RESFFN; }
}
__global__ void __launch_bounds__(NWAVES * 64, 2) trunk_fwd(Args args) {
    extern __shared__ __attribute__((aligned(16))) unsigned char lds[];
    Frame F;
    F.lds = (LAS unsigned char*)lds;
    F.MISC = (volatile LAS unsigned*)(F.lds + MISC_OFF);
    F.G = gridDim.x; { const int bx = blockIdx.x; F.vcu = (F.G % 8 == 0) ? (bx % 8) * (F.G / 8) + bx / 8 : bx; }
    F.ws = args.ws; F.ctl = (gu32*)(args.ws + WS_CTL); F.x = args.out;
#pragma unroll
    for (int i = 0; i < 16; ++i) F.in[i] = args.in[i];
    for (int u = threadIdx.x; u < (LDS_BYTES - LDSCTL_OFF) / 4; u += NWAVES * 64) ((LAS unsigned*)(F.lds + LDSCTL_OFF))[u] = 0u;
    __syncthreads();
    XcdBarrier bar; bar.bar = (unsigned*)(F.ctl + CW_BAR); bar.x = 0; bar.st = nullptr;
    if (!MK_PER_PHASE) bar = xcd_barrier_post((unsigned*)(F.ctl + CW_BAR), F.MISC + 8);
    bf16* xb = (bf16*)(F.ws + WS_XB); bf16* Yb = (bf16*)(F.ws + WS_Y); bf16* big = (bf16*)(F.ws + WS_BIG);
    float* sq16 = (float*)(F.ws + WS_SQ);
    unsigned long long tpacc = 0;
    for (int p = args.ph_lo; p < args.ph_hi; ++p) {
        int kind, layer; decode_phase(p, kind, layer);
        const int j = layer >> 1;
        const int reps = ((PROBE_MASK >> kind) & 1) ? 2 : 1;
        unsigned long long tp0 = 0, tp1 = 0; if (TPROBE_KIND >= 0) tp0 = (TPROBE_MODE == 3) ? __builtin_amdgcn_s_memtime() : __builtin_amdgcn_s_memrealtime();
        for (int rep = 0; rep < reps; ++rep) {
        if (kind == K_P0) { p0_prologue(F, F.in[0]); }
        else if (kind == K_E1) {
            pg8::Gemm g{xb, (const bf16*)(F.ws + WS_WEI) + (size_t)j * EVEN_NP * DM, M, EVEN_NP, DM}; pg8::StaticOrder S; S.init(M, EVEN_NP, F.G, (int)blockIdx.x);
            pg8::EpiEvenIn E{big, sq16, (float*)(F.ws + WS_GATES), F.in[5] + (size_t)j * 8};
            pg8::gemm_phase<pg8::EpiEvenIn, pg8::StaticOrder, true, true>(F.lds, g, S, E);
        }
        else if (kind == K_E2) { mlstm_phase_a(F); }
        else if (kind == K_E3) { mlstm_scan_and_conv(F, F.in[4] + (size_t)j * 3 * CD); }
        else if (kind == K_E4) { mlstm_phase_c(F, F.in[6] + (size_t)j * MD); }
        else if (kind == K_RESMIX || kind == K_RESFFN) {
            const bool ffn = kind == K_RESFFN, odd = layer & 1;
            const bf16* A = ffn ? big : Yb;
            const bf16* Bt = ffn ? (const bf16*)(F.ws + WS_WFO) + (size_t)layer * DM * DFF : odd ? (const bf16*)(F.ws + WS_WOO) + (size_t)j * DM * DM : (const bf16*)(F.ws + WS_WEO) + (size_t)j * DM * DM;
            pg8::Gemm g{A, Bt, M, DM, ffn ? DFF : DM}; pg8::StaticOrder S; S.init(M, DM, F.G, (int)blockIdx.x);
            pg8::EpiResid E{xb, (LAS float*)(F.lds + SQS_OFF)};
            pg8::gemm_phase<pg8::EpiResid, pg8::StaticOrder, false, true>(F.lds, g, S, E);
            __syncthreads();
            { OPQ_TID(); (void)lane; pg8::Unit u0; if (S.next(0, u0) && tid < 256) { const f32x4 q = *(const LAS f32x4*)(F.lds + SQS_OFF + tid * 16);
                sq16[(size_t)(u0.pm * 256 + tid) * 4 + u0.pn] = (q[0] + q[1]) + (q[2] + q[3]); } }
        }
        else if (kind == K_F1) {
            pg8::Gemm g{xb, (const bf16*)(F.ws + WS_WFI) + (size_t)layer * 2 * DFF * DM, M, 2 * DFF, DM}; pg8::StaticOrder S; S.init(M, 2 * DFF, F.G, (int)blockIdx.x);
            pg8::EpiSwiGLU E{big, sq16};
            pg8::gemm_phase<pg8::EpiSwiGLU, pg8::StaticOrder, true, true>(F.lds, g, S, E);
            if (layer + 1 < DEPTH && rep == 0 && blockIdx.x >= 128) { __syncthreads(); convert_layer(F, layer + 1, ((int)blockIdx.x - 128) * NWAVES, (F.G - 128) * NWAVES); }
        }
        else if (kind == K_O1) {
            pg8::Gemm g{xb, (const bf16*)(F.ws + WS_WOI) + (size_t)j * 2048 * DM, M, 2048, DM}; pg8::StaticOrder S; S.init(M, 2048, F.G, (int)blockIdx.x);
            pg8::EpiGeluZ E{big, sq16, (float*)(F.ws + WS_VSQ)};
            pg8::gemm_phase<pg8::EpiGeluZ, pg8::StaticOrder, true, true>(F.lds, g, S, E);
        }
        else if (kind == K_O2) { sgu_phase(F, F.in[9] + (size_t)j * DM, F.in[10] + (size_t)j * 8 * CHUNK * CHUNK, F.in[11] + (size_t)j * 8 * CHUNK); }
        else { final_norm(F); }
        if (rep + 1 < reps) xcd_barrier(bar);
        }
        if (TPROBE_KIND >= 0) tp1 = (TPROBE_MODE == 3) ? __builtin_amdgcn_s_memtime() : __builtin_amdgcn_s_memrealtime();
        if (p + 1 < args.ph_hi) xcd_barrier(bar);
        if (TPROBE_KIND >= 0) { const unsigned long long tp2 = __builtin_amdgcn_s_memrealtime(); if (kind == TPROBE_KIND || TPROBE_KIND == 99) tpacc += (TPROBE_MODE == 0) ? (tp1 - tp0) : (TPROBE_MODE == 1) ? (tp2 - tp1) : (TPROBE_MODE == 3) ? ((tp1 - tp0) >> 7) : (tp2 - tp0); }
    }
    if (TPROBE_KIND >= 0 && blockIdx.x == 0 && threadIdx.x == 0) { const unsigned long long t0 = __builtin_amdgcn_s_memrealtime(); while (__builtin_amdgcn_s_memrealtime() - t0 < 8ull * tpacc) __builtin_amdgcn_s_sleep(8); }
}

extern "C" void kernel_launch(void* const* d_in, const int* in_sizes, int n_in, void* d_out, int out_size, void* d_ws, size_t ws_size, hipStream_t stream) {
    static int grid = 0;
    if (grid == 0) {
        if (n_in != 16 || in_sizes[0] != M * DM || out_size != M * DM || ws_size < WS_END) { fprintf(stderr, "kernel_launch: unexpected shapes / workspace (n_in %d, ws %zu < %zu); nothing launched\n", n_in, ws_size, (size_t)WS_END); grid = -1; return; }
        int dev = 0, cus = 0, per_cu = 0;
        if (hipGetDevice(&dev) != hipSuccess || hipDeviceGetAttribute(&cus, hipDeviceAttributeMultiprocessorCount, dev) != hipSuccess) { grid = -1; return; }
        if (hipFuncSetAttribute((const void*)trunk_fwd, hipFuncAttributeMaxDynamicSharedMemorySize, LDS_BYTES) != hipSuccess) { fprintf(stderr, "kernel_launch: hipFuncSetAttribute failed\n"); grid = -1; return; }
        if (hipOccupancyMaxActiveBlocksPerMultiprocessor(&per_cu, (const void*)trunk_fwd, NWAVES * 64, LDS_BYTES) != hipSuccess || per_cu < 1) fprintf(stderr, "kernel_launch: note: occupancy query says %d\n", per_cu);
        (void)hipGetLastError();
        grid = cus;
    }
    if (grid < 0) return;
    if (hipMemsetAsync((char*)d_ws + WS_CTL, 0, CTL_ZERO_BYTES, stream) != hipSuccess) return;
    Args a{};
    for (int i = 0; i < 16; ++i) a.in[i] = (const float*)d_in[i];
    a.out = (float*)d_out; a.ws = (unsigned char*)d_ws;
#if MK_PER_PHASE
    for (int p = 0; p < N_PHASES; ++p) { a.ph_lo = p; a.ph_hi = p + 1; hipLaunchKernelGGL(trunk_fwd, dim3(grid), dim3(NWAVES * 64), LDS_BYTES, stream, a); }
#else
    a.ph_lo = 0; a.ph_hi = N_PHASES; hipLaunchKernelGGL(trunk_fwd, dim3(grid), dim3(NWAVES * 64), LDS_BYTES, stream, a);
#endif
}
```

```cpp
#include <hip/hip_runtime.h>
#include <cstdio>
#include <cstdint>
#define MK_PER_PHASE 0
#define PG8_WT 2
namespace pg8 {
#define PG8_LAS __attribute__((address_space(3)))
typedef unsigned short bf16_t;
typedef short bf16x8 __attribute__((ext_vector_type(8)));
typedef float f32x4 __attribute__((ext_vector_type(4)));
typedef unsigned u32x4 __attribute__((ext_vector_type(4)));
constexpr int BM = 256, BK = 64, HALF = 128, HTB = HALF * BK * 2  , STAGE_BYTES = 8 * HTB, NXCD = 8, WGM = 8;

__host__ __device__ __forceinline__ int lds_byte(int r, int c) { const int st = (r >> 4) * 2 + (c >> 5), rr = r & 15, cc = c & 31, ob = rr * 64 + cc * 2; return st * 1024 + (ob ^ (((ob >> 9) & 1) << 5)); }
__host__ __device__ __forceinline__ void stage_rc(int b, int& R, int& C) { const int st = b / 1024, sb = b % 1024, swz = sb ^ (((sb >> 9) & 1) << 5); R = (st >> 1) * 16 + swz / 64; C = (st & 1) * 32 + (swz % 64) / 2; }
__host__ __device__ __forceinline__ int perm32(int rho) { const int n = rho >> 4, i = rho & 15; return 8 * (i >> 2) + 4 * n + (i & 3); }

struct Unit { int pm, pn; int wt; };
struct Gemm { const bf16_t* A; const bf16_t* Bt; int M, N, K; };

struct StaticOrder {
    int nM, nN, nwg, G, c;
    __host__ __device__ void init(int M, int N, int G_, int c_) { nM = M / BM; nN = N / BM; nwg = nM * nN; G = G_; c = c_; }
    __host__ __device__ bool next(int i, Unit& u) const {
        const long L = (long)i * G + c; if (L >= nwg) return false;
        int wgid = (int)L; { const int q = nwg / NXCD, r = nwg % NXCD, xcd = wgid % NXCD, off = wgid / NXCD; wgid = (xcd < r ? xcd * (q + 1) : r * (q + 1) + (xcd - r) * q) + off; }
        const int nig = WGM * nN, gid = wgid / nig, fm = gid * WGM, gsz = (nM - fm) < WGM ? (nM - fm) : WGM;
        u.pm = fm + ((wgid % nig) % gsz); u.pn = (wgid % nig) / gsz; return true;
    }
    __device__ __forceinline__ void a_ready(const Unit&) const {}
    __device__ __forceinline__ void done(const Unit&) const {}
};

typedef __bf16 hwbf16x2_ __attribute__((ext_vector_type(2)));
typedef float f32x2_ __attribute__((ext_vector_type(2)));
__device__ __forceinline__ unsigned cvt_pk_bf16(float lo, float hi) { const f32x2_ v = {lo, hi}; return __builtin_bit_cast(unsigned, __builtin_convertvector(v, hwbf16x2_)); }
typedef float f32x2 __attribute__((ext_vector_type(2)));
constexpr float RMS_EPS_F = 1e-6f;
typedef unsigned u32x2 __attribute__((ext_vector_type(2)));
__device__ __forceinline__ float row_rstd4(const float* sq4, int row) {
    const f32x4 a = *(const f32x4*)(sq4 + (size_t)row * 4);
    return __builtin_amdgcn_rsqf(((a[0] + a[1]) + (a[2] + a[3])) * (1.0f / 1024.0f) + RMS_EPS_F);
}
__device__ __forceinline__ float row_rstd16(const float* sq16, int row) {
    const f32x4* p = (const f32x4*)(sq16 + (size_t)row * 16);
    const f32x4 a = p[0], b = p[1], c = p[2], d = p[3];
    const float s = ((a[0] + a[1]) + (a[2] + a[3])) + ((b[0] + b[1]) + (b[2] + b[3])) + ((c[0] + c[1]) + (c[2] + c[3])) + ((d[0] + d[1]) + (d[2] + d[3]));
    return __builtin_amdgcn_rsqf(s * (1.0f / 1024.0f) + RMS_EPS_F);
}
__device__ __forceinline__ float bf_lo(unsigned w) { return __builtin_bit_cast(float, w << 16); }
__device__ __forceinline__ float bf_hi(unsigned w) { return __builtin_bit_cast(float, w & 0xffff0000u); }
#ifndef PG8_WT
#define PG8_WT 1
#endif
__device__ __forceinline__ void st16(bf16_t* base, size_t elem_off, u32x4 v, int wt) {
#if PG8_WT == 1
    __builtin_amdgcn_raw_buffer_store_b128(v, __builtin_amdgcn_make_buffer_rsrc((void*)base, (short)0, 0x7fffffff, 0x00020000), (unsigned)(elem_off * 2), 0, 16);
#elif PG8_WT == 2
    if (wt) __builtin_amdgcn_raw_buffer_store_b128(v, __builtin_amdgcn_make_buffer_rsrc((void*)base, (short)0, 0x7fffffff, 0x00020000), (unsigned)(elem_off * 2), 0, 16);
    else __builtin_amdgcn_raw_buffer_store_b128(v, __builtin_amdgcn_make_buffer_rsrc((void*)base, (short)0, 0x7fffffff, 0x00020000), (unsigned)(elem_off * 2), 0, 0);
#else
    *(u32x4*)(base + elem_off) = v;
#endif
}
__device__ __forceinline__ float fast_sigmoid(float x) { return __builtin_amdgcn_rcpf(1.0f + __expf(-x)); }
struct EpiEvenIn {
    static constexpr bool PERM = true, AFTER_DRAIN = false;
    bf16_t* O; const float* sq16; float* gates; const float* bgate;
    __device__ __forceinline__ void operator()(const f32x4 (&acc)[2][2][4][2], const Unit& u, int wr, int wc, int fr, int fq) const {
        const int row0 = u.pm * BM + wr * 64 + fr;
        if (u.pn < 14) {
            const int col0 = u.pn * BM + wc * 32 + 8 * fq;
#pragma unroll
            for (int ai = 0; ai < 2; ++ai)
#pragma unroll
                for (int m = 0; m < 4; ++m) { const int row = row0 + ai * HALF + m * 16; const float r = row_rstd4(sq16, row); const size_t ro = (size_t)row * 3584 + col0;
#pragma unroll
                    for (int bj = 0; bj < 2; ++bj) { const f32x4 v0 = acc[ai][bj][m][0] * r, v1 = acc[ai][bj][m][1] * r;
                        u32x4 w; w.x = cvt_pk_bf16(v0[0], v0[1]); w.y = cvt_pk_bf16(v0[2], v0[3]); w.z = cvt_pk_bf16(v1[0], v1[1]); w.w = cvt_pk_bf16(v1[2], v1[3]);
                        st16(O, ro + bj * HALF, w, u.wt); } }
        } else if (wc == 0 && fq == 0) {
            const f32x4 b0 = *(const f32x4*)(bgate), b1 = *(const f32x4*)(bgate + 4);
#pragma unroll
            for (int ai = 0; ai < 2; ++ai)
#pragma unroll
                for (int m = 0; m < 4; ++m) { const int row = row0 + ai * HALF + m * 16; const float r = row_rstd4(sq16, row);
                    *(f32x4*)(gates + (size_t)row * 8) = acc[ai][0][m][0] * r + b0; *(f32x4*)(gates + (size_t)row * 8 + 4) = acc[ai][0][m][1] * r + b1; }
        }
    }
};
struct EpiResid {
    static constexpr bool PERM = true, AFTER_DRAIN = false;
    bf16_t* xb; PG8_LAS float* sqs;
    __device__ __forceinline__ void operator()(const f32x4 (&acc)[2][2][4][2], const Unit& u, int wr, int wc, int fr, int fq) const {
        const int rl0 = wr * 64 + fr, col0 = u.pn * BM + wc * 32 + 8 * fq;
        const bf16_t* base = xb + (size_t)(u.pm * BM + rl0) * 1024 + col0;
        u32x4 o[2][4][2];
#pragma unroll
        for (int ai = 0; ai < 2; ++ai)
#pragma unroll
            for (int m = 0; m < 4; ++m)
#pragma unroll
                for (int bj = 0; bj < 2; ++bj) o[ai][m][bj] = *(const u32x4*)(base + (size_t)(ai * HALF + m * 16) * 1024 + bj * HALF);
#pragma unroll
        for (int ai = 0; ai < 2; ++ai)
#pragma unroll
            for (int m = 0; m < 4; ++m) { const int rl = rl0 + ai * HALF + m * 16; float ss = 0.f;
#pragma unroll
                for (int bj = 0; bj < 2; ++bj) { const u32x4 ov = o[ai][m][bj];
                    const f32x4 v0 = acc[ai][bj][m][0] + (f32x4){bf_lo(ov.x), bf_hi(ov.x), bf_lo(ov.y), bf_hi(ov.y)}, v1 = acc[ai][bj][m][1] + (f32x4){bf_lo(ov.z), bf_hi(ov.z), bf_lo(ov.w), bf_hi(ov.w)};
                    u32x4 w; w.x = cvt_pk_bf16(v0[0], v0[1]); w.y = cvt_pk_bf16(v0[2], v0[3]); w.z = cvt_pk_bf16(v1[0], v1[1]); w.w = cvt_pk_bf16(v1[2], v1[3]);
                    st16(xb, (size_t)(u.pm * BM + rl) * 1024 + col0 + bj * HALF, w, u.wt);
                    ss += ((v0[0] * v0[0] + v0[1] * v0[1]) + (v0[2] * v0[2] + v0[3] * v0[3])) + ((v1[0] * v1[0] + v1[1] * v1[1]) + (v1[2] * v1[2] + v1[3] * v1[3])); }
                ss += __shfl_xor(ss, 16); ss += __shfl_xor(ss, 32);
                if (fq == 0) sqs[rl * 4 + wc] = ss; }
    }
};
struct EpiSwiGLU {
    static constexpr bool PERM = true, AFTER_DRAIN = false;
    bf16_t* O; const float* sq16;
    __device__ __forceinline__ void operator()(const f32x4 (&acc)[2][2][4][2], const Unit& u, int wr, int wc, int fr, int fq) const {
        const int row0 = u.pm * BM + wr * 64 + fr, col0 = u.pn * HALF + wc * 32 + 8 * fq;
        float rr[2][4];
#pragma unroll
        for (int ai = 0; ai < 2; ++ai)
#pragma unroll
            for (int m = 0; m < 4; ++m) rr[ai][m] = row_rstd4(sq16, row0 + ai * HALF + m * 16);
#pragma unroll
        for (int ai = 0; ai < 2; ++ai)
#pragma unroll
            for (int m = 0; m < 4; ++m) { const int row = row0 + ai * HALF + m * 16; const float r = rr[ai][m]; const float r2 = r * r, rl = r * -1.4426950408889634f;
                unsigned pk[4];
#pragma unroll
                for (int n = 0; n < 2; ++n)
#pragma unroll
                    for (int hh = 0; hh < 2; ++hh) { const f32x2 g = {acc[ai][0][m][n][2 * hh], acc[ai][0][m][n][2 * hh + 1]}, up = {acc[ai][1][m][n][2 * hh], acc[ai][1][m][n][2 * hh + 1]};
                        const f32x2 t = g * rl; f32x2 d; d.x = __builtin_amdgcn_exp2f(t.x); d.y = __builtin_amdgcn_exp2f(t.y); d = d + 1.0f;
                        f32x2 rc; rc.x = __builtin_amdgcn_rcpf(d.x); rc.y = __builtin_amdgcn_rcpf(d.y);
                        const f32x2 h = ((g * up) * r2) * rc; pk[2 * n + hh] = cvt_pk_bf16(h.x, h.y); }
                u32x4 w; w.x = pk[0]; w.y = pk[1]; w.z = pk[2]; w.w = pk[3];
                st16(O, (size_t)row * 2816 + col0, w, u.wt); }
    }
};
struct EpiGeluZ {
    static constexpr bool PERM = true, AFTER_DRAIN = false;
    bf16_t* O; const float* sq16; float* vsq16;
    __device__ __forceinline__ void operator()(const f32x4 (&acc)[2][2][4][2], const Unit& u, int wr, int wc, int fr, int fq) const {
        const int row0 = u.pm * BM + wr * 64 + fr, col0 = u.pn * BM + wc * 32 + 8 * fq;
        constexpr float GA = -2.3022082f, GB = -0.10294324f;
        float rr[2][4];
#pragma unroll
        for (int ai = 0; ai < 2; ++ai)
#pragma unroll
            for (int m = 0; m < 4; ++m) rr[ai][m] = row_rstd4(sq16, row0 + ai * HALF + m * 16);
#pragma unroll
        for (int ai = 0; ai < 2; ++ai)
#pragma unroll
            for (int m = 0; m < 4; ++m) { const int row = row0 + ai * HALF + m * 16; const float r = rr[ai][m]; f32x2 ss = {0.f, 0.f};
#pragma unroll
                for (int bj = 0; bj < 2; ++bj) { unsigned pk[4];
#pragma unroll
                    for (int n = 0; n < 2; ++n)
#pragma unroll
                        for (int hh = 0; hh < 2; ++hh) { const f32x2 v = (f32x2){acc[ai][bj][m][n][2 * hh], acc[ai][bj][m][n][2 * hh + 1]} * r;
                            const f32x2 p = v * ((v * v) * GB + GA); f32x2 d; d.x = __builtin_amdgcn_exp2f(p.x); d.y = __builtin_amdgcn_exp2f(p.y); d = d + 1.0f;
                            f32x2 rc; rc.x = __builtin_amdgcn_rcpf(d.x); rc.y = __builtin_amdgcn_rcpf(d.y);
                            const f32x2 z = v * rc; ss = z * z + ss; pk[2 * n + hh] = cvt_pk_bf16(z.x, z.y); }
                    u32x4 w; w.x = pk[0]; w.y = pk[1]; w.z = pk[2]; w.w = pk[3];
                    st16(O, (size_t)row * 2048 + col0 + bj * HALF, w, u.wt); }
                if (u.pn >= 4) { float s1 = ss.x + ss.y; s1 += __shfl_xor(s1, 16); s1 += __shfl_xor(s1, 32); if (fq == 0) vsq16[(size_t)row * 16 + (u.pn - 4) * 4 + wc] = s1; } }
    }
};
template <class Epi, class Sched, bool ALIGN_EPI = false, bool SP2 = false>
__device__ __forceinline__ void gemm_phase(PG8_LAS unsigned char* lds, const Gemm g, const Sched& S, const Epi& E) {
    int tid_ = threadIdx.x; asm volatile("" : "+v"(tid_)); const int tid = tid_, wid = __builtin_amdgcn_readfirstlane(tid >> 6), lane = tid & 63, wr = wid >> 2, wc = wid & 3, fr = lane & 15, fq = lane >> 4;
    const int K = g.K, nt = K / BK;
    unsigned voffA[2], voffB[2];
#pragma unroll
    for (int i = 0; i < 2; ++i) { int R, C; stage_rc(tid * 16 + i * 8192, R, C); const int Rb = Epi::PERM ? ((R & ~31) + perm32(R & 31)) : R;
        voffA[i] = (unsigned)(R * K + C) * 2u; voffB[i] = (unsigned)(Rb * K + C) * 2u; }
    const size_t kstep = (size_t)(BK * 2);
    const size_t hstep = (size_t)HALF * K * 2;
    const size_t tstep = 2 * hstep;
    const unsigned ldsw = (unsigned)wid * 1024u;
    const int aoff = lds_byte(wr * 64 + fr, fq * 8), boff = lds_byte(wc * 32 + fr, fq * 8);
#define PG8_SA(b, h) (((b) * 2 + (h)) * HTB)
#define PG8_SB(b, h) ((4 + (b) * 2 + (h)) * HTB)
#define PG8_STAGE(bufoff, gbase, voff) do { _Pragma("unroll") for (int _i = 0; _i < 2; ++_i) \
        __builtin_amdgcn_global_load_lds((const unsigned*)((const char*)(gbase) + (voff)[_i]), (PG8_LAS unsigned*)(lds + (bufoff) + ldsw + _i * 8192), 16, 0, 0); } while (0)
#define PG8_LDA(dst, b, h) do { _Pragma("unroll") for (int m = 0; m < 4; ++m) _Pragma("unroll") for (int k = 0; k < 2; ++k) dst[m][k] = *(const PG8_LAS bf16x8*)(lds + PG8_SA(b, h) + aoff + m * 2048 + k * 1024); } while (0)
#define PG8_LDB(dst, b, h) do { _Pragma("unroll") for (int n = 0; n < 2; ++n) _Pragma("unroll") for (int k = 0; k < 2; ++k) dst[n][k] = *(const PG8_LAS bf16x8*)(lds + PG8_SB(b, h) + boff + n * 2048 + k * 1024); } while (0)
#define PG8_MMA(ai, bj, At, Bt) do { __builtin_amdgcn_s_setprio(1); _Pragma("unroll") for (int m = 0; m < 4; ++m) _Pragma("unroll") for (int n = 0; n < 2; ++n) _Pragma("unroll") for (int k = 0; k < 2; ++k) \
        acc[ai][bj][m][n] = __builtin_amdgcn_mfma_f32_16x16x32_bf16(Bt[n][k], At[m][k], acc[ai][bj][m][n], 0, 0, 0); __builtin_amdgcn_s_setprio(0); } while (0)
#define PG8_WAIT_V(n) asm volatile("s_waitcnt vmcnt(" #n ")" ::: "memory")
#define PG8_WAIT_L(n) asm volatile("s_waitcnt lgkmcnt(" #n ")" ::: "memory")
#define PG8_BAR __builtin_amdgcn_s_barrier()
#define PG8_SCHED __builtin_amdgcn_sched_barrier(0)
    Unit cur, nxt; int ui = 0;
    if (!S.next(0, cur)) return;
    f32x4 acc[2][2][4][2];
#pragma unroll
    for (int a = 0; a < 2; ++a)
#pragma unroll
        for (int b = 0; b < 2; ++b)
#pragma unroll
            for (int m = 0; m < 4; ++m)
#pragma unroll
                for (int n = 0; n < 2; ++n) acc[a][b][m][n] = (f32x4){0.f, 0.f, 0.f, 0.f};
    bf16x8 At[4][2], B0[2][2], B1[2][2];
    const char* cA = (const char*)g.A + (size_t)cur.pm * tstep; const char* cB = (const char*)g.Bt + (size_t)cur.pn * tstep;
    S.a_ready(cur);
    if constexpr (SP2) {
        PG8_STAGE(PG8_SB(0, 0), cB, voffB); PG8_STAGE(PG8_SB(0, 1), cB + hstep, voffB); PG8_STAGE(PG8_SA(0, 0), cA, voffA); PG8_STAGE(PG8_SA(0, 1), cA + hstep, voffA);
        if (wr == 1) PG8_BAR;
        PG8_WAIT_V(2); PG8_BAR;
        PG8_STAGE(PG8_SB(1, 0), cB + kstep, voffB); PG8_STAGE(PG8_SA(1, 0), cA + kstep, voffA); PG8_STAGE(PG8_SB(1, 1), cB + hstep + kstep, voffB);
        PG8_WAIT_V(6); PG8_BAR;
    } else {
        PG8_STAGE(PG8_SB(0, 0), cB, voffB); PG8_STAGE(PG8_SA(0, 0), cA, voffA); PG8_STAGE(PG8_SB(0, 1), cB + hstep, voffB); PG8_STAGE(PG8_SA(0, 1), cA + hstep, voffA);
        if (wr == 1) PG8_BAR;
        PG8_WAIT_V(4); PG8_BAR;
        PG8_STAGE(PG8_SB(1, 0), cB + kstep, voffB); PG8_STAGE(PG8_SA(1, 0), cA + kstep, voffA); PG8_STAGE(PG8_SB(1, 1), cB + hstep + kstep, voffB);
        PG8_WAIT_V(6); PG8_BAR;
    }
    for (;;) {
        const bool has_next = S.next(ui + 1, nxt); cur.wt = has_next ? 0 : 1;
        const char* nA = has_next ? (const char*)g.A + (size_t)nxt.pm * tstep : cA; const char* nB = has_next ? (const char*)g.Bt + (size_t)nxt.pn * tstep : cB;
        for (int t = 0; t < nt; t += 2) {
            const bool last = (t == nt - 2);
            const char* a1 = cA + (size_t)(t + 1) * kstep;
            const char* a2 = last ? nA : cA + (size_t)(t + 2) * kstep; const char* b2 = last ? nB : cB + (size_t)(t + 2) * kstep;
            const char* a3 = a2 + kstep; const char* b3 = b2 + kstep;
            if (last && has_next) S.a_ready(nxt);
            if constexpr (SP2) {
            PG8_LDB(B0, 0, 0); PG8_LDB(B1, 0, 1); PG8_SCHED; PG8_LDA(At, 0, 0); PG8_STAGE(PG8_SA(1, 1), a1 + hstep, voffA);
            PG8_WAIT_V(8); PG8_WAIT_L(0); PG8_BAR; PG8_MMA(0, 0, At, B0); PG8_MMA(0, 1, At, B1); PG8_BAR; PG8_SCHED;
            PG8_LDA(At, 0, 1); PG8_STAGE(PG8_SB(0, 0), b2, voffB); PG8_STAGE(PG8_SB(0, 1), b2 + hstep, voffB); PG8_STAGE(PG8_SA(0, 0), a2, voffA);
            PG8_WAIT_V(8); PG8_WAIT_L(0); PG8_BAR; PG8_MMA(1, 0, At, B0); PG8_MMA(1, 1, At, B1); PG8_BAR; PG8_SCHED;
            PG8_LDB(B0, 1, 0); PG8_LDB(B1, 1, 1); PG8_SCHED; PG8_LDA(At, 1, 0); PG8_STAGE(PG8_SA(0, 1), a2 + hstep, voffA);
            PG8_WAIT_V(8); PG8_WAIT_L(0); PG8_BAR; PG8_MMA(0, 0, At, B0); PG8_MMA(0, 1, At, B1); PG8_BAR; PG8_SCHED;
            PG8_LDA(At, 1, 1); PG8_STAGE(PG8_SB(1, 0), b3, voffB); PG8_STAGE(PG8_SB(1, 1), b3 + hstep, voffB); PG8_STAGE(PG8_SA(1, 0), a3, voffA);
            PG8_WAIT_V(8); PG8_WAIT_L(0); PG8_BAR; PG8_MMA(1, 0, At, B0); PG8_MMA(1, 1, At, B1); PG8_BAR; PG8_SCHED;
            } else {
            PG8_LDB(B0, 0, 0); PG8_SCHED; PG8_LDA(At, 0, 0); PG8_STAGE(PG8_SA(1, 1), a1 + hstep, voffA);
            PG8_WAIT_L(8); PG8_BAR; PG8_WAIT_L(0); PG8_MMA(0, 0, At, B0); PG8_BAR; PG8_SCHED;
            PG8_LDB(B1, 0, 1); PG8_STAGE(PG8_SB(0, 0), b2, voffB);
            PG8_BAR; PG8_WAIT_L(0); PG8_MMA(0, 1, At, B1); PG8_BAR;
            PG8_LDA(At, 0, 1); PG8_STAGE(PG8_SA(0, 0), a2, voffA);
            PG8_BAR; PG8_WAIT_L(0); PG8_MMA(1, 0, At, B0); PG8_BAR; PG8_SCHED;
            PG8_STAGE(PG8_SB(0, 1), b2 + hstep, voffB);
            PG8_WAIT_V(6); PG8_BAR; PG8_MMA(1, 1, At, B1); PG8_BAR;
            PG8_LDB(B0, 1, 0); PG8_SCHED; PG8_LDA(At, 1, 0); PG8_STAGE(PG8_SA(0, 1), a2 + hstep, voffA);
            PG8_WAIT_L(8); PG8_BAR; PG8_WAIT_L(0); PG8_MMA(0, 0, At, B0); PG8_BAR; PG8_SCHED;
            PG8_LDB(B1, 1, 1); PG8_STAGE(PG8_SB(1, 0), b3, voffB);
            PG8_BAR; PG8_WAIT_L(0); PG8_MMA(0, 1, At, B1); PG8_BAR;
            PG8_LDA(At, 1, 1); PG8_STAGE(PG8_SA(1, 0), a3, voffA);
            PG8_BAR; PG8_WAIT_L(0); PG8_MMA(1, 0, At, B0); PG8_BAR; PG8_SCHED;
            PG8_STAGE(PG8_SB(1, 1), b3 + hstep, voffB);
            PG8_WAIT_V(6); PG8_BAR; PG8_MMA(1, 1, At, B1); PG8_BAR;
            }
        }
        if constexpr (ALIGN_EPI) { if (wr == 0) PG8_BAR; }
        if constexpr (!Epi::AFTER_DRAIN) { E(acc, cur, wr, wc, fr, fq); S.done(cur); }
        if (!has_next) break;
#pragma unroll
        for (int a = 0; a < 2; ++a)
#pragma unroll
            for (int b = 0; b < 2; ++b)
#pragma unroll
                for (int m = 0; m < 4; ++m)
#pragma unroll
                    for (int n = 0; n < 2; ++n) acc[a][b][m][n] = (f32x4){0.f, 0.f, 0.f, 0.f};
        cur = nxt; cA = nA; cB = nB; ++ui;
        if constexpr (ALIGN_EPI) { if (wr == 1) PG8_BAR; }
    }
    PG8_WAIT_V(0);
    if constexpr (!ALIGN_EPI) { if (wr == 0) PG8_BAR; }
    PG8_BAR;
    if constexpr (Epi::AFTER_DRAIN) { E.fused(acc, cur, wr, wc, fr, fq, lds, wid, lane); S.done(cur); }
#undef PG8_SA
#undef PG8_SB
#undef PG8_STAGE
#undef PG8_LDA
#undef PG8_LDB
#undef PG8_MMA
#undef PG8_WAIT_V
#undef PG8_WAIT_L
#undef PG8_BAR
#undef PG8_SCHED
}
}
constexpr int NWAVES = 8;
#ifndef MK_PER_PHASE
#define MK_PER_PHASE 0
#endif
constexpr int DM = 1024, NB = 2, SEQ = 8192, M = NB * SEQ, DEPTH = 4;
constexpr int CD = 512, HEADS = 4, HD = 128, MD = 512, EVEN_IN = 3592, EVEN_NP = 3840, EVEN_W = 3584, DFF = 2816, CHUNK = 128, NCH = SEQ / CHUNK, NUNIT = NB * HEADS * NCH;
constexpr float RMS_EPS = 1e-6f;
constexpr size_t MiB = 1u << 20;
constexpr size_t WS_CTL = 0, CTL_ZERO_BYTES = 1 * MiB;
constexpr size_t WS_SQ = 1 * MiB;
constexpr size_t WS_VSQ = 2 * MiB;
constexpr size_t WS_GATES = 3 * MiB;
constexpr size_t WS_NLOC = 4 * MiB;
constexpr size_t WS_NIN = 4 * MiB + 256 * 1024;
constexpr size_t WS_MLOC = 4 * MiB + 512 * 1024;
constexpr size_t WS_BL = WS_MLOC + 4096;
constexpr size_t WS_MIN = WS_BL + 4096;
constexpr size_t WS_WEI = 5 * MiB;
constexpr size_t WS_WEO = 20 * MiB;
constexpr size_t WS_WOI = 24 * MiB;
constexpr size_t WS_WOO = 32 * MiB;
constexpr size_t WS_WFI = 36 * MiB;
constexpr size_t WS_WFO = 80 * MiB;
constexpr size_t WS_XB = 102 * MiB;
constexpr size_t WS_Y = 134 * MiB;
constexpr size_t WS_BIG = 166 * MiB;
constexpr size_t WS_CLOC = 278 * MiB;
constexpr size_t WS_CIN = 310 * MiB;
constexpr size_t WS_END = 326 * MiB;
constexpr int CW_BAR = 4096;
constexpr int RING_BYTES = 131072;
constexpr int SQS_OFF = RING_BYTES;
constexpr int LDS_BYTES = 163840;
constexpr int LDSCTL_OFF = LDS_BYTES - 512, MISC_OFF = LDSCTL_OFF + 320;
constexpr int TSTR = 272;
constexpr int TILE_B = 128 * TSTR;
#define GAS __attribute__((address_space(1)))
#define LAS __attribute__((address_space(3)))
typedef unsigned short bf16;
typedef unsigned v4u __attribute__((ext_vector_type(4)));
typedef float f32x4 __attribute__((ext_vector_type(4)));
typedef short bf16x8 __attribute__((ext_vector_type(8)));
typedef GAS unsigned gu32;
typedef GAS unsigned long long gu64;
#define RLX_AGENT __ATOMIC_RELAXED, __HIP_MEMORY_SCOPE_AGENT
#define LDS_WAIT() asm volatile("s_waitcnt lgkmcnt(0)" ::: "memory")
#define VM_WAIT() asm volatile("s_waitcnt vmcnt(0)" ::: "memory")
__device__ __forceinline__ unsigned long long rt() { return __builtin_amdgcn_s_memrealtime(); }
typedef __bf16 hwbf16x2 __attribute__((ext_vector_type(2)));
typedef float f32x2h __attribute__((ext_vector_type(2)));
__device__ __forceinline__ unsigned pk2(float lo, float hi) { const f32x2h v = {lo, hi}; return __builtin_bit_cast(unsigned, __builtin_convertvector(v, hwbf16x2)); }
__device__ __forceinline__ unsigned f2bf(float f) { return pk2(f, 0.f) & 0xffffu; }

#define XB_TMO      128
#define XB_XCNT(j)  (256  + 64 * (j))
#define XB_XSUB(j)  (1280 + 64 * (j))
#define XB_XGEN(j)  (2304 + 64 * (j))
#define XB_TOP      3328
#define XB_TOPGEN   3392
#define XCD_BAR_WORDS 3456
#define XB_SPIN_CAP (1u << 18)

__device__ __forceinline__ unsigned xb_ld(unsigned* p)              { return __hip_atomic_load(p, __ATOMIC_RELAXED, __HIP_MEMORY_SCOPE_AGENT); }
__device__ __forceinline__ unsigned xb_add(unsigned* p, unsigned v) { return __hip_atomic_fetch_add(p, v, __ATOMIC_RELAXED, __HIP_MEMORY_SCOPE_AGENT); }
__device__ __forceinline__ unsigned xb_xcc_id() { return (unsigned)__builtin_amdgcn_s_getreg((3 << 11) | 20) & 0xFu; }
#define XB_SPIN(cond, bar) do { unsigned _sp = 0; while (cond) { __builtin_amdgcn_s_sleep(1); \
    if ((++_sp & 255u) == 0u) { if (xb_ld(&(bar)[XB_TMO])) break; if (_sp > XB_SPIN_CAP) { atomicAdd(&(bar)[XB_TMO], 1u); break; } } } } while (0)

struct XcdBarrier {
    unsigned* bar; unsigned x;
    volatile LAS unsigned* st;
};

__device__ __forceinline__ XcdBarrier xcd_barrier_post(unsigned* bar, volatile LAS unsigned* st) {
    XcdBarrier b; b.bar = bar; b.x = xb_xcc_id(); b.st = st;
    if (threadIdx.x == 0) (void)xb_add(&bar[XB_XCNT(b.x)], 1u);
    return b;
}
__device__ __forceinline__ void xcd_barrier_complete(unsigned* bar, unsigned x, unsigned& nloc, unsigned& nx) {
    const unsigned G = gridDim.x * gridDim.y * gridDim.z;
    unsigned sum, cnt, mine, sp = 0u;
    for (;;) {
        sum = 0u; cnt = 0u; mine = 0u;
#pragma unroll
        for (unsigned j = 0; j < 16; ++j) { const unsigned c = xb_ld(&bar[XB_XCNT(j)]); sum += c; cnt += (c > 0u) ? 1u : 0u; mine = (j == x) ? c : mine; }
        if (sum == G) break;
        __builtin_amdgcn_s_sleep(1);
        if ((++sp & 255u) == 0u) { if (xb_ld(&bar[XB_TMO])) break; if (sp > XB_SPIN_CAP) { atomicAdd(&bar[XB_TMO], 1u); break; } }
    }
    nloc = mine > 0u ? mine : 1u; nx = cnt > 0u ? cnt : 1u;
}

__device__ __forceinline__ void xcd_barrier(const XcdBarrier& b) {
    asm volatile("s_waitcnt vmcnt(0)" ::: "memory");
    __syncthreads();
    if (threadIdx.x == 0) {
        unsigned* bar = b.bar;
        __builtin_amdgcn_s_waitcnt(0);
        unsigned nloc = b.st[0], nx = b.st[1];
        if (nloc == 0u) { xcd_barrier_complete(bar, b.x, nloc, nx); b.st[0] = nloc; b.st[1] = nx; }
        const unsigned old = xb_add(&bar[XB_XSUB(b.x)], 1u);
        const unsigned gen = old / nloc;
        if (old + 1u == (gen + 1u) * nloc) {
            __builtin_amdgcn_fence(__ATOMIC_RELEASE, "agent");
            asm volatile("s_waitcnt vmcnt(0)" ::: "memory");
            const unsigned og = xb_add(&bar[XB_TOP], 1u);
            const unsigned tg = og / nx;
            if (og + 1u == (tg + 1u) * nx) xb_add(&bar[XB_TOPGEN], 1u);
            else XB_SPIN(xb_ld(&bar[XB_TOPGEN]) == tg, bar);
            __builtin_amdgcn_fence(__ATOMIC_ACQUIRE, "agent");
            xb_add(&bar[XB_XGEN(b.x)], 1u);
            asm volatile("s_waitcnt vmcnt(0)" ::: "memory");
        } else {
            XB_SPIN(xb_ld(&bar[XB_XGEN(b.x)]) == gen, bar);
            __builtin_amdgcn_fence(__ATOMIC_ACQUIRE, "agent");
            asm volatile("s_waitcnt vmcnt(0)" ::: "memory");
        }
    }
    __syncthreads();
}
typedef unsigned u32x2 __attribute__((ext_vector_type(2)));
struct Frame {
    LAS unsigned char* lds;
    volatile LAS unsigned* MISC;
    gu32* ctl;
    int vcu, G;
    unsigned char* ws;
    const float* in[16];
    float* x;
    unsigned long long tp, tl;
};
#ifndef TSEC_ID
#define TSEC_ID (-1)
#endif
#define TSEC_MARK(F) do { if (TSEC_ID >= 0) (F).tl = __builtin_amdgcn_s_memrealtime(); } while (0)
#define TSEC_ADD(F, id) do { if (TSEC_ID >= 0) { const unsigned long long n_ = __builtin_amdgcn_s_memrealtime(); if (TSEC_ID == (id)) (F).tp += n_ - (F).tl; (F).tl = n_; } } while (0)
#define OPQ_TID() int tid = threadIdx.x; asm volatile("" : "+v"(tid)); const int lane = tid & 63, w = __builtin_amdgcn_readfirstlane(tid >> 6), fr = lane & 15, fq = lane >> 4; (void)w; (void)fr; (void)fq
__device__ __forceinline__ float wave_sum(float v) {
#pragma unroll
    for (int o = 1; o < 64; o <<= 1) v += __shfl_xor(v, o);
    return v;
}
__device__ __forceinline__ float wave_max(float v) {
#pragma unroll
    for (int o = 1; o < 64; o <<= 1) v = fmaxf(v, __shfl_xor(v, o));
    return v;
}
__device__ __forceinline__ float bf2f(unsigned short h) { return __builtin_bit_cast(float, (unsigned)h << 16); }
__device__ __forceinline__ float logsig(float x) { return fminf(x, 0.f) - log1pf(expf(-fabsf(x))); }

__device__ __forceinline__ void cv_item(const float* W, int ldw, int K, int sc0, bf16* Bt, int dr0, int k0, const float* gain, float cs, LAS float* scr, int lane) {
    float v[32];
    const float* wp = W + (size_t)(k0 + (lane >> 5)) * ldw + sc0 + (lane & 31);
#pragma unroll
    for (int i = 0; i < 32; ++i) v[i] = wp[(size_t)(2 * i) * ldw];
#pragma unroll
    for (int i = 0; i < 32; ++i) scr[(2 * i + (lane >> 5)) * 33 + (lane & 31)] = v[i];
    LDS_WAIT(); asm volatile("" ::: "memory");
    const int c = lane & 7;
    f32x4 g0 = {cs, cs, cs, cs}, g1 = g0;
    if (gain) { g0 = *(const f32x4*)(gain + k0 + 8 * c) * cs; g1 = *(const f32x4*)(gain + k0 + 8 * c + 4) * cs; }
#pragma unroll
    for (int j = 0; j < 4; ++j) { const int n = (lane >> 3) + 8 * j; const LAS float* s = scr + (8 * c) * 33 + n;
        v4u o; o.x = pk2(s[0 * 33] * g0[0], s[1 * 33] * g0[1]); o.y = pk2(s[2 * 33] * g0[2], s[3 * 33] * g0[3]); o.z = pk2(s[4 * 33] * g1[0], s[5 * 33] * g1[1]); o.w = pk2(s[6 * 33] * g1[2], s[7 * 33] * g1[3]);
        *(GAS v4u*)(Bt + (size_t)(dr0 + n) * K + k0 + 8 * c) = o; }
    LDS_WAIT(); asm volatile("" ::: "memory");
}
__device__ __forceinline__ void convert_layer(Frame& F, int l, int wbase, int nw) {
    OPQ_TID();
    const int wi = wbase + w;
    LAS float* scr = (LAS float*)(F.lds + w * 16384);
    const int j = l >> 1; const bool odd = l & 1;
    const float* norm_mix = F.in[1] + (size_t)l * DM; const float* norm_ffn = F.in[2] + (size_t)l * DM;
    const int nbi = odd ? 64 : 112, I_MI = nbi * 16, I_MO = 32 * 16, I_FI = 176 * 16, I_FO = 32 * 44;
    const int N0 = I_MI, N1 = N0 + I_MO, N2 = N1 + I_FI, N3 = N2 + I_FO, NT = N3 + (odd ? 0 : 16);
    for (int it = wi; it < NT; it += nw) {
        if (it < N0) { const int kb = it / nbi, nb = it % nbi, c0 = 32 * nb;
            if (odd) cv_item(F.in[8] + (size_t)j * DM * 2048, 2048, DM, c0, (bf16*)(F.ws + WS_WOI) + (size_t)j * 2048 * DM, c0, 64 * kb, norm_mix, 1.0f, scr, lane);
            else cv_item(F.in[3] + (size_t)j * DM * EVEN_IN, EVEN_IN, DM, c0, (bf16*)(F.ws + WS_WEI) + (size_t)j * EVEN_NP * DM, c0, 64 * kb, norm_mix, (c0 >= 2048 && c0 < 2560) ? 0.08838834764831845f : 1.0f, scr, lane);
        } else if (it < N1) { const int r = it - N0, kb = r / 32, nb = r % 32;
            cv_item((odd ? F.in[12] : F.in[7]) + (size_t)j * DM * DM, DM, DM, 32 * nb, (bf16*)(F.ws + (odd ? WS_WOO : WS_WEO)) + (size_t)j * DM * DM, 32 * nb, 64 * kb, nullptr, 1.0f, scr, lane);
        } else if (it < N2) { const int r = it - N1, kb = r / 176, nb = r % 176, c0 = 32 * nb;
            const int up = c0 >= DFF, cc = up ? c0 - DFF : c0, dr = 256 * (cc >> 7) + (up ? 128 : 0) + (cc & 127);
            cv_item(F.in[13] + (size_t)l * DM * 2 * DFF, 2 * DFF, DM, c0, (bf16*)(F.ws + WS_WFI) + (size_t)l * 2 * DFF * DM, dr, 64 * kb, norm_ffn, 1.0f, scr, lane);
        } else if (it < N3) { const int r = it - N2, kb = r / 32, nb = r % 32;
            cv_item(F.in[14] + (size_t)l * DFF * DM, DM, DFF, 32 * nb, (bf16*)(F.ws + WS_WFO) + (size_t)l * DM * DFF, 32 * nb, 64 * kb, nullptr, 1.0f, scr, lane);
        } else { const int k0 = 64 * (it - N3);
            const float* W = F.in[3] + (size_t)j * DM * EVEN_IN; bf16* Bt = (bf16*)(F.ws + WS_WEI) + (size_t)j * EVEN_NP * DM;
#pragma unroll
            for (int e = 0; e < 8; ++e) { const int id = lane + 64 * e, col = id & 7, kk = k0 + (id >> 3);
                Bt[(size_t)(EVEN_W + col) * DM + kk] = (bf16)f2bf(W[(size_t)kk * EVEN_IN + EVEN_W + col] * norm_mix[kk]); }
        }
    }
}
__device__ __forceinline__ void p0_prologue(Frame& F, const float* xin) {
    OPQ_TID();
    const int gw = F.vcu * NWAVES + w, NGW = F.G * NWAVES;
    float* sq4 = (float*)(F.ws + WS_SQ); bf16* xb = (bf16*)(F.ws + WS_XB);
    for (int m = gw; m < M; m += 2 * NGW) {
        const int m1 = m + NGW;
        const GAS f32x4* xr0 = (const GAS f32x4*)(xin + (size_t)m * DM) + lane; const GAS f32x4* xr1 = (const GAS f32x4*)(xin + (size_t)m1 * DM) + lane;
        f32x4 v0[4], v1[4];
#pragma unroll
        for (int jj = 0; jj < 4; ++jj) { v0[jj] = xr0[64 * jj]; v1[jj] = xr1[64 * jj]; }
        GAS u32x2* bo0 = (GAS u32x2*)(xb + (size_t)m * DM) + lane; GAS u32x2* bo1 = (GAS u32x2*)(xb + (size_t)m1 * DM) + lane; float s0 = 0.f, s1 = 0.f;
#pragma unroll
        for (int jj = 0; jj < 4; ++jj) { u32x2 q; q.x = pk2(v0[jj].x, v0[jj].y); q.y = pk2(v0[jj].z, v0[jj].w); bo0[64 * jj] = q; s0 += (v0[jj].x * v0[jj].x + v0[jj].y * v0[jj].y) + (v0[jj].z * v0[jj].z + v0[jj].w * v0[jj].w);
            u32x2 p; p.x = pk2(v1[jj].x, v1[jj].y); p.y = pk2(v1[jj].z, v1[jj].w); bo1[64 * jj] = p; s1 += (v1[jj].x * v1[jj].x + v1[jj].y * v1[jj].y) + (v1[jj].z * v1[jj].z + v1[jj].w * v1[jj].w); }
        s0 = wave_sum(s0); s1 = wave_sum(s1);
        if (lane < 4) { sq4[(size_t)m * 4 + lane] = (lane == 0) ? s0 : 0.f; sq4[(size_t)m1 * 4 + lane] = (lane == 0) ? s1 : 0.f; }
    }
    convert_layer(F, 0, F.vcu * NWAVES, NGW);
}
__device__ __forceinline__ void final_norm(Frame& F) {
    OPQ_TID();
    const int gw = F.vcu * NWAVES + w, NGW = F.G * NWAVES;
    const float* sq4 = (const float*)(F.ws + WS_SQ); const float* gf = F.in[15]; const bf16* xb = (const bf16*)(F.ws + WS_XB);
    f32x4 g[4];
#pragma unroll
    for (int j = 0; j < 4; ++j) g[j] = ((const f32x4*)gf)[lane + 64 * j];
    for (int m = gw; m < M; m += NGW) {
        const float r = pg8::row_rstd4(sq4, m);
        GAS f32x4* xo = (GAS f32x4*)(F.x + (size_t)m * DM) + lane; const GAS u32x2* bi = (const GAS u32x2*)(xb + (size_t)m * DM) + lane;
#pragma unroll
        for (int j = 0; j < 4; ++j) { const u32x2 b = bi[64 * j]; f32x4 v = {pg8::bf_lo(b.x), pg8::bf_hi(b.x), pg8::bf_lo(b.y), pg8::bf_hi(b.y)}; v = v * r * g[j]; xo[64 * j] = v; }
    }
}
__device__ __forceinline__ void scan128_add(float& v0, float& v1, int lane) {
#pragma unroll
    for (int o = 1; o < 64; o <<= 1) { const float a = __shfl_up(v0, o), b = __shfl_up(v1, o); if (lane >= o) { v0 += a; v1 += b; } }
    v1 += __shfl(v0, 63);
}
__device__ __forceinline__ void scan128_max(float& v0, float& v1, int lane) {
#pragma unroll
    for (int o = 1; o < 64; o <<= 1) { const float a = __shfl_up(v0, o), b = __shfl_up(v1, o); if (lane >= o) { v0 = fmaxf(v0, a); v1 = fmaxf(v1, b); } }
    v1 = fmaxf(v1, __shfl(v0, 63));
}
struct Stg { v4u v[4]; };
__device__ __forceinline__ void stg_load_rows(Stg& s, const bf16* src, int ld, int tid) {
#pragma unroll
    for (int i = 0; i < 4; ++i) { const int id = tid + 512 * i, r = id >> 4, dc = id & 15; s.v[i] = *(const GAS v4u*)(src + (size_t)r * ld + 8 * dc); }
}
__device__ __forceinline__ void stg_store_rows(const Stg& s, LAS unsigned char* tile, int tid) {
#pragma unroll
    for (int i = 0; i < 4; ++i) { const int id = tid + 512 * i, r = id >> 4, dc = id & 15; *(LAS v4u*)(tile + r * TSTR + 16 * dc) = s.v[i]; }
}
__device__ __forceinline__ unsigned scale2(unsigned w, float f) { return pk2(pg8::bf_lo(w) * f, pg8::bf_hi(w) * f); }
__device__ __forceinline__ void stg_store_rows_scaled(const Stg& s, LAS unsigned char* tile, const float (&f)[4], int tid) {
#pragma unroll
    for (int i = 0; i < 4; ++i) { const int id = tid + 512 * i, r = id >> 4, dc = id & 15; v4u o; o.x = scale2(s.v[i].x, f[i]); o.y = scale2(s.v[i].y, f[i]); o.z = scale2(s.v[i].z, f[i]); o.w = scale2(s.v[i].w, f[i]);
        *(LAS v4u*)(tile + r * TSTR + 16 * dc) = o; }
}
typedef short s16x4 __attribute__((ext_vector_type(4)));
__device__ __forceinline__ bf16x8 tr_frag(LAS unsigned char* tile, int trb, int cb, int ks) {
    const s16x4 lo = __builtin_amdgcn_ds_read_tr16_b64_v4i16((LAS s16x4*)(tile + trb + ks * 32 * TSTR + cb * 32));
    const s16x4 hi = __builtin_amdgcn_ds_read_tr16_b64_v4i16((LAS s16x4*)(tile + trb + ks * 32 * TSTR + 4 * TSTR + cb * 32));
    return (bf16x8){lo[0], lo[1], lo[2], lo[3], hi[0], hi[1], hi[2], hi[3]};
}
#define TRB(lane) ((8 * ((lane) >> 4) + (((lane) & 15) >> 2)) * TSTR + 8 * ((lane) & 3))
#define FRAG(tile, row, kk, fq) (*(const LAS bf16x8*)((tile) + (row) * TSTR + (32 * (kk) + 8 * (fq)) * 2))

__device__ __forceinline__ void mlstm_phase_a(Frame& F) {
    LAS unsigned char* TK = F.lds; LAS unsigned char* TV = F.lds + TILE_B; LAS float* aS = (LAS float*)(F.lds + 2 * TILE_B); LAS float* nP = aS + 128;
    const bf16* proj = (const bf16*)(F.ws + WS_BIG); const float* gates = (const float*)(F.ws + WS_GATES);
    bf16* Cloc = (bf16*)(F.ws + WS_CLOC); float* nloc = (float*)(F.ws + WS_NLOC); float* mloc = (float*)(F.ws + WS_MLOC); float* bLv = (float*)(F.ws + WS_BL);
    for (int u = F.vcu; u < NUNIT; u += F.G) {
        OPQ_TID();
        const int bh = u >> 6, c = u & 63, b = bh >> 2, h = bh & 3, row0 = b * SEQ + c * CHUNK;
        if (w == 0) {
            const float i0 = gates[(size_t)(row0 + lane) * 8 + h], i1 = gates[(size_t)(row0 + lane + 64) * 8 + h];
            float b0 = logsig(gates[(size_t)(row0 + lane) * 8 + 4 + h]), b1 = logsig(gates[(size_t)(row0 + lane + 64) * 8 + 4 + h]);
            scan128_add(b0, b1, lane);
            const float bL = __shfl(b1, 63);
            const float w0 = bL - b0 + i0, w1 = bL - b1 + i1;
            const float ml = wave_max(fmaxf(w0, w1));
            aS[lane] = __expf(w0 - ml); aS[lane + 64] = __expf(w1 - ml);
            if (lane == 0) { mloc[u] = ml; bLv[u] = bL; }
        }
        Stg sk, sv;
        stg_load_rows(sk, proj + (size_t)row0 * EVEN_W + 2048 + h * HD, EVEN_W, tid); stg_load_rows(sv, proj + (size_t)row0 * EVEN_W + 2560 + h * HD, EVEN_W, tid);
        __syncthreads();
        { float fa[4];
#pragma unroll
          for (int i = 0; i < 4; ++i) fa[i] = aS[(tid >> 4) + 32 * i];
          stg_store_rows_scaled(sk, TK, fa, tid); }
        stg_store_rows(sv, TV, tid);
        __syncthreads();
        const int trb = TRB(lane);
        bf16x8 vf[4];
#pragma unroll
        for (int kk = 0; kk < 4; ++kk) vf[kk] = tr_frag(TV, trb, w, kk);
#pragma unroll
        for (int db = 0; db < 8; ++db) { f32x4 acc = {0.f, 0.f, 0.f, 0.f};
#pragma unroll
            for (int kk = 0; kk < 4; ++kk) acc = __builtin_amdgcn_mfma_f32_16x16x32_bf16(tr_frag(TK, trb, db, kk), vf[kk], acc, 0, 0, 0);
            u32x2 cw; cw.x = pk2(acc[0], acc[1]); cw.y = pk2(acc[2], acc[3]);
            *(GAS u32x2*)(Cloc + (size_t)u * (HD * HD) + (size_t)(16 * w + fr) * HD + 16 * db + 4 * fq) = cw; }
        {
            const bf16x8 ones = {0x3F80, 0x3F80, 0x3F80, 0x3F80, 0x3F80, 0x3F80, 0x3F80, 0x3F80}; f32x4 an = {0.f, 0.f, 0.f, 0.f};
#pragma unroll
            for (int kk = 0; kk < 4; ++kk) an = __builtin_amdgcn_mfma_f32_16x16x32_bf16(tr_frag(TK, trb, w, kk), ones, an, 0, 0, 0);
            if (fr == 0) *(GAS f32x4*)(nloc + (size_t)u * HD + 16 * w + 4 * fq) = an; }
        __syncthreads();
    }
}
struct ConvRegs { v4u cg[6], xa[6], bg[4]; };
__device__ __forceinline__ void conv_load(ConvRegs& R, const bf16* proj, int g) {
    const int t0 = (g >> 6) * 4, c8 = (g & 63) * 8; const bool first = (t0 & (SEQ - 1)) == 0;
#pragma unroll
    for (int i = 0; i < 6; ++i) { const int t = (first && i < 2) ? t0 : t0 - 2 + i; const bf16* p = proj + (size_t)t * EVEN_W; R.cg[i] = *(const GAS v4u*)(p + CD + c8); R.xa[i] = *(const GAS v4u*)(p + 2 * CD + c8); }
#pragma unroll
    for (int i = 0; i < 4; ++i) R.bg[i] = *(const GAS v4u*)(proj + (size_t)(t0 + i) * EVEN_W + c8);
}
__device__ __forceinline__ void conv_z(float (&z)[8], const v4u& c, const v4u& x, float msk) {
    const unsigned cw[4] = {c.x, c.y, c.z, c.w}, xw[4] = {x.x, x.y, x.z, x.w};
#pragma unroll
    for (int j = 0; j < 4; ++j) { z[2 * j] = msk * pg8::bf_lo(cw[j]) * pg8::bf_lo(xw[j]); z[2 * j + 1] = msk * pg8::bf_hi(cw[j]) * pg8::bf_hi(xw[j]); }
}
__device__ __forceinline__ void conv_finish(const ConvRegs& R, const float* wconv, bf16* Y, int g) {
    const int t0 = (g >> 6) * 4, c8 = (g & 63) * 8; const bool first = (t0 & (SEQ - 1)) == 0; const float msk = first ? 0.f : 1.f;
    float wc[3][8];
#pragma unroll
    for (int jj = 0; jj < 3; ++jj) { const f32x4 a = *(const f32x4*)(wconv + jj * CD + c8), b = *(const f32x4*)(wconv + jj * CD + c8 + 4);
        wc[jj][0] = a[0]; wc[jj][1] = a[1]; wc[jj][2] = a[2]; wc[jj][3] = a[3]; wc[jj][4] = b[0]; wc[jj][5] = b[1]; wc[jj][6] = b[2]; wc[jj][7] = b[3]; }
    float z0[8], z1[8], z2[8];
    conv_z(z0, R.cg[0], R.xa[0], msk); conv_z(z1, R.cg[1], R.xa[1], msk);
#pragma unroll
    for (int i = 0; i < 4; ++i) { conv_z(z2, R.cg[i + 2], R.xa[i + 2], 1.0f);
        const unsigned bw[4] = {R.bg[i].x, R.bg[i].y, R.bg[i].z, R.bg[i].w}; unsigned ow[4];
#pragma unroll
        for (int j = 0; j < 4; ++j) { const float a0 = wc[0][2 * j] * z0[2 * j] + wc[1][2 * j] * z1[2 * j] + wc[2][2 * j] * z2[2 * j];
            const float a1 = wc[0][2 * j + 1] * z0[2 * j + 1] + wc[1][2 * j + 1] * z1[2 * j + 1] + wc[2][2 * j + 1] * z2[2 * j + 1];
            ow[j] = pk2(pg8::bf_lo(bw[j]) * a0, pg8::bf_hi(bw[j]) * a1); }
        v4u o; o.x = ow[0]; o.y = ow[1]; o.z = ow[2]; o.w = ow[3];
        *(GAS v4u*)(Y + (size_t)(t0 + i) * DM + c8) = o;
#pragma unroll
        for (int j = 0; j < 8; ++j) { z0[j] = z1[j]; z1[j] = z2[j]; } }
}
__device__ __forceinline__ void mlstm_scan_and_conv(Frame& F, const float* wconv) {
    OPQ_TID();
    const bf16* Cloc = (const bf16*)(F.ws + WS_CLOC); const float* nloc = (const float*)(F.ws + WS_NLOC); const float* mloc = (const float*)(F.ws + WS_MLOC); const float* bLv = (const float*)(F.ws + WS_BL);
    bf16* Cin = (bf16*)(F.ws + WS_CIN); float* nin = (float*)(F.ws + WS_NIN); float* minv = (float*)(F.ws + WS_MIN);
    const bf16* proj = (const bf16*)(F.ws + WS_BIG); bf16* Y = (bf16*)(F.ws + WS_Y);
    LAS float* alS = (LAS float*)F.lds; LAS float* beS = alS + 64;
    const int NCONV = (M / 4) * (CD / 8), NT = F.G * 512; int g = F.vcu * 512 + tid;
    for (int v = F.vcu; v < NB * HEADS * 32; v += F.G) {
        const int bh = v >> 5, part = v & 31, idx = part * 512 + tid;
        ConvRegs R; const bool c0 = g < NCONV; if (c0) conv_load(R, proj, g);
        unsigned short cl[64];
#pragma unroll
        for (int c = 0; c < 64; ++c) cl[c] = Cloc[(size_t)(bh * NCH + c) * (HD * HD) + idx];
        if (w == 0) {
            const float ml = mloc[bh * NCH + lane], bl = bLv[bh * NCH + lane]; float m = 0.f, al = 0.f, be = 0.f, mi = 0.f;
            for (int c = 0; c < 64; ++c) { const float mlc = __shfl(ml, c), blc = __shfl(bl, c); const float mn = fmaxf(blc + m, mlc);
                if (lane == c) { al = __expf(blc + m - mn); be = __expf(mlc - mn); mi = m; } m = mn; }
            alS[lane] = al; beS[lane] = be; if (part == 0) minv[bh * NCH + lane] = mi;
        }
        if (c0) { conv_finish(R, wconv, Y, g); g += NT; }
        const bool c1 = g < NCONV; if (c1) conv_load(R, proj, g);
        __syncthreads();
        float C = 0.f;
#pragma unroll
        for (int c = 0; c < 64; ++c) { Cin[(size_t)(bh * NCH + c) * (HD * HD) + idx] = (bf16)f2bf(C); C = alS[c] * C + beS[c] * bf2f(cl[c]); }
        if (part == 0 && tid < 128) { float n = 0.f;
#pragma unroll 8
            for (int c = 0; c < 64; ++c) { nin[(size_t)(bh * NCH + c) * HD + tid] = n; n = alS[c] * n + beS[c] * nloc[(size_t)(bh * NCH + c) * HD + tid]; } }
        if (c1) { conv_finish(R, wconv, Y, g); g += NT; }
        __syncthreads();
    }
    for (; g < NCONV; g += NT) { ConvRegs R; conv_load(R, proj, g); conv_finish(R, wconv, Y, g); }
}
__device__ __forceinline__ void mlstm_phase_c(Frame& F, const float* ghead) {
    LAS unsigned char* TK = F.lds; LAS unsigned char* TV = F.lds + TILE_B; LAS unsigned char* TC = F.lds + 2 * TILE_B; LAS unsigned char* TS = F.lds + 3 * TILE_B;
    LAS float* gS = (LAS float*)(F.lds + 4 * TILE_B); LAS float* mxS = gS + 128; LAS float* bS = gS + 256; LAS float* nS = gS + 384;
    const bf16* proj = (const bf16*)(F.ws + WS_BIG); const float* gates = (const float*)(F.ws + WS_GATES);
    const bf16* Cin = (const bf16*)(F.ws + WS_CIN); const float* nin = (const float*)(F.ws + WS_NIN); const float* minv = (const float*)(F.ws + WS_MIN);
    bf16* Y = (bf16*)(F.ws + WS_Y);
    for (int u = F.vcu; u < NUNIT; u += F.G) {
        OPQ_TID();
        const int bh = u >> 6, c = u & 63, b = bh >> 2, h = bh & 3, row0 = b * SEQ + c * CHUNK;
        const float m_in = minv[u];
        if (w == 0) {
            const float i0 = gates[(size_t)(row0 + lane) * 8 + h], i1 = gates[(size_t)(row0 + lane + 64) * 8 + h];
            float b0 = logsig(gates[(size_t)(row0 + lane) * 8 + 4 + h]), b1 = logsig(gates[(size_t)(row0 + lane + 64) * 8 + 4 + h]);
            scan128_add(b0, b1, lane);
            const float g0 = i0 - b0, g1 = i1 - b1; float p0 = g0, p1 = g1;
            scan128_max(p0, p1, lane);
            gS[lane] = g0; gS[lane + 64] = g1; mxS[lane] = fmaxf(m_in, p0); mxS[lane + 64] = fmaxf(m_in, p1); bS[lane] = b0; bS[lane + 64] = b1;
        } else if (w == 1) { nS[lane] = nin[(size_t)u * HD + lane]; nS[lane + 64] = nin[(size_t)u * HD + lane + 64]; }
        const int t = 16 * w + fr;
        bf16x8 qf[4];
#pragma unroll
        for (int kk = 0; kk < 4; ++kk) qf[kk] = *(const GAS bf16x8*)(proj + (size_t)(row0 + t) * EVEN_W + 1536 + h * HD + 32 * kk + 8 * fq);
        Stg sk, sc, sv;
        stg_load_rows(sk, proj + (size_t)row0 * EVEN_W + 2048 + h * HD, EVEN_W, tid); stg_load_rows(sc, Cin + (size_t)u * (HD * HD), HD, tid); stg_load_rows(sv, proj + (size_t)row0 * EVEN_W + 2560 + h * HD, EVEN_W, tid);
        u32x2 ovv[8]; f32x4 ghv[8];
#pragma unroll
        for (int eb = 0; eb < 8; ++eb) ghv[eb] = *(const f32x4*)(ghead + h * HD + 16 * eb + 4 * fq);
#pragma unroll
        for (int eb = 0; eb < 8; ++eb) ovv[eb] = *(const GAS u32x2*)(proj + (size_t)(row0 + t) * EVEN_W + 3072 + h * HD + 16 * eb + 4 * fq);
        stg_store_rows(sk, TK, tid);
        stg_store_rows(sc, TC, tid);
        stg_store_rows(sv, TV, tid);
        const int trb = TRB(lane);
        __syncthreads();
        const float mx_t = mxS[t], b_t = bS[t], inter = __expf(m_in - mx_t);
        float den1 = 0.f;
#pragma unroll
        for (int sb = 0; sb < 8; ++sb) {
            u32x2 pk = {0u, 0u};
            if (sb <= w) { f32x4 acc = {0.f, 0.f, 0.f, 0.f};
#pragma unroll
                for (int kk = 0; kk < 4; ++kk) acc = __builtin_amdgcn_mfma_f32_16x16x32_bf16(FRAG(TK, 16 * sb + fr, kk, fq), qf[kk], acc, 0, 0, 0);
                float sv[4]; const f32x4 gq = *(const LAS f32x4*)(gS + 16 * sb + 4 * fq);
#pragma unroll
                for (int r = 0; r < 4; ++r) { const int s = 16 * sb + 4 * fq + r; const float e = __expf(gq[r] - mx_t); sv[r] = (s <= t) ? acc[r] * e : 0.f; den1 += sv[r]; }
                pk.x = pk2(sv[0], sv[1]); pk.y = pk2(sv[2], sv[3]); }
            *(LAS u32x2*)(TS + t * TSTR + (16 * sb + 4 * fq) * 2) = pk;
        }
        den1 += __shfl_xor(den1, 16); den1 += __shfl_xor(den1, 32);
        float qn = 0.f;
#pragma unroll
        for (int kk = 0; kk < 4; ++kk) { const f32x4 n0 = *(const LAS f32x4*)(nS + 32 * kk + 8 * fq), n1 = *(const LAS f32x4*)(nS + 32 * kk + 8 * fq + 4);
#pragma unroll
            for (int j = 0; j < 4; ++j) qn += bf2f((unsigned short)qf[kk][j]) * n0[j] + bf2f((unsigned short)qf[kk][j + 4]) * n1[j]; }
        qn += __shfl_xor(qn, 16); qn += __shfl_xor(qn, 32);
        const float den = den1 + inter * qn, m_t = b_t + mx_t;
        const float rden = 1.0f / fmaxf(fabsf(den), __expf(-m_t));
        bf16x8 sf[4];
#pragma unroll
        for (int kk = 0; kk < 4; ++kk) sf[kk] = FRAG(TS, t, kk, fq);
        float hh[32]; float ssq = 0.f;
#pragma unroll
        for (int eb = 0; eb < 8; ++eb) { f32x4 a1 = {0.f, 0.f, 0.f, 0.f}, a2 = {0.f, 0.f, 0.f, 0.f};
#pragma unroll
            for (int kk = 0; kk < 4; ++kk) { if (2 * kk <= w) a1 = __builtin_amdgcn_mfma_f32_16x16x32_bf16(tr_frag(TV, trb, eb, kk), sf[kk], a1, 0, 0, 0);
                a2 = __builtin_amdgcn_mfma_f32_16x16x32_bf16(FRAG(TC, 16 * eb + fr, kk, fq), qf[kk], a2, 0, 0, 0); }
#pragma unroll
            for (int r = 0; r < 4; ++r) { const float v = (a1[r] + inter * a2[r]) * rden; hh[4 * eb + r] = v; ssq += v * v; } }
        ssq += __shfl_xor(ssq, 16); ssq += __shfl_xor(ssq, 32);
        const float rs = __builtin_amdgcn_rsqf(ssq * (1.0f / 128.0f) + RMS_EPS);
#pragma unroll
        for (int eb = 0; eb < 8; ++eb) { const int e = 16 * eb + 4 * fq;
            const u32x2 ov = ovv[eb]; const f32x4 gh = ghv[eb] * rs; (void)e;
            const float o0 = bf2f((unsigned short)(ov.x & 0xffffu)), o1 = bf2f((unsigned short)(ov.x >> 16)), o2 = bf2f((unsigned short)(ov.y & 0xffffu)), o3 = bf2f((unsigned short)(ov.y >> 16));
            u32x2 y; y.x = pk2(pg8::fast_sigmoid(o0) * hh[4 * eb] * gh[0], pg8::fast_sigmoid(o1) * hh[4 * eb + 1] * gh[1]);
            y.y = pk2(pg8::fast_sigmoid(o2) * hh[4 * eb + 2] * gh[2], pg8::fast_sigmoid(o3) * hh[4 * eb + 3] * gh[3]);
            *(GAS u32x2*)(Y + (size_t)(row0 + t) * DM + MD + h * HD + e) = y; }
        __syncthreads();
    }
}
__device__ __forceinline__ void sgu_phase(Frame& F, const float* gv, const float* wsp, const float* bsp) {
    LAS unsigned char* TW = F.lds; LAS unsigned char* TV = F.lds + TILE_B;
    const bf16* Z = (const bf16*)(F.ws + WS_BIG); const float* vsq16 = (const float*)(F.ws + WS_VSQ); bf16* Y = (bf16*)(F.ws + WS_Y);
    for (int v = F.vcu; v < 256; v += F.G) {
        OPQ_TID();
        const int g = v & 7, cb0 = (v >> 3) * 4;
#pragma unroll
        for (int i = 0; i < 8; ++i) { const int id = tid + 512 * i, t = id >> 5, s4 = (id & 31) * 4;
            const f32x4 wv = *(const f32x4*)(wsp + ((size_t)g * CHUNK + t) * CHUNK + s4);
            u32x2 pk; pk.x = pk2(s4 <= t ? wv[0] : 0.f, s4 + 1 <= t ? wv[1] : 0.f); pk.y = pk2(s4 + 2 <= t ? wv[2] : 0.f, s4 + 3 <= t ? wv[3] : 0.f);
            *(LAS u32x2*)(TW + t * TSTR + s4 * 2) = pk; }
        const int trb = TRB(lane), col = g * 128 + 16 * w + 4 * fq;
        const f32x4 gvv = *(const f32x4*)(gv + col);
        float bst[8];
#pragma unroll
        for (int tb = 0; tb < 8; ++tb) bst[tb] = bsp[g * CHUNK + 16 * tb + fr];
        for (int ci = 0; ci < 4; ++ci) {
            const int row0 = (cb0 + ci) * CHUNK;
            Stg sv; stg_load_rows(sv, Z + (size_t)row0 * 2048 + 1024 + g * 128, 2048, tid);
            float rs[4];
#pragma unroll
            for (int i = 0; i < 4; ++i) rs[i] = pg8::row_rstd16(vsq16, row0 + (tid >> 4) + 32 * i);
            u32x2 uv[8];
#pragma unroll
            for (int tb = 0; tb < 8; ++tb) uv[tb] = *(const GAS u32x2*)(Z + (size_t)(row0 + 16 * tb + fr) * 2048 + col);
            stg_store_rows_scaled(sv, TV, rs, tid);
            __syncthreads();
            bf16x8 vf[4];
#pragma unroll
            for (int kk = 0; kk < 4; ++kk) vf[kk] = tr_frag(TV, trb, w, kk);
#pragma unroll
            for (int tb = 0; tb < 8; ++tb) { f32x4 acc = {0.f, 0.f, 0.f, 0.f};
#pragma unroll
                for (int kk = 0; kk < 4; ++kk) if (2 * kk <= tb) acc = __builtin_amdgcn_mfma_f32_16x16x32_bf16(vf[kk], FRAG(TW, 16 * tb + fr, kk, fq), acc, 0, 0, 0);
                u32x2 y; y.x = pk2(pg8::bf_lo(uv[tb].x) * (acc[0] * gvv[0] + bst[tb]), pg8::bf_hi(uv[tb].x) * (acc[1] * gvv[1] + bst[tb]));
                y.y = pk2(pg8::bf_lo(uv[tb].y) * (acc[2] * gvv[2] + bst[tb]), pg8::bf_hi(uv[tb].y) * (acc[3] * gvv[3] + bst[tb]));
                *(GAS u32x2*)(Y + (size_t)(row0 + 16 * tb + fr) * DM + col) = y; }
            __syncthreads();
        }
    }
}
#ifndef PROBE_MASK
#define PROBE_MASK 0
#endif
#ifndef TPROBE_KIND
#define TPROBE_KIND (-1)
#endif
#ifndef TPROBE_MODE
#define TPROBE_MODE 2
#endif
struct Args { const float* in[16]; float* out; unsigned char* ws; int ph_lo, ph_hi; };
constexpr int N_PHASES = 26;
enum Kind { K_P0, K_E1, K_E2, K_E3, K_E4, K_RESMIX, K_F1, K_RESFFN, K_O1, K_O2, K_FINAL };
__device__ __forceinline__ void decode_phase(int p, int& kind, int& layer) {
    if (p == 0) { kind = K_P0; layer = 0; return; }
    if (p == 25) { kind = K_FINAL; layer = 0; return; }
    int q = p - 1; const int pair = q / 12; q -= pair * 12;
    if (q < 7) { layer = 2 * pair; kind = q == 0 ? K_E1 : q == 1 ? K_E2 : q == 2 ? K_E3 : q == 3 ? K_E4 : q == 4 ? K_RESMIX : q == 5 ? K_F1 : K_RESFFN; }
    else { layer = 2 * pair + 1; q -= 7; kind = q == 0 ? K_O1 : q == 1 ? K_O2 : q == 2 ? K_RESMIX : q == 3 ? K_F1 : K_RESFFN; }
}
__global__ void __launch_bounds__(NWAVES * 64, 2) trunk_fwd(Args args) {
    extern __shared__ __attribute__((aligned(16))) unsigned char lds[];
    Frame F;
    F.lds = (LAS unsigned char*)lds;
    F.MISC = (volatile LAS unsigned*)(F.lds + MISC_OFF);
    F.G = gridDim.x; { const int bx = blockIdx.x; F.vcu = (F.G % 8 == 0) ? (bx % 8) * (F.G / 8) + bx / 8 : bx; }
    F.ws = args.ws; F.ctl = (gu32*)(args.ws + WS_CTL); F.x = args.out;
#pragma unroll
    for (int i = 0; i < 16; ++i) F.in[i] = args.in[i];
    for (int u = threadIdx.x; u < (LDS_BYTES - LDSCTL_OFF) / 4; u += NWAVES * 64) ((LAS unsigned*)(F.lds + LDSCTL_OFF))[u] = 0u;
    __syncthreads();
    XcdBarrier bar; bar.bar = (unsigned*)(F.ctl + CW_BAR); bar.x = 0; bar.st = nullptr;
    if (!MK_PER_PHASE) bar = xcd_barrier_post((unsigned*)(F.ctl + CW_BAR), F.MISC + 8);
    bf16* xb = (bf16*)(F.ws + WS_XB); bf16* Yb = (bf16*)(F.ws + WS_Y); bf16* big = (bf16*)(F.ws + WS_BIG);
    float* sq16 = (float*)(F.ws + WS_SQ);
    unsigned long long tpacc = 0; F.tp = 0; F.tl = 0;
    for (int p = args.ph_lo; p < args.ph_hi; ++p) {
        int kind, layer; decode_phase(p, kind, layer);
        const int j = layer >> 1;
        const int reps = ((PROBE_MASK >> kind) & 1) ? 2 : 1;
        unsigned long long tp0 = 0, tp1 = 0; if (TPROBE_KIND >= 0) tp0 = (TPROBE_MODE == 3) ? __builtin_amdgcn_s_memtime() : __builtin_amdgcn_s_memrealtime();
        for (int rep = 0; rep < reps; ++rep) {
        if (kind == K_P0) { p0_prologue(F, F.in[0]); }
        else if (kind == K_E1) {
            pg8::Gemm g{xb, (const bf16*)(F.ws + WS_WEI) + (size_t)j * EVEN_NP * DM, M, EVEN_NP, DM}; pg8::StaticOrder S; S.init(M, EVEN_NP, F.G, (int)blockIdx.x);
            pg8::EpiEvenIn E{big, sq16, (float*)(F.ws + WS_GATES), F.in[5] + (size_t)j * 8};
            pg8::gemm_phase<pg8::EpiEvenIn, pg8::StaticOrder, true, true>(F.lds, g, S, E);
        }
        else if (kind == K_E2) { mlstm_phase_a(F); }
        else if (kind == K_E3) { mlstm_scan_and_conv(F, F.in[4] + (size_t)j * 3 * CD); }
        else if (kind == K_E4) { mlstm_phase_c(F, F.in[6] + (size_t)j * MD); }
        else if (kind == K_RESMIX || kind == K_RESFFN) {
            const bool ffn = kind == K_RESFFN, odd = layer & 1;
            const bf16* A = ffn ? big : Yb;
            const bf16* Bt = ffn ? (const bf16*)(F.ws + WS_WFO) + (size_t)layer * DM * DFF : odd ? (const bf16*)(F.ws + WS_WOO) + (size_t)j * DM * DM : (const bf16*)(F.ws + WS_WEO) + (size_t)j * DM * DM;
            pg8::Gemm g{A, Bt, M, DM, ffn ? DFF : DM}; pg8::StaticOrder S; S.init(M, DM, F.G, (int)blockIdx.x);
            pg8::EpiResid E{xb, (LAS float*)(F.lds + SQS_OFF)};
            pg8::gemm_phase<pg8::EpiResid, pg8::StaticOrder, false, true>(F.lds, g, S, E);
            __syncthreads();
            { OPQ_TID(); (void)lane; pg8::Unit u0; if (S.next(0, u0) && tid < 256) { const f32x4 q = *(const LAS f32x4*)(F.lds + SQS_OFF + tid * 16);
                sq16[(size_t)(u0.pm * 256 + tid) * 4 + u0.pn] = (q[0] + q[1]) + (q[2] + q[3]); } }
        }
        else if (kind == K_F1) {
            pg8::Gemm g{xb, (const bf16*)(F.ws + WS_WFI) + (size_t)layer * 2 * DFF * DM, M, 2 * DFF, DM}; pg8::StaticOrder S; S.init(M, 2 * DFF, F.G, (int)blockIdx.x);
            pg8::EpiSwiGLU E{big, sq16};
            pg8::gemm_phase<pg8::EpiSwiGLU, pg8::StaticOrder, true, true>(F.lds, g, S, E);
            if (layer + 1 < DEPTH && rep == 0 && blockIdx.x >= 128) { __syncthreads(); convert_layer(F, layer + 1, ((int)blockIdx.x - 128) * NWAVES, (F.G - 128) * NWAVES); }
        }
        else if (kind == K_O1) {
            pg8::Gemm g{xb, (const bf16*)(F.ws + WS_WOI) + (size_t)j * 2048 * DM, M, 2048, DM}; pg8::StaticOrder S; S.init(M, 2048, F.G, (int)blockIdx.x);
            pg8::EpiGeluZ E{big, sq16, (float*)(F.ws + WS_VSQ)};
            pg8::gemm_phase<pg8::EpiGeluZ, pg8::StaticOrder, true, true>(F.lds, g, S, E);
        }
        else if (kind == K_O2) { sgu_phase(F, F.in[9] + (size_t)j * DM, F.in[10] + (size_t)j * 8 * CHUNK * CHUNK, F.in[11] + (size_t)j * 8 * CHUNK); }
        else { final_norm(F); }
        if (rep + 1 < reps) xcd_barrier(bar);
        }
        if (TPROBE_KIND >= 0) tp1 = (TPROBE_MODE == 3) ? __builtin_amdgcn_s_memtime() : __builtin_amdgcn_s_memrealtime();
        if (p + 1 < args.ph_hi) xcd_barrier(bar);
        if (TPROBE_KIND >= 0) { const unsigned long long tp2 = __builtin_amdgcn_s_memrealtime(); if (kind == TPROBE_KIND || TPROBE_KIND == 99) tpacc += (TPROBE_MODE == 0) ? (tp1 - tp0) : (TPROBE_MODE == 1) ? (tp2 - tp1) : (TPROBE_MODE == 3) ? ((tp1 - tp0) >> 7) : (tp2 - tp0); }
    }
    if (TSEC_ID >= 0 && blockIdx.x == 0 && threadIdx.x == 0) { const unsigned long long t0 = __builtin_amdgcn_s_memrealtime(); while (__builtin_amdgcn_s_memrealtime() - t0 < 8ull * F.tp) __builtin_amdgcn_s_sleep(8); }
    if (TPROBE_KIND >= 0 && blockIdx.x == 0 && threadIdx.x == 0) { const unsigned long long t0 = __builtin_amdgcn_s_memrealtime(); while (__builtin_amdgcn_s_memrealtime() - t0 < 8ull * tpacc) __builtin_amdgcn_s_sleep(8); }
}

extern "C" void kernel_launch(void* const* d_in, const int* in_sizes, int n_in, void* d_out, int out_size, void* d_ws, size_t ws_size, hipStream_t stream) {
    static int grid = 0;
    if (grid == 0) {
        if (n_in != 16 || in_sizes[0] != M * DM || out_size != M * DM || ws_size < WS_END) { fprintf(stderr, "kernel_launch: unexpected shapes / workspace (n_in %d, ws %zu < %zu); nothing launched\n", n_in, ws_size, (size_t)WS_END); grid = -1; return; }
        int dev = 0, cus = 0, per_cu = 0;
        if (hipGetDevice(&dev) != hipSuccess || hipDeviceGetAttribute(&cus, hipDeviceAttributeMultiprocessorCount, dev) != hipSuccess) { grid = -1; return; }
        if (hipFuncSetAttribute((const void*)trunk_fwd, hipFuncAttributeMaxDynamicSharedMemorySize, LDS_BYTES) != hipSuccess) { fprintf(stderr, "kernel_launch: hipFuncSetAttribute failed\n"); grid = -1; return; }
        if (hipOccupancyMaxActiveBlocksPerMultiprocessor(&per_cu, (const void*)trunk_fwd, NWAVES * 64, LDS_BYTES) != hipSuccess || per_cu < 1) fprintf(stderr, "kernel_launch: note: occupancy query says %d\n", per_cu);
        (void)hipGetLastError();
        grid = cus;
    }
    if (grid < 0) return;
    if (hipMemsetAsync((char*)d_ws + WS_CTL, 0, CTL_ZERO_BYTES, stream) != hipSuccess) return;
    Args a{};
    for (int i = 0; i < 16; ++i) a.in[i] = (const float*)d_in[i];
    a.out = (float*)d_out; a.ws = (unsigned char*)d_ws;
#if MK_PER_PHASE
    for (int p = 0; p < N_PHASES; ++p) { a.ph_lo = p; a.ph_hi = p + 1; hipLaunchKernelGGL(trunk_fwd, dim3(grid), dim3(NWAVES * 64), LDS_BYTES, stream, a); }
#else
    a.ph_lo = 0; a.ph_hi = N_PHASES; hipLaunchKernelGGL(trunk_fwd, dim3(grid), dim3(NWAVES * 64), LDS_BYTES, stream, a);
#endif
}
```
